# Optimizing an MI355X kernel written in HIP

```python
import math
import jax, jax.numpy as jnp
from jax import lax
import numpy as np

D_MODEL = 1024
BATCH = 2
SEQ = 8192
DEPTH = 1

D_MIX = D_MODEL
N_DIFF_HEADS = 4
DIFF_HEAD_DIM = 64
DIFF_V_DIM = 2 * DIFF_HEAD_DIM
ATTN_WIDTH = N_DIFF_HEADS * DIFF_V_DIM
QK_WIDTH = N_DIFF_HEADS * 2 * DIFF_HEAD_DIM
POOL_WINDOWS = (2, 4, 8, 16)
POOL_GROUPS = len(POOL_WINDOWS)
POOL_WIDTH = D_MIX - ATTN_WIDTH
POOL_GROUP_DIM = POOL_WIDTH // POOL_GROUPS
IN_COLS = 2 * QK_WIDTH + ATTN_WIDTH + POOL_WIDTH
Q_BLOCK = 128
N_GROUPS = 4
E_PER_GROUP = 8
N_EXPERTS = N_GROUPS * E_PER_GROUP
TOP_K = 2
D_EXPERT = D_MODEL // 2
ROW_BLOCK = 128
EPS = 1e-6

kernel_name = "hybrid_diffattn_pool_hmoe_encoder"


def rmsnorm(x, g):
    xf = x.astype(jnp.float32)
    y = xf * lax.rsqrt(jnp.mean(xf * xf, axis=-1, keepdims=True) + EPS)
    return (y * g.astype(jnp.float32)).astype(x.dtype)


def diff_attention(q, k, v, lam, lam_init, subln_g):
    B, S = q.shape[:2]
    H, Dh = N_DIFF_HEADS, DIFF_HEAD_DIM
    nqb = S // Q_BLOCK
    scale = 1.0 / math.sqrt(Dh)
    slopes = 2.0 ** (-8.0 * jnp.arange(1, H + 1, dtype=jnp.float32) / H)
    kpos = jnp.arange(S, dtype=jnp.int32)
    q_blocks = q.reshape(B, nqb, Q_BLOCK, H, 2, Dh).transpose(1, 0, 2, 3, 4, 5)

    def block(args):
        q_blk, i = args
        s = jnp.einsum('bqhcd,bkhcd->bhcqk', q_blk, k,
                       preferred_element_type=jnp.float32) * scale
        qpos = i * Q_BLOCK + jnp.arange(Q_BLOCK, dtype=jnp.int32)
        dist = jnp.abs(qpos[:, None] - kpos[None, :]).astype(jnp.float32)
        s = s - slopes[None, :, None, None, None] * dist
        p = jax.nn.softmax(s, axis=-1)
        a = p[:, :, 0] - lam * p[:, :, 1]
        return jnp.einsum('bhqk,bkhe->bqhe', a.astype(v.dtype), v)

    o = lax.map(block, (q_blocks, jnp.arange(nqb, dtype=jnp.int32)))
    o = o.transpose(1, 0, 2, 3, 4).reshape(B, S, H, DIFF_V_DIM)
    o = rmsnorm(o, subln_g) * (1.0 - lam_init)
    return o.reshape(B, S, ATTN_WIDTH)


def multiscale_pool(u, w_pool, pool_scale):
    B, S, _ = u.shape
    uf = u.astype(jnp.float32).reshape(B, S, POOL_GROUPS, POOL_GROUP_DIM)
    csum = jnp.concatenate([jnp.zeros((B, 1, POOL_GROUPS, POOL_GROUP_DIM), jnp.float32),
                            jnp.cumsum(uf, axis=1)], axis=1)
    t = jnp.arange(S, dtype=jnp.int32)
    means = []
    for g, w in enumerate(POOL_WINDOWS):
        lo = jnp.clip(t - w // 2, 0, S)
        hi = jnp.clip(t + w // 2, 0, S)
        cnt = (hi - lo).astype(jnp.float32)
        sg = csum[:, hi, g] - csum[:, lo, g]
        means.append(sg / cnt[None, :, None])
    pooled = jnp.stack(means, axis=2)
    d = (pooled - uf).astype(u.dtype)
    y = jnp.einsum('bsgc,gcd->bsgd', d, w_pool).reshape(B, S, POOL_WIDTH)
    return y * pool_scale


def hierarchical_moe(xn, w_gr, b_gr, w_er, b_er, w_gate, w_up, w_down):
    B, S, D = xn.shape
    T = B * S
    xt = xn.reshape(T, D)
    g_logits = (xt @ w_gr).astype(jnp.float32) + b_gr.astype(jnp.float32)
    p_group = jax.nn.softmax(g_logits, axis=-1)
    gsel = jnp.argmax(g_logits, axis=-1).astype(jnp.int32)
    pg = jnp.take_along_axis(p_group, gsel[:, None], axis=-1)
    e_logits = (xt @ w_er.reshape(D, N_EXPERTS)).astype(jnp.float32).reshape(T, N_GROUPS, E_PER_GROUP)
    e_logits = e_logits + b_er.astype(jnp.float32)
    e_logits = jnp.take_along_axis(e_logits, gsel[:, None, None], axis=1)[:, 0]
    p_e = jax.nn.softmax(e_logits, axis=-1)
    top_p, top_i = lax.top_k(p_e, TOP_K)
    top_p = top_p / jnp.sum(top_p, axis=-1, keepdims=True)
    gates = pg * top_p
    expert_ids = gsel[:, None] * E_PER_GROUP + top_i.astype(jnp.int32)

    A = T * TOP_K
    nb = (A + ROW_BLOCK - 1) // ROW_BLOCK + N_EXPERTS
    P = nb * ROW_BLOCK
    flat_e = expert_ids.reshape(-1)
    flat_tok = jnp.repeat(jnp.arange(T, dtype=jnp.int32), TOP_K)
    flat_g = gates.reshape(-1)
    order = jnp.argsort(flat_e)
    se = flat_e[order]
    counts = jnp.bincount(flat_e, length=N_EXPERTS)
    starts = jnp.cumsum(counts) - counts
    padded = (counts + ROW_BLOCK - 1) // ROW_BLOCK * ROW_BLOCK
    pad_ends = jnp.cumsum(padded)
    pad_starts = pad_ends - padded
    dest = pad_starts[se] + (jnp.arange(A, dtype=jnp.int32) - starts[se])
    buf_tok = jnp.full((P,), T, jnp.int32).at[dest].set(flat_tok[order])
    buf_gate = jnp.zeros((P,), jnp.float32).at[dest].set(flat_g[order])
    block_e = jnp.minimum(jnp.searchsorted(pad_ends, jnp.arange(nb, dtype=jnp.int32) * ROW_BLOCK,
                                           side='right'), N_EXPERTS - 1).astype(jnp.int32)
    xpad = jnp.concatenate([xt, jnp.zeros((1, D), xt.dtype)], axis=0)
    xs = xpad[buf_tok].reshape(nb, ROW_BLOCK, D)

    def expert_block(args):
        xb, e = args
        hdn = jax.nn.silu(xb @ w_gate[e]) * (xb @ w_up[e])
        return hdn @ w_down[e]

    ys = lax.map(expert_block, (xs, block_e)).reshape(P, D)
    ys = ys * buf_gate[:, None].astype(ys.dtype)
    out = jnp.zeros((T + 1, D), ys.dtype).at[buf_tok].add(ys)[:T]
    return out.reshape(B, S, D)


def setup_inputs(seed: int = 0) -> dict:
    key = jax.random.key(seed)
    ks = jax.random.split(key, 20)
    f32 = jnp.float32
    L, D = DEPTH, D_MODEL
    nrm = lambda k, shape, s: jax.random.normal(k, shape, f32) * s
    return {
        "x": jax.random.normal(ks[0], (BATCH, SEQ, D), f32),
        "norm1_g": 1.0 + nrm(ks[1], (L, D), 0.02),
        "w_in": nrm(ks[2], (L, D, IN_COLS), D ** -0.5),
        "lambda_q1": nrm(ks[3], (L, DIFF_HEAD_DIM), 0.1),
        "lambda_k1": nrm(ks[4], (L, DIFF_HEAD_DIM), 0.1),
        "lambda_q2": nrm(ks[5], (L, DIFF_HEAD_DIM), 0.1),
        "lambda_k2": nrm(ks[6], (L, DIFF_HEAD_DIM), 0.1),
        "subln_g": 1.0 + nrm(ks[7], (L, DIFF_V_DIM), 0.02),
        "w_pool": nrm(ks[8], (L, POOL_GROUPS, POOL_GROUP_DIM, POOL_GROUP_DIM), POOL_GROUP_DIM ** -0.5),
        "pool_scale": 1.0 + nrm(ks[9], (L, POOL_WIDTH), 0.02),
        "w_out": nrm(ks[10], (L, D_MIX, D), D_MIX ** -0.5),
        "norm2_g": 1.0 + nrm(ks[11], (L, D), 0.02),
        "w_group_router": nrm(ks[12], (L, D, N_GROUPS), D ** -0.5),
        "b_group_router": nrm(ks[13], (L, N_GROUPS), 0.01),
        "w_expert_router": nrm(ks[14], (L, D, N_GROUPS, E_PER_GROUP), D ** -0.5),
        "b_expert_router": nrm(ks[15], (L, N_GROUPS, E_PER_GROUP), 0.01),
        "w_gate": nrm(ks[16], (L, N_EXPERTS, D, D_EXPERT), D ** -0.5),
        "w_up": nrm(ks[17], (L, N_EXPERTS, D, D_EXPERT), D ** -0.5),
        "w_down": nrm(ks[18], (L, N_EXPERTS, D_EXPERT, D), D_EXPERT ** -0.5),
        "final_g": 1.0 + nrm(ks[19], (D,), 0.02),
    }


def reference(x, norm1_g, w_in, lambda_q1, lambda_k1, lambda_q2, lambda_k2, subln_g,
              w_pool, pool_scale, w_out, norm2_g, w_group_router, b_group_router,
              w_expert_router, b_expert_router, w_gate, w_up, w_down, final_g):
    B, S, _ = x.shape
    H, Dh = N_DIFF_HEADS, DIFF_HEAD_DIM
    h = x
    for l in range(DEPTH):
        hn = rmsnorm(h, norm1_g[l])
        proj = hn @ w_in[l]
        q = proj[..., :QK_WIDTH].reshape(B, S, H, 2, Dh)
        k = proj[..., QK_WIDTH:2 * QK_WIDTH].reshape(B, S, H, 2, Dh)
        v = proj[..., 2 * QK_WIDTH:2 * QK_WIDTH + ATTN_WIDTH].reshape(B, S, H, DIFF_V_DIM)
        u = proj[..., 2 * QK_WIDTH + ATTN_WIDTH:]
        lam_init = 0.8 - 0.6 * math.exp(-0.3 * l)
        lam = (jnp.exp(jnp.sum(lambda_q1[l].astype(jnp.float32) * lambda_k1[l].astype(jnp.float32)))
               - jnp.exp(jnp.sum(lambda_q2[l].astype(jnp.float32) * lambda_k2[l].astype(jnp.float32)))
               + lam_init)
        a = diff_attention(q, k, v, lam, lam_init, subln_g[l])
        p = multiscale_pool(u, w_pool[l], pool_scale[l])
        h = h + jnp.concatenate([a, p], axis=-1) @ w_out[l]
        h = h + hierarchical_moe(rmsnorm(h, norm2_g[l]), w_group_router[l], b_group_router[l],
                                 w_expert_router[l], b_expert_router[l],
                                 w_gate[l], w_up[l], w_down[l])
    return rmsnorm(h, final_g)
```

```cpp
#include <hip/hip_runtime.h>
#include <hip/hip_bf16.h>
#include <cstdio>
#include <cstdint>
#include <cmath>
namespace pg8 {
#define PG8_LAS __attribute__((address_space(3)))
typedef unsigned short bf16_t;
typedef short bf16x8 __attribute__((ext_vector_type(8)));
typedef float f32x4 __attribute__((ext_vector_type(4)));
typedef float f32x2 __attribute__((ext_vector_type(2)));
typedef unsigned u32x4 __attribute__((ext_vector_type(4)));
constexpr int BM = 256, BK = 64, HALF = 128, HTB = HALF * BK * 2  , STAGE_BYTES = 8 * HTB, NXCD = 8, WGM = 8;

__host__ __device__ __forceinline__ int lds_byte(int r, int c) { const int st = (r >> 4) * 2 + (c >> 5), rr = r & 15, cc = c & 31, ob = rr * 64 + cc * 2; return st * 1024 + (ob ^ (((ob >> 9) & 1) << 5)); }
__host__ __device__ __forceinline__ void stage_rc(int b, int& R, int& C) { const int st = b / 1024, sb = b % 1024, swz = sb ^ (((sb >> 9) & 1) << 5); R = (st >> 1) * 16 + swz / 64; C = (st & 1) * 32 + (swz % 64) / 2; }
__host__ __device__ __forceinline__ int perm32(int rho) { const int n = rho >> 4, i = rho & 15; return 8 * (i >> 2) + 4 * n + (i & 3); }

struct Unit { int pm, pn, e, lt, cnt; };
struct Gemm { const bf16_t* A; const bf16_t* Bt; int M, N, K; };

struct StaticOrder {
    int nM, nN, nwg, G, c; const bf16_t* A; const bf16_t* Bt; size_t tstep;
    __device__ void init(const Gemm& g, int G_, int c_) { nM = g.M / BM; nN = g.N / BM; nwg = nM * nN; G = G_; c = c_; A = g.A; Bt = g.Bt; tstep = (size_t)BM * g.K * 2; }
    __device__ bool next(int i, Unit& u) const {
        const long L = (long)i * G + c; if (L >= nwg) return false;
        int wgid = (int)L; { const int q = nwg / NXCD, r = nwg % NXCD, xcd = wgid % NXCD, off = wgid / NXCD; wgid = (xcd < r ? xcd * (q + 1) : r * (q + 1) + (xcd - r) * q) + off; }
        const int nig = WGM * nN, gid = wgid / nig, fm = gid * WGM, gsz = (nM - fm) < WGM ? (nM - fm) : WGM;
        u.pm = fm + ((wgid % nig) % gsz); u.pn = (wgid % nig) / gsz; u.e = 0; u.lt = 0; u.cnt = 0; return true;
    }
    __device__ __forceinline__ const char* a_base(const Unit& u) const { return (const char*)A + (size_t)u.pm * tstep; }
    __device__ __forceinline__ const char* b_base(const Unit& u) const { return (const char*)Bt + (size_t)u.pn * tstep; }
    __device__ __forceinline__ unsigned row_off(const Unit&, int) const { return 0u; }
};
template <bool GATHER> struct MoeOrder {
    const PG8_LAS int* tstart; const PG8_LAS int* cnt; int ntiles, G, c;
    const bf16_t* A; const bf16_t* Bt; size_t a_tstep, b_estep, b_tstep; const int* list; int Kb  ;
    __device__ bool next(int i, Unit& u) const {
        const long L = (long)i * G + c; if (L >= 4L * ntiles) return false;
        const int rt = (int)(L >> 2); u.pn = (int)(L & 3); u.pm = rt;
        int e = 0;
#pragma unroll
        for (int k = 1; k < 32; ++k) e += (rt >= tstart[k]) ? 1 : 0;
        e = __builtin_amdgcn_readfirstlane(e);
        u.e = e; u.lt = __builtin_amdgcn_readfirstlane(rt - tstart[e]); u.cnt = __builtin_amdgcn_readfirstlane(cnt[e]); return true;
    }
    __device__ __forceinline__ const char* a_base(const Unit& u) const { return GATHER ? (const char*)A : (const char*)A + (size_t)u.pm * a_tstep; }
    __device__ __forceinline__ const char* b_base(const Unit& u) const { return (const char*)Bt + (size_t)u.e * b_estep + (size_t)u.pn * b_tstep; }
    __device__ __forceinline__ unsigned row_off(const Unit& u, int R) const { const int pos = u.lt * BM + R; const int tok = (pos < u.cnt) ? list[(size_t)u.e * 16384 + pos] : 0; return (unsigned)tok * (unsigned)Kb; }
};

__device__ __forceinline__ unsigned cvt_pk_bf16(float lo, float hi) { unsigned r; asm volatile("v_cvt_pk_bf16_f32 %0, %1, %2" : "=v"(r) : "v"(lo), "v"(hi)); return r; }

struct EpiBf16 {
    static constexpr bool PERM = true;
    bf16_t* O; int ldc; int split_cols; size_t split_stride; float scale0;
    __device__ __forceinline__ void operator()(const f32x4 (&acc)[2][2][4][2], const Unit& u, int wr, int wc, int fr, int fq) const {
        const int row0 = u.pm * BM + wr * 64 + fr; int colt = u.pn * BM; bf16_t* base = O;
        float sc = 1.f; if (split_cols) { const int t = colt / split_cols; base += (size_t)t * split_stride; colt -= t * split_cols; if (t == 0) sc = scale0; }
        const int col0 = colt + wc * 32 + 8 * fq;
#pragma unroll
        for (int ai = 0; ai < 2; ++ai)
#pragma unroll
            for (int m = 0; m < 4; ++m) { bf16_t* rowp = base + (size_t)(row0 + ai * HALF + m * 16) * ldc + col0;
#pragma unroll
                for (int bj = 0; bj < 2; ++bj) { f32x4 v0 = acc[ai][bj][m][0] * sc, v1 = acc[ai][bj][m][1] * sc;
                    u32x4 w; w.x = cvt_pk_bf16(v0[0], v0[1]); w.y = cvt_pk_bf16(v0[2], v0[3]); w.z = cvt_pk_bf16(v1[0], v1[1]); w.w = cvt_pk_bf16(v1[2], v1[3]);
                    *(u32x4*)(rowp + bj * HALF) = w; } }
    }
};
struct EpiResF32 {
    static constexpr bool PERM = false;
    const float* base; float* out; int ldc;
    __device__ __forceinline__ void operator()(const f32x4 (&acc)[2][2][4][2], const Unit& u, int wr, int wc, int fr, int fq) const {
        const int col0 = u.pn * BM + wc * 32 + 4 * fq;
#pragma unroll
        for (int ai = 0; ai < 2; ++ai)
#pragma unroll
            for (int m = 0; m < 4; ++m) { const size_t off = (size_t)(u.pm * BM + ai * HALF + wr * 64 + m * 16 + fr) * ldc + col0;
#pragma unroll
                for (int bj = 0; bj < 2; ++bj)
#pragma unroll
                    for (int n = 0; n < 2; ++n) { const f32x4 bs = *(const f32x4*)(base + off + bj * HALF + n * 16); *(f32x4*)(out + off + bj * HALF + n * 16) = bs + acc[ai][bj][m][n]; } }
    }
};
struct EpiSwiGLU {
    static constexpr bool PERM = true;
    bf16_t* O;
    __device__ __forceinline__ void operator()(const f32x4 (&acc)[2][2][4][2], const Unit& u, int wr, int wc, int fr, int fq) const {
        const int row0 = u.pm * BM + wr * 64 + fr, col0 = u.pn * HALF + wc * 32 + 8 * fq;
#pragma unroll
        for (int ai = 0; ai < 2; ++ai)
#pragma unroll
            for (int m = 0; m < 4; ++m) { float hv[8];
#pragma unroll
                for (int n = 0; n < 2; ++n)
#pragma unroll
                    for (int j = 0; j < 4; ++j) { const float g = acc[ai][0][m][n][j], up = acc[ai][1][m][n][j];
                        const float sg = __builtin_amdgcn_rcpf(1.0f + __builtin_amdgcn_exp2f(-1.4426950408889634f * g)); hv[n * 4 + j] = g * sg * up; }
                u32x4 w; w.x = cvt_pk_bf16(hv[0], hv[1]); w.y = cvt_pk_bf16(hv[2], hv[3]); w.z = cvt_pk_bf16(hv[4], hv[5]); w.w = cvt_pk_bf16(hv[6], hv[7]);
                *(u32x4*)(O + (size_t)(row0 + ai * HALF + m * 16) * 512 + col0) = w; }
    }
};
struct EpiGateBf16 {
    static constexpr bool PERM = true;
    bf16_t* O; const float* glist;
    __device__ __forceinline__ void operator()(const f32x4 (&acc)[2][2][4][2], const Unit& u, int wr, int wc, int fr, int fq) const {
        const int col0 = u.pn * BM + wc * 32 + 8 * fq;
#pragma unroll
        for (int ai = 0; ai < 2; ++ai)
#pragma unroll
            for (int m = 0; m < 4; ++m) { const int R = ai * HALF + wr * 64 + m * 16 + fr, pos = u.lt * BM + R; const float gt = (pos < u.cnt) ? glist[(size_t)u.e * 16384 + pos] : 0.f;
                bf16_t* rowp = O + (size_t)(u.pm * BM + R) * 1024 + col0;
#pragma unroll
                for (int bj = 0; bj < 2; ++bj) { f32x4 v0 = acc[ai][bj][m][0] * gt, v1 = acc[ai][bj][m][1] * gt;
                    u32x4 w; w.x = cvt_pk_bf16(v0[0], v0[1]); w.y = cvt_pk_bf16(v0[2], v0[3]); w.z = cvt_pk_bf16(v1[0], v1[1]); w.w = cvt_pk_bf16(v1[2], v1[3]);
                    *(u32x4*)(rowp + bj * HALF) = w; } }
    }
};

template <class Epi, class Sched, bool GATHER>
__device__ __forceinline__ void gemm_phase(PG8_LAS unsigned char* lds, const int K, const Sched& S, const Epi& E) {
    const int tid = threadIdx.x, wid = __builtin_amdgcn_readfirstlane(tid >> 6), lane = tid & 63, wr = wid >> 2, wc = wid & 3, fr = lane & 15, fq = lane >> 4;
    const int nt = K / BK;
    unsigned voffA[2], voffB[2]; int rowA[2];
#pragma unroll
    for (int i = 0; i < 2; ++i) { int R, C; stage_rc(tid * 16 + i * 8192, R, C); const int Rb = Epi::PERM ? ((R & ~31) + perm32(R & 31)) : R;
        rowA[i] = R; voffA[i] = GATHER ? (unsigned)C * 2u : (unsigned)(R * K + C) * 2u; voffB[i] = (unsigned)(Rb * K + C) * 2u; }
    const size_t kstep = (size_t)(BK * 2);
    const size_t hstep = (size_t)HALF * K * 2;
    const size_t hstepA = GATHER ? 0 : hstep;
    const unsigned ldsw = (unsigned)wid * 1024u;
    const int aoff = lds_byte(wr * 64 + fr, fq * 8), boff = lds_byte(wc * 32 + fr, fq * 8);
#define PG8_SA(b, h) (((b) * 2 + (h)) * HTB)
#define PG8_SB(b, h) ((4 + (b) * 2 + (h)) * HTB)
#define PG8_STAGE(bufoff, gbase, voff) do { _Pragma("unroll") for (int _i = 0; _i < 2; ++_i) \
        __builtin_amdgcn_global_load_lds((const unsigned*)((const char*)(gbase) + (voff)[_i]), (PG8_LAS unsigned*)(lds + (bufoff) + ldsw + _i * 8192), 16, 0, 0); } while (0)
#define PG8_STAGE_A(bufoff, gbase, h, VO) do { _Pragma("unroll") for (int _i = 0; _i < 2; ++_i) \
        __builtin_amdgcn_global_load_lds((const unsigned*)((const char*)(gbase) + (size_t)(h) * hstepA + (GATHER ? (VO)[2 * (h) + _i] : voffA[_i])), (PG8_LAS unsigned*)(lds + (bufoff) + ldsw + _i * 8192), 16, 0, 0); } while (0)
#define PG8_LDA(dst, b, h) do { _Pragma("unroll") for (int m = 0; m < 4; ++m) _Pragma("unroll") for (int k = 0; k < 2; ++k) dst[m][k] = *(const PG8_LAS bf16x8*)(lds + PG8_SA(b, h) + aoff + m * 2048 + k * 1024); } while (0)
#define PG8_LDB(dst, b, h) do { _Pragma("unroll") for (int n = 0; n < 2; ++n) _Pragma("unroll") for (int k = 0; k < 2; ++k) dst[n][k] = *(const PG8_LAS bf16x8*)(lds + PG8_SB(b, h) + boff + n * 2048 + k * 1024); } while (0)
#define PG8_MMA(ai, bj, At, Bt) do { __builtin_amdgcn_s_setprio(1); _Pragma("unroll") for (int m = 0; m < 4; ++m) _Pragma("unroll") for (int n = 0; n < 2; ++n) _Pragma("unroll") for (int k = 0; k < 2; ++k) \
        acc[ai][bj][m][n] = __builtin_amdgcn_mfma_f32_16x16x32_bf16(Bt[n][k], At[m][k], acc[ai][bj][m][n], 0, 0, 0); __builtin_amdgcn_s_setprio(0); } while (0)
#define PG8_WAIT_V(n) asm volatile("s_waitcnt vmcnt(" #n ")" ::: "memory")
#define PG8_WAIT_L(n) asm volatile("s_waitcnt lgkmcnt(" #n ")" ::: "memory")
#define PG8_BAR __builtin_amdgcn_s_barrier()
#define PG8_SCHED __builtin_amdgcn_sched_barrier(0)
    Unit cur, nxt; int ui = 0;
    if (!S.next(0, cur)) return;
    f32x4 acc[2][2][4][2];
#pragma unroll
    for (int a = 0; a < 2; ++a)
#pragma unroll
        for (int b = 0; b < 2; ++b)
#pragma unroll
            for (int m = 0; m < 4; ++m)
#pragma unroll
                for (int n = 0; n < 2; ++n) acc[a][b][m][n] = (f32x4){0.f, 0.f, 0.f, 0.f};
    bf16x8 At[4][2], B0[2][2], B1[2][2];
    const char* cA = S.a_base(cur); const char* cB = S.b_base(cur);
    unsigned vc[4] = {0u, 0u, 0u, 0u}, vn[4] = {0u, 0u, 0u, 0u};
    if constexpr (GATHER) {
#pragma unroll
        for (int h = 0; h < 2; ++h)
#pragma unroll
            for (int i = 0; i < 2; ++i) vc[2 * h + i] = S.row_off(cur, h * HALF + rowA[i]) + voffA[i];
    }
    PG8_STAGE(PG8_SB(0, 0), cB, voffB); PG8_STAGE(PG8_SB(0, 1), cB + hstep, voffB); PG8_STAGE_A(PG8_SA(0, 0), cA, 0, vc); PG8_STAGE_A(PG8_SA(0, 1), cA, 1, vc);
    if (wr == 1) PG8_BAR;
    PG8_WAIT_V(2); PG8_BAR;
    PG8_STAGE(PG8_SB(1, 0), cB + kstep, voffB); PG8_STAGE_A(PG8_SA(1, 0), cA + kstep, 0, vc); PG8_STAGE(PG8_SB(1, 1), cB + hstep + kstep, voffB);
    PG8_WAIT_V(6); PG8_BAR;
    for (;;) {
        const bool has_next = S.next(ui + 1, nxt);
        const char* nA = has_next ? S.a_base(nxt) : cA; const char* nB = has_next ? S.b_base(nxt) : cB;
        if constexpr (GATHER) {
#pragma unroll
            for (int h = 0; h < 2; ++h)
#pragma unroll
                for (int i = 0; i < 2; ++i) vn[2 * h + i] = has_next ? (S.row_off(nxt, h * HALF + rowA[i]) + voffA[i]) : vc[2 * h + i];
        }
        for (int t = 0; t < nt; t += 2) {
            const bool last = (t == nt - 2);
            const char* a1 = cA + (size_t)(t + 1) * kstep;
            const char* a2 = last ? nA : cA + (size_t)(t + 2) * kstep; const char* b2 = last ? nB : cB + (size_t)(t + 2) * kstep;
            const char* a3 = a2 + kstep; const char* b3 = b2 + kstep;
            unsigned v2[4];
#pragma unroll
            for (int q = 0; q < 4; ++q) v2[q] = last ? vn[q] : vc[q];
            PG8_LDB(B0, 0, 0); PG8_LDB(B1, 0, 1); PG8_SCHED; PG8_LDA(At, 0, 0); PG8_STAGE_A(PG8_SA(1, 1), a1, 1, vc);
            PG8_WAIT_V(8); PG8_WAIT_L(0); PG8_BAR; PG8_MMA(0, 0, At, B0); PG8_MMA(0, 1, At, B1); PG8_BAR; PG8_SCHED;
            PG8_LDA(At, 0, 1); PG8_STAGE(PG8_SB(0, 0), b2, voffB); PG8_STAGE(PG8_SB(0, 1), b2 + hstep, voffB); PG8_STAGE_A(PG8_SA(0, 0), a2, 0, v2);
            PG8_WAIT_V(8); PG8_WAIT_L(0); PG8_BAR; PG8_MMA(1, 0, At, B0); PG8_MMA(1, 1, At, B1); PG8_BAR; PG8_SCHED;
            PG8_LDB(B0, 1, 0); PG8_LDB(B1, 1, 1); PG8_SCHED; PG8_LDA(At, 1, 0); PG8_STAGE_A(PG8_SA(0, 1), a2, 1, v2);
            PG8_WAIT_V(8); PG8_WAIT_L(0); PG8_BAR; PG8_MMA(0, 0, At, B0); PG8_MMA(0, 1, At, B1); PG8_BAR; PG8_SCHED;
            PG8_LDA(At, 1, 1); PG8_STAGE(PG8_SB(1, 0), b3, voffB); PG8_STAGE(PG8_SB(1, 1), b3 + hstep, voffB); PG8_STAGE_A(PG8_SA(1, 0), a3, 0, v2);
            PG8_WAIT_V(8); PG8_WAIT_L(0); PG8_BAR; PG8_MMA(1, 0, At, B0); PG8_MMA(1, 1, At, B1); PG8_BAR; PG8_SCHED;
        }
        if (wr == 0) PG8_BAR;
        E(acc, cur, wr, wc, fr, fq);
        if (!has_next) break;
#pragma unroll
        for (int a = 0; a < 2; ++a)
#pragma unroll
            for (int b = 0; b < 2; ++b)
#pragma unroll
                for (int m = 0; m < 4; ++m)
#pragma unroll
                    for (int n = 0; n < 2; ++n) acc[a][b][m][n] = (f32x4){0.f, 0.f, 0.f, 0.f};
        cur = nxt; cA = nA; cB = nB; ++ui;
#pragma unroll
        for (int q = 0; q < 4; ++q) vc[q] = vn[q];
        if (wr == 1) PG8_BAR;
    }
    PG8_WAIT_V(0);
    PG8_BAR;
#undef PG8_SA
#undef PG8_SB
#undef PG8_STAGE
#undef PG8_STAGE_A
#undef PG8_LDA
#undef PG8_LDB
#undef PG8_MMA
#undef PG8_WAIT_V
#undef PG8_WAIT_L
#undef PG8_BAR
#undef PG8_SCHED
}
}
namespace attn {
using bf16x8 = __attribute__((ext_vector_type(8))) short;
using s16x4 = __attribute__((ext_vector_type(4))) short;
using f32x16 = __attribute__((ext_vector_type(16))) float;
using u32x4 = __attribute__((ext_vector_type(4))) unsigned;
typedef unsigned short bf16_t;
constexpr int SEQ = 8192, NW = 8, QBLK = 32, QB = QBLK * NW, KVBLK = 64, NTILE = SEQ / KVBLK, PITCH = 512;
constexpr int KSLOT = 8192, VSLOT = 16384;
constexpr int LDS_K = 0, LDS_V = 3 * KSLOT, LDS_WS = LDS_V + 3 * VSLOT, LDS_OST = LDS_WS + NW * 256, LDS_BYTES = LDS_OST + NW * 8192;
#define SBAR() __builtin_amdgcn_sched_barrier(0)
#define PIN(x) asm volatile("" : "+v"(x))
#define MFMA32(a, b, c) __builtin_amdgcn_mfma_f32_32x32x16_bf16(a, b, c, 0, 0, 0)
#define WAIT_BAR(N) asm volatile("s_waitcnt vmcnt(" #N ") lgkmcnt(0)\n\ts_barrier" ::: "memory")
__device__ __forceinline__ constexpr int crow0(int r) { return (r & 3) + 8 * (r >> 2); }
__device__ __forceinline__ void glds16(const void* g, unsigned lds_base) {
    unsigned sv; asm volatile("s_mov_b32 %0, m0\n\ts_mov_b32 m0, %2\n\ts_nop 0\n\tglobal_load_lds_dwordx4 %1, off\n\ts_mov_b32 m0, %0" : "=&s"(sv) : "v"(g), "s"(lds_base) : "memory"); }
typedef float f32x2_t __attribute__((ext_vector_type(2))); typedef __bf16 bf16x2_t __attribute__((ext_vector_type(2)));
__device__ __forceinline__ unsigned cvtpk(float lo, float hi) { f32x2_t v = {lo, hi}; bf16x2_t b = __builtin_convertvector(v, bf16x2_t); return __builtin_bit_cast(unsigned, b); }
typedef __attribute__((address_space(3))) const char* lds_cptr;
typedef short v4i16_t __attribute__((ext_vector_type(4)));
__device__ __forceinline__ bf16x8 kld(lds_cptr p) { return *(const __attribute__((address_space(3))) bf16x8*)p; }
__device__ __forceinline__ s16x4 vtr(lds_cptr p) { return __builtin_bit_cast(s16x4, __builtin_amdgcn_ds_read_tr16_b64_v4i16((__attribute__((address_space(3))) v4i16_t*)p)); }
#define MX3(a, b, c) __builtin_fmaxf(__builtin_fmaxf((a), (b)), (c))
__device__ __forceinline__ float rowmax(const f32x16& p0, const f32x16& p1) {
    float a = MX3(p0[0], p0[1], p1[0]), b = MX3(p0[2], p0[3], p1[1]); a = MX3(a, p1[2], p1[3]);
#pragma unroll
    for (int r = 4; r < 16; r += 4) { a = MX3(a, p0[r], p0[r + 1]); b = MX3(b, p0[r + 2], p0[r + 3]); a = MX3(a, p1[r], p1[r + 1]); b = MX3(b, p1[r + 2], p1[r + 3]); }
    float m = __builtin_fmaxf(a, b); auto rr = __builtin_amdgcn_permlane32_swap(__float_as_uint(m), __float_as_uint(m), false, false);
    return __builtin_fmaxf(__uint_as_float(rr[0]), __uint_as_float(rr[1])); }
__device__ __forceinline__ float bf2f(short s) { return __uint_as_float(((unsigned)(unsigned short)s) << 16); }
__device__ __forceinline__ void build_c(f32x16& C, int side, float dj, float sg2, float mhat) {
    if (side == 0) {
#pragma unroll
        for (int r = 0; r < 16; ++r) C[r] = __builtin_fmaf(-sg2, __builtin_fabsf(dj + (float)crow0(r)), -mhat);
    } else {
        const float ss = (side > 0) ? -sg2 : sg2, cl = __builtin_fmaf(ss, dj, -mhat);
#pragma unroll
        for (int r = 0; r < 16; ++r) C[r] = __builtin_fmaf(ss, (float)crow0(r), cl);
    }
}

template <int THRL>
__device__ __forceinline__ void attn_unit(int b, int h, int c, int qb, int tlo, int thi, float sg2, const bf16_t* Q, const bf16_t* __restrict__ K, const bf16_t* __restrict__ V, bf16_t* AO, char* lds) {
    const int tid = threadIdx.x, lane = tid & 63, r32 = lane & 31, hi = lane >> 5; const int wid = __builtin_amdgcn_readfirstlane(tid >> 6);
    const long rowbase = (long)b * SEQ; const int q0 = qb * QB, iw0 = q0 + wid * QBLK, n = thi - tlo + 1;
    const bf16_t* Qw = Q + (rowbase + iw0) * PITCH + h * 128 + c * 64;
    const bf16_t* Kh = K + rowbase * PITCH + h * 128 + c * 64; const bf16_t* Vh = V + rowbase * PITCH + h * 128;
    const unsigned lds0 = (unsigned)(uintptr_t)lds; float* wsf = (float*)(lds + LDS_WS) + wid * 64;
    const bf16_t* ksrc = Kh + (long)tlo * KVBLK * PITCH + (long)lane * PITCH + wid * 8;
    const bf16_t* vsrc = Vh + (long)tlo * KVBLK * PITCH + (long)(32 * (wid & 1) + (lane >> 2)) * PITCH + (wid >> 1) * 32 + (lane & 3) * 8;
    const unsigned kdst = lds0 + LDS_K + wid * 1024, vdst = lds0 + LDS_V + wid * 2048;
#define DMA_K(s, slot) glds16(ksrc + (long)(s) * KVBLK * PITCH, (unsigned)__builtin_amdgcn_readfirstlane(kdst + (slot) * KSLOT))
#define DMA_V(s, slot) do { glds16(vsrc + (long)(s) * KVBLK * PITCH, (unsigned)__builtin_amdgcn_readfirstlane(vdst + (slot) * VSLOT)); \
                            glds16(vsrc + (long)(s) * KVBLK * PITCH + 16 * PITCH, (unsigned)__builtin_amdgcn_readfirstlane(vdst + (slot) * VSLOT + 1024)); } while (0)
    const lds_cptr vp0 = (lds_cptr)lds + LDS_V + ((lane >> 4) & 1) * 32 + (lane & 3) * 8 + (4 * hi + ((lane & 15) >> 2)) * 64;
    const lds_cptr kp0 = (lds_cptr)lds + LDS_K + hi * 1024 + r32 * 16;
    DMA_K(0, 0); DMA_V(0, 0); DMA_K(1, 1); DMA_K(2, 2);
    bf16x8 qr[4];
#pragma unroll
    for (int d0 = 0; d0 < 4; ++d0) qr[d0] = *reinterpret_cast<const bf16x8*>(&Qw[(long)r32 * PITCH + d0 * 16 + hi * 8]);
    float mhat;
    { const bf16_t* Kd = Kh + (long)(iw0 + r32) * PITCH; float s = 0.f;
#pragma unroll
      for (int d0 = 0; d0 < 4; ++d0) { const bf16x8 kk = *reinterpret_cast<const bf16x8*>(&Kd[d0 * 16 + hi * 8]);
#pragma unroll
          for (int j = 0; j < 8; ++j) s = __builtin_fmaf(bf2f(qr[d0][j]), bf2f(kk[j]), s); }
      auto rr = __builtin_amdgcn_permlane32_swap(__float_as_uint(s), __float_as_uint(s), false, false); mhat = __uint_as_float(rr[0]) + __uint_as_float(rr[1]); }
    float l_reg = 0.f; f32x16 o[4]; o[0] = f32x16{}; o[1] = f32x16{}; o[2] = f32x16{}; o[3] = f32x16{};
    const float fi = (float)(4 * hi - (iw0 + r32));
    bool resc = false;
    f32x16 C0, C1; bf16x8 kf[8]; u32x4 pw0, pw1, pw2, pw3;
    pw0 = u32x4{}; pw1 = u32x4{}; pw2 = u32x4{}; pw3 = u32x4{};
    int s_prev = 0, s_cur = 0, s_next = 1;
#define ROT() do { s_prev = s_cur; s_cur = s_next; s_next = (s_next == 2) ? 0 : s_next + 1; } while (0)
#define EX(v) __builtin_amdgcn_exp2f(v)
#define RESC() do { if (resc) { asm volatile("s_waitcnt lgkmcnt(0)" ::: "memory"); _Pragma("unroll") for (int d_ = 0; d_ < 4; ++d_) _Pragma("unroll") for (int r = 0; r < 16; ++r) o[d_][r] *= wsf[crow0(r) + 4 * hi]; } } while (0)
    asm volatile("s_waitcnt vmcnt(0) lgkmcnt(0)\n\ts_barrier" ::: "memory");
#pragma unroll
    for (int f = 0; f < 8; ++f) kf[f] = kld(kp0 + (f >> 1) * 2048 + (f & 1) * 512);
    asm volatile("s_waitcnt lgkmcnt(0)\n\ts_barrier" ::: "memory");
#define PKW(P, i) cvtpk(P[i], P[i + 1])
#define PAF(k) __builtin_bit_cast(bf16x8, pw##k)
#define VFRG(lo, hi_) (bf16x8){lo[0], lo[1], lo[2], lo[3], hi_[0], hi_[1], hi_[2], hi_[3]}
#define VRD(f) do { vlo[f] = vtr(vp_ + (((f) & 3) * 4096 + ((f) >> 2) * 1024)); vhi[f] = vtr(vp_ + (((f) & 3) * 4096 + ((f) >> 2) * 1024 + 512)); } while (0)
#define STEP(s, FIRST, GK, GV, GL) do { SBAR(); \
    const int jt_ = (tlo + (s)) * KVBLK; const lds_cptr vp_ = vp0 + s_prev * VSLOT; s16x4 vlo[16], vhi[16]; \
    { const int d0_ = jt_ - iw0, d1_ = jt_ + 32 - iw0; \
      build_c(C0, (d0_ > 0) - (d0_ < 0), (float)jt_ + fi, sg2, mhat); build_c(C1, (d1_ > 0) - (d1_ < 0), (float)(jt_ + 32) + fi, sg2, mhat); } \
    if (!(FIRST)) { VRD(0); VRD(1); } SBAR(); \
    C0 = MFMA32(kf[0], qr[0], C0); C1 = MFMA32(kf[1], qr[0], C1); SBAR(); \
    if (!(FIRST)) { VRD(2); VRD(3); } SBAR(); \
    C0 = MFMA32(kf[2], qr[1], C0); C1 = MFMA32(kf[3], qr[1], C1); SBAR(); \
    C0 = MFMA32(kf[4], qr[2], C0); C1 = MFMA32(kf[5], qr[2], C1); SBAR(); \
    C0 = MFMA32(kf[6], qr[3], C0); C1 = MFMA32(kf[7], qr[3], C1); SBAR(); \
    if (GK) DMA_K((s) + 3, s_cur); if (GV) DMA_V((s) + 1, s_next); \
    { const float rm = rowmax(C0, C1); resc = false; \
      if (__builtin_expect(__any(rm > (float)THRL), 0)) { const float dl = __builtin_fmaxf(rm, 0.f); mhat += dl; \
          _Pragma("unroll") for (int r = 0; r < 16; ++r) { C0[r] -= dl; C1[r] -= dl; } \
          const float f = EX(-dl); l_reg *= f; if (hi == 0) wsf[r32] = f; resc = true; } } \
    SBAR(); \
    float sacc = 0.f; u32x4 nw0, nw1, nw2, nw3; \
    _Pragma("unroll") for (int g = 0; g < 16; ++g) { \
        if (!(FIRST)) { const int ks_ = g >> 2, db_ = g & 3; \
            if (g + 4 < 16) { VRD(g + 4); } \
            const bf16x8 pa_ = (ks_ == 0) ? PAF(0) : (ks_ == 1) ? PAF(1) : (ks_ == 2) ? PAF(2) : PAF(3); \
            o[db_] = MFMA32(pa_, VFRG(vlo[g], vhi[g]), o[db_]); } \
        if (GL) { if (g >= 4 && g < 12) { kf[g - 4] = kld(kp0 + s_next * KSLOT + ((g - 4) >> 1) * 2048 + ((g - 4) & 1) * 512); } } \
        if (g < 8) { C0[2 * g] = EX(C0[2 * g]); C0[2 * g + 1] = EX(C0[2 * g + 1]); sacc += C0[2 * g]; sacc += C0[2 * g + 1]; } \
        else { C1[2 * g - 16] = EX(C1[2 * g - 16]); C1[2 * g - 15] = EX(C1[2 * g - 15]); sacc += C1[2 * g - 16]; sacc += C1[2 * g - 15]; } \
        if (g == 0) nw0[0] = PKW(C0, 0); if (g == 1) nw0[1] = PKW(C0, 2); if (g == 2) nw0[2] = PKW(C0, 4); if (g == 3) nw0[3] = PKW(C0, 6); \
        if (g == 4) nw1[0] = PKW(C0, 8); if (g == 5) nw1[1] = PKW(C0, 10); if (g == 6) nw1[2] = PKW(C0, 12); if (g == 7) nw1[3] = PKW(C0, 14); \
        if (g == 8) nw2[0] = PKW(C1, 0); if (g == 9) nw2[1] = PKW(C1, 2); if (g == 10) nw2[2] = PKW(C1, 4); if (g == 11) nw2[3] = PKW(C1, 6); \
        if (g == 12) nw3[0] = PKW(C1, 8); if (g == 13) nw3[1] = PKW(C1, 10); if (g == 14) nw3[2] = PKW(C1, 12); if (g == 15) nw3[3] = PKW(C1, 14); \
        PIN(sacc); SBAR(); } \
    l_reg += sacc; pw0 = nw0; pw1 = nw1; pw2 = nw2; pw3 = nw3; \
    } while (0)
    STEP(0, true, true, true, true); WAIT_BAR(3); RESC(); ROT();
    int s = 1;
    for (; s + 3 < n; ++s) { STEP(s, false, true, true, true); WAIT_BAR(3); RESC(); ROT(); }
    STEP(s, false, false, true, true); WAIT_BAR(2); RESC(); ROT(); ++s;
    STEP(s, false, false, true, true); WAIT_BAR(2); RESC(); ROT(); ++s;
    STEP(s, false, false, false, false); WAIT_BAR(0); RESC(); ROT();
    { const lds_cptr vp_ = vp0 + s_prev * VSLOT; s16x4 vlo[16], vhi[16];
#pragma unroll
      for (int g = 0; g < 16; ++g) VRD(g);
#pragma unroll
      for (int g = 0; g < 16; ++g) { const int ks_ = g >> 2, db_ = g & 3; const bf16x8 pa_ = (ks_ == 0) ? PAF(0) : (ks_ == 1) ? PAF(1) : (ks_ == 2) ? PAF(2) : PAF(3);
          o[db_] = MFMA32(pa_, VFRG(vlo[g], vhi[g]), o[db_]); } }
    { auto rr = __builtin_amdgcn_permlane32_swap(__float_as_uint(l_reg), __float_as_uint(l_reg), false, false); l_reg = __uint_as_float(rr[0]) + __uint_as_float(rr[1]); }
    if (hi == 0) wsf[32 + r32] = l_reg; asm volatile("s_waitcnt lgkmcnt(0)" ::: "memory");
    float rli[16];
#pragma unroll
    for (int r = 0; r < 16; ++r) rli[r] = __builtin_amdgcn_rcpf(wsf[32 + crow0(r) + 4 * hi]);
    bf16_t* Ow = AO + (rowbase + iw0) * PITCH + h * 128; __hip_bfloat16* stg = (__hip_bfloat16*)(lds + LDS_OST) + wid * 4096;
#pragma unroll
    for (int r = 0; r < 16; ++r) { const int orow = crow0(r) + 4 * hi;
#pragma unroll
        for (int db = 0; db < 4; ++db) stg[orow * 128 + db * 32 + r32] = __float2bfloat16(o[db][r] * rli[r]); }
    asm volatile("s_waitcnt lgkmcnt(0)" ::: "memory");
#pragma unroll
    for (int i = 0; i < 8; ++i) { const int row = i * 4 + (lane >> 4), ch = lane & 15; *(u32x4*)(Ow + (long)row * PITCH + ch * 8) = *(const u32x4*)(stg + row * 128 + ch * 8); }
    asm volatile("s_waitcnt lgkmcnt(0)\n\ts_barrier" ::: "memory");
#undef DMA_K
#undef DMA_V
#undef ROT
#undef EX
#undef RESC
#undef PKW
#undef PAF
#undef VFRG
#undef VRD
#undef STEP
}
#undef SBAR
#undef PIN
#undef MFMA32
#undef WAIT_BAR
#undef MX3
}
constexpr int NWAVES = 8;
constexpr int BATCH = 2, SEQ = 8192, DM = 1024, T = BATCH * SEQ, NEXP = 32, DEXP = 512;
constexpr float EPS = 1e-6f, LAM_INIT = 0.2f;
constexpr float C2 = 0.125f * 1.4426950408889634f;
constexpr float LOG2E = 1.4426950408889634f;
constexpr int ATT_THR = 8;

constexpr size_t MiB = 1u << 20;
constexpr size_t WS_CTL = 0, CTL_ZERO_BYTES = 65536;
constexpr size_t WS_LIST = 1 * MiB, WS_GLIST = 3 * MiB, WS_EPOS = 5 * MiB;
constexpr size_t WS_WIN = 6 * MiB, WS_WOUT = 10 * MiB, WS_WGU = 12 * MiB, WS_WD = 76 * MiB;
constexpr size_t WS_QKVU = 108 * MiB;
constexpr size_t WS_XN2 = 108 * MiB;
constexpr size_t WS_Y = 108 * MiB;
constexpr size_t WS_XN1 = 172 * MiB;
constexpr size_t WS_MIX = 172 * MiB;
constexpr size_t WS_AO = 204 * MiB;
constexpr size_t WS_HDN = 204 * MiB;
constexpr size_t WS_END = 244 * MiB;
constexpr int MAXROWS = 40960;
constexpr int CW_CNT = 64;
constexpr int CW_BAR = 4096;
constexpr int LDS_BYTES = 163840;
constexpr int MISC_OFF = LDS_BYTES - 256;
constexpr int MOE_TAB_OFF = 131072;
constexpr int RT_WR = 0, RT_SC = 148032, RT_SQ = 160320, RT_SR = 160576;

#define GAS __attribute__((address_space(1)))
#define LAS __attribute__((address_space(3)))
typedef unsigned short bf16;
typedef unsigned v4u __attribute__((ext_vector_type(4)));
typedef unsigned v2u __attribute__((ext_vector_type(2)));
typedef float f32x4 __attribute__((ext_vector_type(4)));
typedef GAS unsigned gu32;
#define RLX_AGENT __ATOMIC_RELAXED, __HIP_MEMORY_SCOPE_AGENT
#define LDS_WAIT() asm volatile("s_waitcnt lgkmcnt(0)" ::: "memory")
#define VM_WAIT() asm volatile("s_waitcnt vmcnt(0)" ::: "memory")
__device__ __forceinline__ unsigned f2bf(float f) { unsigned u = __builtin_bit_cast(unsigned, f); return (u + 0x7fffu + ((u >> 16) & 1u)) >> 16; }
__device__ __forceinline__ unsigned pk2(float lo, float hi) { return f2bf(lo) | (f2bf(hi) << 16); }
__device__ __forceinline__ float bflo(unsigned w) { return __uint_as_float(w << 16); }
__device__ __forceinline__ float bfhi(unsigned w) { return __uint_as_float(w & 0xffff0000u); }

#define XB_TMO      128
#define XB_XCNT(j)  (256  + 64 * (j))
#define XB_XSUB(j)  (1280 + 64 * (j))
#define XB_XGEN(j)  (2304 + 64 * (j))
#define XB_TOP      3328
#define XB_TOPGEN   3392
#define XCD_BAR_WORDS 3456
#define XB_SPIN_CAP (1u << 18)
__device__ __forceinline__ unsigned xb_ld(unsigned* p)              { return __hip_atomic_load(p, __ATOMIC_RELAXED, __HIP_MEMORY_SCOPE_AGENT); }
__device__ __forceinline__ unsigned xb_add(unsigned* p, unsigned v) { return __hip_atomic_fetch_add(p, v, __ATOMIC_RELAXED, __HIP_MEMORY_SCOPE_AGENT); }
__device__ __forceinline__ unsigned xb_xcc_id() { return (unsigned)__builtin_amdgcn_s_getreg((3 << 11) | 20) & 0xFu; }
#define XB_SPIN(cond, bar) do { unsigned _sp = 0; while (cond) { __builtin_amdgcn_s_sleep(1); \
    if ((++_sp & 255u) == 0u) { if (xb_ld(&(bar)[XB_TMO])) break; if (_sp > XB_SPIN_CAP) { atomicAdd(&(bar)[XB_TMO], 1u); break; } } } } while (0)
struct XcdBarrier { unsigned* bar; unsigned x; volatile LAS unsigned* st; };
__device__ __forceinline__ XcdBarrier xcd_barrier_post(unsigned* bar, volatile LAS unsigned* st) {
    XcdBarrier b; b.bar = bar; b.x = xb_xcc_id(); b.st = st;
    if (threadIdx.x == 0) (void)xb_add(&bar[XB_XCNT(b.x)], 1u);
    return b;
}
__device__ __forceinline__ void xcd_barrier_complete(unsigned* bar, unsigned x, unsigned& nloc, unsigned& nx) {
    const unsigned G = gridDim.x * gridDim.y * gridDim.z;
    unsigned sum, cnt, mine, sp = 0u;
    for (;;) {
        sum = 0u; cnt = 0u; mine = 0u;
#pragma unroll
        for (unsigned j = 0; j < 16; ++j) { const unsigned c = xb_ld(&bar[XB_XCNT(j)]); sum += c; cnt += (c > 0u) ? 1u : 0u; mine = (j == x) ? c : mine; }
        if (sum == G) break;
        __builtin_amdgcn_s_sleep(1);
        if ((++sp & 255u) == 0u) { if (xb_ld(&bar[XB_TMO])) break; if (sp > XB_SPIN_CAP) { atomicAdd(&bar[XB_TMO], 1u); break; } }
    }
    nloc = mine > 0u ? mine : 1u; nx = cnt > 0u ? cnt : 1u;
}
__device__ __forceinline__ void xcd_barrier(const XcdBarrier& b) {
    asm volatile("s_waitcnt vmcnt(0)" ::: "memory");
    __syncthreads();
    if (threadIdx.x == 0) {
        unsigned* bar = b.bar;
        __builtin_amdgcn_s_waitcnt(0);
        unsigned nloc = b.st[0], nx = b.st[1];
        if (nloc == 0u) { xcd_barrier_complete(bar, b.x, nloc, nx); b.st[0] = nloc; b.st[1] = nx; }
        const unsigned old = xb_add(&bar[XB_XSUB(b.x)], 1u);
        const unsigned gen = old / nloc;
        if (old + 1u == (gen + 1u) * nloc) {
            __builtin_amdgcn_fence(__ATOMIC_RELEASE, "agent");
            asm volatile("s_waitcnt vmcnt(0)" ::: "memory");
            const unsigned og = xb_add(&bar[XB_TOP], 1u);
            const unsigned tg = og / nx;
            if (og + 1u == (tg + 1u) * nx) xb_add(&bar[XB_TOPGEN], 1u);
            else XB_SPIN(xb_ld(&bar[XB_TOPGEN]) == tg, bar);
            __builtin_amdgcn_fence(__ATOMIC_ACQUIRE, "agent");
            xb_add(&bar[XB_XGEN(b.x)], 1u);
            asm volatile("s_waitcnt vmcnt(0)" ::: "memory");
        } else {
            XB_SPIN(xb_ld(&bar[XB_XGEN(b.x)]) == gen, bar);
            __builtin_amdgcn_fence(__ATOMIC_ACQUIRE, "agent");
            asm volatile("s_waitcnt vmcnt(0)" ::: "memory");
        }
    }
    __syncthreads();
}

__device__ __forceinline__ float wave_sum(float v) {
#pragma unroll
    for (int o = 1; o < 64; o <<= 1) v += __shfl_xor(v, o);
    return v;
}
__device__ __forceinline__ void transpose_item(const float* W, int ldw, int k0, int n0, bf16* WT, size_t opitch, int orow, int ocol, LAS float* scr, int lane) {
#pragma unroll 8
    for (int i = 0; i < 32; ++i) { const int kk = 2 * i + (lane >> 5); scr[kk * 33 + (lane & 31)] = W[(size_t)(k0 + kk) * ldw + n0 + (lane & 31)]; }
    LDS_WAIT(); asm volatile("" ::: "memory");
    const int c = lane & 7;
#pragma unroll
    for (int j = 0; j < 4; ++j) { const int n = (lane >> 3) + 8 * j; const LAS float* s = scr + (8 * c) * 33 + n;
        v4u o; o.x = pk2(s[0 * 33], s[1 * 33]); o.y = pk2(s[2 * 33], s[3 * 33]); o.z = pk2(s[4 * 33], s[5 * 33]); o.w = pk2(s[6 * 33], s[7 * 33]);
        *(GAS v4u*)(WT + (size_t)(orow + n) * opitch + ocol + 8 * c) = o; }
    LDS_WAIT(); asm volatile("" ::: "memory");
}
__device__ __forceinline__ void rms_row_to_bf16(const float* xrow, const float* g, bf16* orow, int lane) {
    const GAS f32x4* xr = (const GAS f32x4*)xrow + lane; const GAS f32x4* gr = (const GAS f32x4*)g + lane;
    f32x4 v[4]; float s = 0.f;
#pragma unroll
    for (int j = 0; j < 4; ++j) { v[j] = xr[64 * j]; s += (v[j].x * v[j].x + v[j].y * v[j].y) + (v[j].z * v[j].z + v[j].w * v[j].w); }
    const float rstd = 1.0f / sqrtf(wave_sum(s) * (1.f / DM) + EPS);
    GAS v2u* o8 = (GAS v2u*)orow + lane;
#pragma unroll
    for (int j = 0; j < 4; ++j) { const f32x4 gg = gr[64 * j]; v2u w; w.x = pk2(v[j].x * rstd * gg.x, v[j].y * rstd * gg.y); w.y = pk2(v[j].z * rstd * gg.z, v[j].w * rstd * gg.w); o8[64 * j] = w; }
}

struct Args { const float* in[20]; float* out; unsigned char* ws; int ph_lo, ph_hi; };

__global__ void __launch_bounds__(NWAVES * 64, 2) mk_fwd(Args args) {
    extern __shared__ __attribute__((aligned(16))) unsigned char lds[];
    LAS unsigned char* L = (LAS unsigned char*)lds;
    volatile LAS unsigned* MISC = (volatile LAS unsigned*)(L + MISC_OFF);
    const int tid = threadIdx.x, lane = tid & 63, wave = __builtin_amdgcn_readfirstlane(tid >> 6);
    const int G = gridDim.x; const int bx = blockIdx.x; const int vcu = (G % 8 == 0) ? (bx % 8) * (G / 8) + bx / 8 : bx;
    unsigned char* ws = args.ws;
    gu32* ctl = (gu32*)(ws + WS_CTL);
    const float* x = args.in[0]; const float* n1g = args.in[1]; const float* w_in = args.in[2];
    const float* lq1 = args.in[3]; const float* lk1 = args.in[4]; const float* lq2 = args.in[5]; const float* lk2 = args.in[6];
    const float* subg = args.in[7]; const float* wpool = args.in[8]; const float* pscale = args.in[9]; const float* w_out = args.in[10];
    const float* n2g = args.in[11]; const float* wgr = args.in[12]; const float* bgr = args.in[13]; const float* wer = args.in[14];
    const float* ber = args.in[15]; const float* wgate = args.in[16]; const float* wup = args.in[17]; const float* wdown = args.in[18]; const float* fing = args.in[19];
    float* out = args.out;
    bf16* Win_t = (bf16*)(ws + WS_WIN); bf16* Wout_t = (bf16*)(ws + WS_WOUT); bf16* Wgu_t = (bf16*)(ws + WS_WGU); bf16* Wd_t = (bf16*)(ws + WS_WD);
    bf16* QKVU = (bf16*)(ws + WS_QKVU); bf16* XN1 = (bf16*)(ws + WS_XN1); bf16* MIX = (bf16*)(ws + WS_MIX); bf16* AO = (bf16*)(ws + WS_AO);
    bf16* XN2 = (bf16*)(ws + WS_XN2); bf16* HDN = (bf16*)(ws + WS_HDN); bf16* Y = (bf16*)(ws + WS_Y);
    int* list = (int*)(ws + WS_LIST); float* glist = (float*)(ws + WS_GLIST); int* epos = (int*)(ws + WS_EPOS);
    for (int u = tid; u < 64; u += NWAVES * 64) ((LAS unsigned*)(L + MISC_OFF))[u] = 0u;
    __syncthreads();
    XcdBarrier bar = xcd_barrier_post((unsigned*)(ctl + CW_BAR), MISC + 8);
    const int lo = args.ph_lo, hi = args.ph_hi;
#define IN(k) (lo <= (k) && (k) < hi)
#define SEAM(k) do { if (IN(k) && IN((k) + 1)) xcd_barrier(bar); } while (0)
    const int gw = vcu * NWAVES + wave, NGW = G * NWAVES;

    if (IN(0)) {
        LAS float* scr = (LAS float*)(L + wave * 16384);
        constexpr int I_WIN = 16 * 64, I_WO = 8 * 32, I_G = 16 * 16, I_D = 8 * 32;
        constexpr int NITEMS = I_WIN + I_WO + NEXP * (2 * I_G + I_D);
        for (int it = gw; it < NITEMS; it += NGW) {
            int r = it;
            if (r < I_WIN) { const int kb = r / 64, nb = r % 64; transpose_item(w_in, 2048, 64 * kb, 32 * nb, Win_t, 1024, 32 * nb, 64 * kb, scr, lane); continue; } r -= I_WIN;
            if (r < I_WO) { const int kb = r / 32, nb = r % 32; transpose_item(w_out, 1024, 64 * kb, 32 * nb, Wout_t, 1024, 32 * nb, 64 * kb, scr, lane); continue; } r -= I_WO;
            const int e = r / (2 * I_G + I_D); r -= e * (2 * I_G + I_D);
            if (r < 2 * I_G) { const int up = r / I_G; r -= up * I_G; const int kb = r / 16, nb = r % 16, n0 = 32 * nb;
                transpose_item((up ? wup : wgate) + (size_t)e * 1024 * 512, 512, 64 * kb, n0, Wgu_t + (size_t)e * 1024 * 1024, 1024, (n0 >> 7) * 256 + 128 * up + (n0 & 127), 64 * kb, scr, lane); continue; }
            r -= 2 * I_G;
            { const int kb = r / 32, nb = r % 32; transpose_item(wdown + (size_t)e * 512 * 1024, 1024, 64 * kb, 32 * nb, Wd_t + (size_t)e * 1024 * 512, 512, 32 * nb, 64 * kb, scr, lane); }
        }
        for (int idx = (vcu * NWAVES * 64 + tid); idx < 512 * 1024; idx += G * NWAVES * 64) {
            const int kk = idx >> 10, nn = idx & 1023, g = kk >> 7; float acc = 0.f;
            const float* wp = wpool + (size_t)kk * 128; const float* ps = pscale + g * 128; const float* wo = w_out + (size_t)(512 + g * 128) * 1024 + nn;
#pragma unroll 8
            for (int dd = 0; dd < 128; ++dd) acc = __builtin_fmaf(wp[dd] * ps[dd], wo[(size_t)dd * 1024], acc);
            Wout_t[(size_t)nn * 1024 + 512 + kk] = (bf16)f2bf(acc);
        }
        for (int m = gw; m < T; m += NGW) rms_row_to_bf16(x + (size_t)m * DM, n1g, XN1 + (size_t)m * DM, lane);
    }
    SEAM(0);
    if (IN(1)) {
        pg8::Gemm g{XN1, Win_t, T, 2048, DM}; pg8::StaticOrder S; S.init(g, G, bx);
        pg8::EpiBf16 E{QKVU, 512, 512, (size_t)T * 512, C2};
        pg8::gemm_phase<pg8::EpiBf16, pg8::StaticOrder, false>(L, DM, S, E);
    }
    SEAM(1);
    if (IN(2)) {
        const int bh = vcu >> 5, qb = vcu & 31, b = bh >> 2, h = bh & 3;
        const float slope = exp2f(-2.0f * (float)(h + 1)), sg2 = slope * LOG2E;
        if (vcu < 256) {
            for (int c = 0; c < 2; ++c)
                attn::attn_unit<ATT_THR>(b, h, c, qb, 0, attn::NTILE - 1, sg2, QKVU, QKVU + (size_t)T * 512, QKVU + (size_t)2 * T * 512, AO + (size_t)c * T * 512, (char*)lds);
        }
    }
    SEAM(2);
    if (IN(3)) {
        float s1 = wave_sum(lq1[lane] * lk1[lane]), s2 = wave_sum(lq2[lane] * lk2[lane]);
        const float lam = expf(s1) - expf(s2) + LAM_INIT;
        const bf16* U = QKVU + (size_t)3 * T * 512;
        float sg[8];
#pragma unroll
        for (int j = 0; j < 8; ++j) sg[j] = subg[(8 * lane + j) & 127] * (1.0f - LAM_INIT);
        for (int t = gw; t < T; t += NGW) {
            const v4u a1 = *(const GAS v4u*)(AO + (size_t)t * 512 + 8 * lane), a2 = *(const GAS v4u*)(AO + (size_t)(T + t) * 512 + 8 * lane);
            float a[8];
#pragma unroll
            for (int j = 0; j < 4; ++j) { a[2 * j] = bflo(a1[j]) - lam * bflo(a2[j]); a[2 * j + 1] = bfhi(a1[j]) - lam * bfhi(a2[j]); }
            float ss = 0.f;
#pragma unroll
            for (int j = 0; j < 8; ++j) ss += a[j] * a[j];
            ss += __shfl_xor(ss, 1); ss += __shfl_xor(ss, 2); ss += __shfl_xor(ss, 4); ss += __shfl_xor(ss, 8);
            const float r = 1.0f / sqrtf(ss * (1.0f / 128.0f) + EPS);
            v4u o; o.x = pk2(a[0] * r * sg[0], a[1] * r * sg[1]); o.y = pk2(a[2] * r * sg[2], a[3] * r * sg[3]); o.z = pk2(a[4] * r * sg[4], a[5] * r * sg[5]); o.w = pk2(a[6] * r * sg[6], a[7] * r * sg[7]);
            *(GAS v4u*)(MIX + (size_t)t * 1024 + 8 * lane) = o;
            const int tt = t & (SEQ - 1), tb = t - tt, hw = 1 << (lane >> 4); int jlo = tt - hw, jhi = tt + hw; jlo = jlo < 0 ? 0 : jlo; jhi = jhi > SEQ ? SEQ : jhi;
            float sm[8] = {0.f, 0.f, 0.f, 0.f, 0.f, 0.f, 0.f, 0.f}; v4u ut = {0u, 0u, 0u, 0u};
            for (int k = 0; k < 16; ++k) { const int j = tt - 8 + k;
                if (j >= jlo && j < jhi) { const v4u uu = *(const GAS v4u*)(U + (size_t)(tb + j) * 512 + 8 * lane);
#pragma unroll
                    for (int q = 0; q < 4; ++q) { sm[2 * q] += bflo(uu[q]); sm[2 * q + 1] += bfhi(uu[q]); }
                    if (j == tt) ut = uu; } }
            const float ic = 1.0f / (float)(jhi - jlo);
            v4u d; d.x = pk2(sm[0] * ic - bflo(ut[0]), sm[1] * ic - bfhi(ut[0])); d.y = pk2(sm[2] * ic - bflo(ut[1]), sm[3] * ic - bfhi(ut[1]));
            d.z = pk2(sm[4] * ic - bflo(ut[2]), sm[5] * ic - bfhi(ut[2])); d.w = pk2(sm[6] * ic - bflo(ut[3]), sm[7] * ic - bfhi(ut[3]));
            *(GAS v4u*)(MIX + (size_t)t * 1024 + 512 + 8 * lane) = d;
        }
    }
    SEAM(3);
    if (IN(4)) {
        pg8::Gemm g{MIX, Wout_t, T, DM, DM}; pg8::StaticOrder S; S.init(g, G, bx);
        pg8::EpiResF32 E{x, out, DM};
        pg8::gemm_phase<pg8::EpiResF32, pg8::StaticOrder, false>(L, DM, S, E);
    }
    SEAM(4);
    if (IN(5)) {
        LAS float* WR = (LAS float*)(L + RT_WR); LAS float* SC = (LAS float*)(L + RT_SC); LAS float* SQ = (LAS float*)(L + RT_SQ); LAS float* SR = (LAS float*)(L + RT_SR);
        for (int idx = tid; idx < 1024 * 4; idx += NWAVES * 64) { const int k = idx >> 2, n = idx & 3; WR[n * 1028 + k] = wgr[idx] * n2g[k]; }
        for (int idx = tid; idx < 1024 * 32; idx += NWAVES * 64) { const int k = idx >> 5, n = idx & 31; WR[(4 + n) * 1028 + k] = wer[idx] * n2g[k]; }
        __syncthreads();
        const int gq = wave & 3, kh = wave >> 2, tk = lane & 15, kq = lane >> 4;
        for (int tb = vcu * 64; tb < T; tb += G * 64) {
            const float* hrow = out + (size_t)(tb + 16 * gq + tk) * DM + 512 * kh + 4 * kq;
            f32x4 acc[3] = {{0.f, 0.f, 0.f, 0.f}, {0.f, 0.f, 0.f, 0.f}, {0.f, 0.f, 0.f, 0.f}}; float ssq = 0.f;
            int nn[3];
#pragma unroll
            for (int nb = 0; nb < 3; ++nb) { const int n = 16 * nb + tk; nn[nb] = (n < 36 ? n : 35) * 1028 + 512 * kh + 4 * kq; }
#pragma unroll 4
            for (int s = 0; s < 32; ++s) {
                const f32x4 hv = *(const GAS f32x4*)(hrow + 16 * s);
                ssq += (hv.x * hv.x + hv.y * hv.y) + (hv.z * hv.z + hv.w * hv.w);
#pragma unroll
                for (int nb = 0; nb < 3; ++nb) { const f32x4 bv = *(const LAS f32x4*)(WR + nn[nb] + 16 * s);
                    acc[nb] = __builtin_amdgcn_mfma_f32_16x16x4f32(hv.x, bv.x, acc[nb], 0, 0, 0); acc[nb] = __builtin_amdgcn_mfma_f32_16x16x4f32(hv.y, bv.y, acc[nb], 0, 0, 0);
                    acc[nb] = __builtin_amdgcn_mfma_f32_16x16x4f32(hv.z, bv.z, acc[nb], 0, 0, 0); acc[nb] = __builtin_amdgcn_mfma_f32_16x16x4f32(hv.w, bv.w, acc[nb], 0, 0, 0); }
            }
            ssq += __shfl_xor(ssq, 16); ssq += __shfl_xor(ssq, 32);
            if (kh == 1) {
#pragma unroll
                for (int nb = 0; nb < 3; ++nb)
#pragma unroll
                    for (int r = 0; r < 4; ++r) SC[gq * 768 + (nb * 4 + r) * 64 + lane] = acc[nb][r];
                if (kq == 0) SQ[gq * 16 + tk] = ssq;
            }
            __syncthreads();
            if (kh == 0) {
#pragma unroll
                for (int nb = 0; nb < 3; ++nb)
#pragma unroll
                    for (int r = 0; r < 4; ++r) acc[nb][r] += SC[gq * 768 + (nb * 4 + r) * 64 + lane];
                const float sq2 = ssq + SQ[gq * 16 + tk];
                LDS_WAIT(); asm volatile("" ::: "memory");
#pragma unroll
                for (int nb = 0; nb < 3; ++nb)
#pragma unroll
                    for (int r = 0; r < 4; ++r) SC[gq * 768 + (4 * kq + r) * 48 + 16 * nb + tk] = acc[nb][r];
                LDS_WAIT(); asm volatile("" ::: "memory");
                if (lane < 16) {
                    const int t = tb + 16 * gq + lane; const float rstd = 1.0f / sqrtf(sq2 * (1.0f / DM) + EPS);
                    SR[gq * 16 + lane] = rstd;
                    const LAS float* lg = SC + gq * 768 + lane * 48;
                    float gl[4];
#pragma unroll
                    for (int g = 0; g < 4; ++g) gl[g] = lg[g] * rstd + bgr[g];
                    int gs = 0; float gm = gl[0];
#pragma unroll
                    for (int g = 1; g < 4; ++g) if (gl[g] > gm) { gm = gl[g]; gs = g; }
                    float den = 0.f;
#pragma unroll
                    for (int g = 0; g < 4; ++g) den += expf(gl[g] - gm);
                    const float pg = 1.0f / den;
                    float e8[8];
#pragma unroll
                    for (int i = 0; i < 8; ++i) e8[i] = lg[4 + gs * 8 + i] * rstd + ber[gs * 8 + i];
                    float v1 = e8[0]; int i1 = 0;
#pragma unroll
                    for (int i = 1; i < 8; ++i) if (e8[i] > v1) { v1 = e8[i]; i1 = i; }
                    float v2 = -3.0e38f; int i2 = 0;
#pragma unroll
                    for (int i = 0; i < 8; ++i) if (i != i1 && e8[i] > v2) { v2 = e8[i]; i2 = i; }
                    const float p2 = expf(v2 - v1), g1 = pg / (1.0f + p2), g2 = pg * p2 / (1.0f + p2);
                    const int ea = gs * 8 + i1, eb = gs * 8 + i2;
                    const int pa = (int)atomicAdd((unsigned*)(ctl + CW_CNT + ea), 1u), pb = (int)atomicAdd((unsigned*)(ctl + CW_CNT + eb), 1u);
                    list[(size_t)ea * 16384 + pa] = t; glist[(size_t)ea * 16384 + pa] = g1; list[(size_t)eb * 16384 + pb] = t; glist[(size_t)eb * 16384 + pb] = g2;
                    epos[t * 2] = (ea << 16) | pa; epos[t * 2 + 1] = (eb << 16) | pb;
                }
            }
            __syncthreads();
            for (int q = 0; q < 8; ++q) { const int tl = 8 * wave + q, t = tb + tl; const float rstd = SR[tl];
                const GAS f32x4* hr = (const GAS f32x4*)(out + (size_t)t * DM) + lane; const GAS f32x4* gr = (const GAS f32x4*)n2g + lane; GAS v2u* o8 = (GAS v2u*)(XN2 + (size_t)t * DM) + lane;
#pragma unroll
                for (int j = 0; j < 4; ++j) { const f32x4 v = hr[64 * j], gg = gr[64 * j]; v2u w; w.x = pk2(v.x * rstd * gg.x, v.y * rstd * gg.y); w.y = pk2(v.z * rstd * gg.z, v.w * rstd * gg.w); o8[64 * j] = w; } }
            __syncthreads();
        }
    }
    SEAM(5);
    LAS int* tstart = (LAS int*)(L + MOE_TAB_OFF); LAS int* ecnt = (LAS int*)(L + MOE_TAB_OFF + 256);
    if (IN(6) || IN(7) || IN(8)) {
        if (tid < 32) ecnt[tid] = (int)__hip_atomic_load(ctl + CW_CNT + tid, RLX_AGENT);
        __syncthreads();
        if (tid == 0) { int a = 0; for (int e = 0; e < 32; ++e) { tstart[e] = a; a += (ecnt[e] + 255) >> 8; } tstart[32] = a; }
        __syncthreads();
    }
    if (IN(6)) {
        pg8::MoeOrder<true> S; S.tstart = tstart; S.cnt = ecnt; S.ntiles = tstart[32]; S.G = G; S.c = vcu; S.A = XN2; S.Bt = Wgu_t; S.a_tstep = 0; S.b_estep = (size_t)1024 * 1024 * 2; S.b_tstep = (size_t)256 * 1024 * 2; S.list = list; S.Kb = 2048;
        pg8::EpiSwiGLU E{HDN};
        pg8::gemm_phase<pg8::EpiSwiGLU, pg8::MoeOrder<true>, true>(L, DM, S, E);
    }
    SEAM(6);
    if (IN(7)) {
        pg8::MoeOrder<false> S; S.tstart = tstart; S.cnt = ecnt; S.ntiles = tstart[32]; S.G = G; S.c = vcu; S.A = HDN; S.Bt = Wd_t; S.a_tstep = (size_t)256 * 512 * 2; S.b_estep = (size_t)1024 * 512 * 2; S.b_tstep = (size_t)256 * 512 * 2; S.list = list; S.Kb = 1024;
        pg8::EpiGateBf16 E{Y, glist};
        pg8::gemm_phase<pg8::EpiGateBf16, pg8::MoeOrder<false>, false>(L, DEXP, S, E);
    }
    SEAM(7);
    if (IN(8)) {
        for (int t = gw; t < T; t += NGW) {
            const int pa = epos[t * 2], pb = epos[t * 2 + 1];
            const size_t ra = (size_t)tstart[pa >> 16] * 256 + (pa & 0xffff), rb = (size_t)tstart[pb >> 16] * 256 + (pb & 0xffff);
            const GAS f32x4* hr = (const GAS f32x4*)(out + (size_t)t * DM) + lane; const GAS v2u* ya = (const GAS v2u*)(Y + ra * 1024) + lane; const GAS v2u* yb = (const GAS v2u*)(Y + rb * 1024) + lane;
            f32x4 v[4]; float s = 0.f;
#pragma unroll
            for (int j = 0; j < 4; ++j) { v[j] = hr[64 * j]; const v2u a = ya[64 * j], bq = yb[64 * j];
                v[j].x += bflo(a.x) + bflo(bq.x); v[j].y += bfhi(a.x) + bfhi(bq.x); v[j].z += bflo(a.y) + bflo(bq.y); v[j].w += bfhi(a.y) + bfhi(bq.y);
                s += (v[j].x * v[j].x + v[j].y * v[j].y) + (v[j].z * v[j].z + v[j].w * v[j].w); }
            const float rstd = 1.0f / sqrtf(wave_sum(s) * (1.f / DM) + EPS);
            const GAS f32x4* gr = (const GAS f32x4*)fing + lane; GAS f32x4* orow = (GAS f32x4*)(out + (size_t)t * DM) + lane;
#pragma unroll
            for (int j = 0; j < 4; ++j) { const f32x4 gg = gr[64 * j]; orow[64 * j] = v[j] * rstd * gg; }
        }
    }
#undef IN
#undef SEAM
}

extern "C" void kernel_launch(void* const* d_in, const int* in_sizes, int n_in, void* d_out, int out_size, void* d_ws, size_t ws_size, hipStream_t stream) {
    static int grid = 0;
    if (grid == 0) {
        if (n_in != 20 || in_sizes[0] != T * DM || out_size != T * DM || ws_size < WS_END) { fprintf(stderr, "kernel_launch: unexpected shapes: n_in %d in0 %d out %d ws %zu; nothing launched\n", n_in, n_in > 0 ? in_sizes[0] : -1, out_size, ws_size); grid = -1; return; }
        int dev = 0, cus = 0;
        if (hipGetDevice(&dev) != hipSuccess || hipDeviceGetAttribute(&cus, hipDeviceAttributeMultiprocessorCount, dev) != hipSuccess) { grid = -1; return; }
        if (hipFuncSetAttribute((const void*)mk_fwd, hipFuncAttributeMaxDynamicSharedMemorySize, LDS_BYTES) != hipSuccess) { fprintf(stderr, "kernel_launch: hipFuncSetAttribute failed\n"); grid = -1; return; }
        (void)hipGetLastError();
        grid = cus;
    }
    if (grid < 0) return;
    (void)hipMemsetAsync((char*)d_ws + WS_CTL, 0, CTL_ZERO_BYTES, stream);
    Args a{};
    for (int i = 0; i < 20; ++i) a.in[i] = (const float*)d_in[i];
    a.out = (float*)d_out; a.ws = (unsigned char*)d_ws;
#ifndef MK_N_LAUNCHES
#define MK_N_LAUNCHES 1
#endif
    constexpr int NPH = 9;
    if (MK_N_LAUNCHES == 1) { a.ph_lo = 0; a.ph_hi = NPH; hipLaunchKernelGGL(mk_fwd, dim3(grid), dim3(NWAVES * 64), LDS_BYTES, stream, a); }
    else for (int p = 0; p < NPH; ++p) { a.ph_lo = p; a.ph_hi = p + 1; hipLaunchKernelGGL(mk_fwd, dim3(grid), dim3(NWAVES * 64), LDS_BYTES, stream, a); }
}
```

```cpp
#include <hip/hip_runtime.h>
#include <hip/hip_bf16.h>
#include <cstdio>
#include <cstdint>
#include <cmath>
namespace pg8 {
#define PG8_LAS __attribute__((address_space(3)))
typedef unsigned short bf16_t;
typedef short bf16x8 __attribute__((ext_vector_type(8)));
typedef float f32x4 __attribute__((ext_vector_type(4)));
typedef float f32x2 __attribute__((ext_vector_type(2)));
typedef unsigned u32x4 __attribute__((ext_vector_type(4)));
constexpr int BM = 256, BK = 64, HALF = 128, HTB = HALF * BK * 2  , STAGE_BYTES = 8 * HTB, NXCD = 8, WGM = 8;

__host__ __device__ __forceinline__ int lds_byte(int r, int c) { const int st = (r >> 4) * 2 + (c >> 5), rr = r & 15, cc = c & 31, ob = rr * 64 + cc * 2; return st * 1024 + (ob ^ (((ob >> 9) & 1) << 5)); }
__host__ __device__ __forceinline__ void stage_rc(int b, int& R, int& C) { const int st = b / 1024, sb = b % 1024, swz = sb ^ (((sb >> 9) & 1) << 5); R = (st >> 1) * 16 + swz / 64; C = (st & 1) * 32 + (swz % 64) / 2; }
__host__ __device__ __forceinline__ int perm32(int rho) { const int n = rho >> 4, i = rho & 15; return 8 * (i >> 2) + 4 * n + (i & 3); }

struct Unit { int pm, pn, e, lt, cnt; };
struct Gemm { const bf16_t* A; const bf16_t* Bt; int M, N, K; };

struct StaticOrder {
    int nM, nN, nwg, G, c; const bf16_t* A; const bf16_t* Bt; size_t tstep;
    __device__ void init(const Gemm& g, int G_, int c_) { nM = g.M / BM; nN = g.N / BM; nwg = nM * nN; G = G_; c = c_; A = g.A; Bt = g.Bt; tstep = (size_t)BM * g.K * 2; }
    __device__ bool next(int i, Unit& u) const {
        const long L = (long)i * G + c; if (L >= nwg) return false;
        int wgid = (int)L; { const int q = nwg / NXCD, r = nwg % NXCD, xcd = wgid % NXCD, off = wgid / NXCD; wgid = (xcd < r ? xcd * (q + 1) : r * (q + 1) + (xcd - r) * q) + off; }
        const int nig = WGM * nN, gid = wgid / nig, fm = gid * WGM, gsz = (nM - fm) < WGM ? (nM - fm) : WGM;
        u.pm = fm + ((wgid % nig) % gsz); u.pn = (wgid % nig) / gsz; u.e = 0; u.lt = 0; u.cnt = 0; return true;
    }
    __device__ __forceinline__ const char* a_base(const Unit& u) const { return (const char*)A + (size_t)u.pm * tstep; }
    __device__ __forceinline__ const char* b_base(const Unit& u) const { return (const char*)Bt + (size_t)u.pn * tstep; }
    __device__ __forceinline__ unsigned row_off(const Unit&, int) const { return 0u; }
};
template <bool GATHER> struct MoeOrder {
    const PG8_LAS int* tstart; const PG8_LAS int* cnt; int ntiles, G, c;
    const bf16_t* A; const bf16_t* Bt; size_t a_tstep, b_estep, b_tstep; const int* list; int Kb  ;
    __device__ bool next(int i, Unit& u) const {
        const long L = (long)i * G + c; if (L >= 4L * ntiles) return false;
        const int rt = (int)(L >> 2); u.pn = (int)(L & 3); u.pm = rt;
        int e = 0;
#pragma unroll
        for (int k = 1; k < 32; ++k) e += (rt >= tstart[k]) ? 1 : 0;
        e = __builtin_amdgcn_readfirstlane(e);
        u.e = e; u.lt = __builtin_amdgcn_readfirstlane(rt - tstart[e]); u.cnt = __builtin_amdgcn_readfirstlane(cnt[e]); return true;
    }
    __device__ __forceinline__ const char* a_base(const Unit& u) const { return GATHER ? (const char*)A : (const char*)A + (size_t)u.pm * a_tstep; }
    __device__ __forceinline__ const char* b_base(const Unit& u) const { return (const char*)Bt + (size_t)u.e * b_estep + (size_t)u.pn * b_tstep; }
    __device__ __forceinline__ unsigned row_off(const Unit& u, int R) const { const int pos = u.lt * BM + R; const int tok = (pos < u.cnt) ? list[(size_t)u.e * 16384 + pos] : 0; return (unsigned)tok * (unsigned)Kb; }
};

__device__ __forceinline__ unsigned cvt_pk_bf16(float lo, float hi) { unsigned r; asm volatile("v_cvt_pk_bf16_f32 %0, %1, %2" : "=v"(r) : "v"(lo), "v"(hi)); return r; }

struct EpiBf16 {
    static constexpr bool PERM = true;
    bf16_t* O; int ldc; int split_cols; size_t split_stride; float scale0;
    __device__ __forceinline__ void operator()(const f32x4 (&acc)[2][2][4][2], const Unit& u, int wr, int wc, int fr, int fq) const {
        const int row0 = u.pm * BM + wr * 64 + fr; int colt = u.pn * BM; bf16_t* base = O;
        float sc = 1.f; if (split_cols) { const int t = colt / split_cols; base += (size_t)t * split_stride; colt -= t * split_cols; if (t == 0) sc = scale0; }
        const int col0 = colt + wc * 32 + 8 * fq;
#pragma unroll
        for (int ai = 0; ai < 2; ++ai)
#pragma unroll
            for (int m = 0; m < 4; ++m) { bf16_t* rowp = base + (size_t)(row0 + ai * HALF + m * 16) * ldc + col0;
#pragma unroll
                for (int bj = 0; bj < 2; ++bj) { f32x4 v0 = acc[ai][bj][m][0] * sc, v1 = acc[ai][bj][m][1] * sc;
                    u32x4 w; w.x = cvt_pk_bf16(v0[0], v0[1]); w.y = cvt_pk_bf16(v0[2], v0[3]); w.z = cvt_pk_bf16(v1[0], v1[1]); w.w = cvt_pk_bf16(v1[2], v1[3]);
                    *(u32x4*)(rowp + bj * HALF) = w; } }
    }
};
struct EpiResF32 {
    static constexpr bool PERM = false;
    const float* base; float* out; int ldc;
    __device__ __forceinline__ void operator()(const f32x4 (&acc)[2][2][4][2], const Unit& u, int wr, int wc, int fr, int fq) const {
        const int col0 = u.pn * BM + wc * 32 + 4 * fq;
#pragma unroll
        for (int ai = 0; ai < 2; ++ai)
#pragma unroll
            for (int m = 0; m < 4; ++m) { const size_t off = (size_t)(u.pm * BM + ai * HALF + wr * 64 + m * 16 + fr) * ldc + col0;
#pragma unroll
                for (int bj = 0; bj < 2; ++bj)
#pragma unroll
                    for (int n = 0; n < 2; ++n) { const f32x4 bs = *(const f32x4*)(base + off + bj * HALF + n * 16); *(f32x4*)(out + off + bj * HALF + n * 16) = bs + acc[ai][bj][m][n]; } }
    }
};
struct EpiSwiGLU {
    static constexpr bool PERM = true;
    bf16_t* O;
    __device__ __forceinline__ void operator()(const f32x4 (&acc)[2][2][4][2], const Unit& u, int wr, int wc, int fr, int fq) const {
        const int row0 = u.pm * BM + wr * 64 + fr, col0 = u.pn * HALF + wc * 32 + 8 * fq;
#pragma unroll
        for (int ai = 0; ai < 2; ++ai)
#pragma unroll
            for (int m = 0; m < 4; ++m) { float hv[8];
#pragma unroll
                for (int n = 0; n < 2; ++n)
#pragma unroll
                    for (int j = 0; j < 4; ++j) { const float g = acc[ai][0][m][n][j], up = acc[ai][1][m][n][j];
                        const float sg = __builtin_amdgcn_rcpf(1.0f + __builtin_amdgcn_exp2f(-1.4426950408889634f * g)); hv[n * 4 + j] = g * sg * up; }
                u32x4 w; w.x = cvt_pk_bf16(hv[0], hv[1]); w.y = cvt_pk_bf16(hv[2], hv[3]); w.z = cvt_pk_bf16(hv[4], hv[5]); w.w = cvt_pk_bf16(hv[6], hv[7]);
                *(u32x4*)(O + (size_t)(row0 + ai * HALF + m * 16) * 512 + col0) = w; }
    }
};
struct EpiGateBf16 {
    static constexpr bool PERM = true;
    bf16_t* O; const float* glist;
    __device__ __forceinline__ void operator()(const f32x4 (&acc)[2][2][4][2], const Unit& u, int wr, int wc, int fr, int fq) const {
        const int col0 = u.pn * BM + wc * 32 + 8 * fq;
#pragma unroll
        for (int ai = 0; ai < 2; ++ai)
#pragma unroll
            for (int m = 0; m < 4; ++m) { const int R = ai * HALF + wr * 64 + m * 16 + fr, pos = u.lt * BM + R; const float gt = (pos < u.cnt) ? glist[(size_t)u.e * 16384 + pos] : 0.f;
                bf16_t* rowp = O + (size_t)(u.pm * BM + R) * 1024 + col0;
#pragma unroll
                for (int bj = 0; bj < 2; ++bj) { f32x4 v0 = acc[ai][bj][m][0] * gt, v1 = acc[ai][bj][m][1] * gt;
                    u32x4 w; w.x = cvt_pk_bf16(v0[0], v0[1]); w.y = cvt_pk_bf16(v0[2], v0[3]); w.z = cvt_pk_bf16(v1[0], v1[1]); w.w = cvt_pk_bf16(v1[2], v1[3]);
                    *(u32x4*)(rowp + bj * HALF) = w; } }
    }
};

template <class Epi, class Sched, bool GATHER>
__device__ __forceinline__ void gemm_phase(PG8_LAS unsigned char* lds, const int K, const Sched& S, const Epi& E) {
    const int tid = threadIdx.x, wid = __builtin_amdgcn_readfirstlane(tid >> 6), lane = tid & 63, wr = wid >> 2, wc = wid & 3, fr = lane & 15, fq = lane >> 4;
    const int nt = K / BK;
    unsigned voffA[2], voffB[2]; int rowA[2];
#pragma unroll
    for (int i = 0; i < 2; ++i) { int R, C; stage_rc(tid * 16 + i * 8192, R, C); const int Rb = Epi::PERM ? ((R & ~31) + perm32(R & 31)) : R;
        rowA[i] = R; voffA[i] = GATHER ? (unsigned)C * 2u : (unsigned)(R * K + C) * 2u; voffB[i] = (unsigned)(Rb * K + C) * 2u; }
    const size_t kstep = (size_t)(BK * 2);
    const size_t hstep = (size_t)HALF * K * 2;
    const size_t hstepA = GATHER ? 0 : hstep;
    const unsigned ldsw = (unsigned)wid * 1024u;
    const int aoff = lds_byte(wr * 64 + fr, fq * 8), boff = lds_byte(wc * 32 + fr, fq * 8);
#define PG8_SA(b, h) (((b) * 2 + (h)) * HTB)
#define PG8_SB(b, h) ((4 + (b) * 2 + (h)) * HTB)
#define PG8_STAGE(bufoff, gbase, voff) do { _Pragma("unroll") for (int _i = 0; _i < 2; ++_i) \
        __builtin_amdgcn_global_load_lds((const unsigned*)((const char*)(gbase) + (voff)[_i]), (PG8_LAS unsigned*)(lds + (bufoff) + ldsw + _i * 8192), 16, 0, 0); } while (0)
#define PG8_STAGE_A(bufoff, gbase, h, VO) do { _Pragma("unroll") for (int _i = 0; _i < 2; ++_i) \
        __builtin_amdgcn_global_load_lds((const unsigned*)((const char*)(gbase) + (size_t)(h) * hstepA + (GATHER ? (VO)[2 * (h) + _i] : voffA[_i])), (PG8_LAS unsigned*)(lds + (bufoff) + ldsw + _i * 8192), 16, 0, 0); } while (0)
#define PG8_LDA(dst, b, h) do { _Pragma("unroll") for (int m = 0; m < 4; ++m) _Pragma("unroll") for (int k = 0; k < 2; ++k) dst[m][k] = *(const PG8_LAS bf16x8*)(lds + PG8_SA(b, h) + aoff + m * 2048 + k * 1024); } while (0)
#define PG8_LDB(dst, b, h) do { _Pragma("unroll") for (int n = 0; n < 2; ++n) _Pragma("unroll") for (int k = 0; k < 2; ++k) dst[n][k] = *(const PG8_LAS bf16x8*)(lds + PG8_SB(b, h) + boff + n * 2048 + k * 1024); } while (0)
#define PG8_MMA(ai, bj, At, Bt) do { __builtin_amdgcn_s_setprio(1); _Pragma("unroll") for (int m = 0; m < 4; ++m) _Pragma("unroll") for (int n = 0; n < 2; ++n) _Pragma("unroll") for (int k = 0; k < 2; ++k) \
        acc[ai][bj][m][n] = __builtin_amdgcn_mfma_f32_16x16x32_bf16(Bt[n][k], At[m][k], acc[ai][bj][m][n], 0, 0, 0); __builtin_amdgcn_s_setprio(0); } while (0)
#define PG8_WAIT_V(n) asm volatile("s_waitcnt vmcnt(" #n ")" ::: "memory")
#define PG8_WAIT_L(n) asm volatile("s_waitcnt lgkmcnt(" #n ")" ::: "memory")
#define PG8_BAR __builtin_amdgcn_s_barrier()
#define PG8_SCHED __builtin_amdgcn_sched_barrier(0)
    Unit cur, nxt; int ui = 0;
    if (!S.next(0, cur)) return;
    f32x4 acc[2][2][4][2];
#pragma unroll
    for (int a = 0; a < 2; ++a)
#pragma unroll
        for (int b = 0; b < 2; ++b)
#pragma unroll
            for (int m = 0; m < 4; ++m)
#pragma unroll
                for (int n = 0; n < 2; ++n) acc[a][b][m][n] = (f32x4){0.f, 0.f, 0.f, 0.f};
    bf16x8 At[4][2], B0[2][2], B1[2][2];
    const char* cA = S.a_base(cur); const char* cB = S.b_base(cur);
    unsigned vc[4] = {0u, 0u, 0u, 0u}, vn[4] = {0u, 0u, 0u, 0u};
    if constexpr (GATHER) {
#pragma unroll
        for (int h = 0; h < 2; ++h)
#pragma unroll
            for (int i = 0; i < 2; ++i) vc[2 * h + i] = S.row_off(cur, h * HALF + rowA[i]) + voffA[i];
    }
    PG8_STAGE(PG8_SB(0, 0), cB, voffB); PG8_STAGE(PG8_SB(0, 1), cB + hstep, voffB); PG8_STAGE_A(PG8_SA(0, 0), cA, 0, vc); PG8_STAGE_A(PG8_SA(0, 1), cA, 1, vc);
    if (wr == 1) PG8_BAR;
    PG8_WAIT_V(2); PG8_BAR;
    PG8_STAGE(PG8_SB(1, 0), cB + kstep, voffB); PG8_STAGE_A(PG8_SA(1, 0), cA + kstep, 0, vc); PG8_STAGE(PG8_SB(1, 1), cB + hstep + kstep, voffB);
    PG8_WAIT_V(6); PG8_BAR;
    for (;;) {
        const bool has_next = S.next(ui + 1, nxt);
        const char* nA = has_next ? S.a_base(nxt) : cA; const char* nB = has_next ? S.b_base(nxt) : cB;
        if constexpr (GATHER) {
#pragma unroll
            for (int h = 0; h < 2; ++h)
#pragma unroll
                for (int i = 0; i < 2; ++i) vn[2 * h + i] = has_next ? (S.row_off(nxt, h * HALF + rowA[i]) + voffA[i]) : vc[2 * h + i];
        }
        for (int t = 0; t < nt; t += 2) {
            const bool last = (t == nt - 2);
            const char* a1 = cA + (size_t)(t + 1) * kstep;
            const char* a2 = last ? nA : cA + (size_t)(t + 2) * kstep; const char* b2 = last ? nB : cB + (size_t)(t + 2) * kstep;
            const char* a3 = a2 + kstep; const char* b3 = b2 + kstep;
            unsigned v2[4];
#pragma unroll
            for (int q = 0; q < 4; ++q) v2[q] = last ? vn[q] : vc[q];
            PG8_LDB(B0, 0, 0); PG8_LDB(B1, 0, 1); PG8_SCHED; PG8_LDA(At, 0, 0); PG8_STAGE_A(PG8_SA(1, 1), a1, 1, vc);
            PG8_WAIT_V(8); PG8_WAIT_L(0); PG8_BAR; PG8_MMA(0, 0, At, B0); PG8_MMA(0, 1, At, B1); PG8_BAR; PG8_SCHED;
            PG8_LDA(At, 0, 1); PG8_STAGE(PG8_SB(0, 0), b2, voffB); PG8_STAGE(PG8_SB(0, 1), b2 + hstep, voffB); PG8_STAGE_A(PG8_SA(0, 0), a2, 0, v2);
            PG8_WAIT_V(8); PG8_WAIT_L(0); PG8_BAR; PG8_MMA(1, 0, At, B0); PG8_MMA(1, 1, At, B1); PG8_BAR; PG8_SCHED;
            PG8_LDB(B0, 1, 0); PG8_LDB(B1, 1, 1); PG8_SCHED; PG8_LDA(At, 1, 0); PG8_STAGE_A(PG8_SA(0, 1), a2, 1, v2);
            PG8_WAIT_V(8); PG8_WAIT_L(0); PG8_BAR; PG8_MMA(0, 0, At, B0); PG8_MMA(0, 1, At, B1); PG8_BAR; PG8_SCHED;
            PG8_LDA(At, 1, 1); PG8_STAGE(PG8_SB(1, 0), b3, voffB); PG8_STAGE(PG8_SB(1, 1), b3 + hstep, voffB); PG8_STAGE_A(PG8_SA(1, 0), a3, 0, v2);
            PG8_WAIT_V(8); PG8_WAIT_L(0); PG8_BAR; PG8_MMA(1, 0, At, B0); PG8_MMA(1, 1, At, B1); PG8_BAR; PG8_SCHED;
        }
        if (wr == 0) PG8_BAR;
        E(acc, cur, wr, wc, fr, fq);
        if (!has_next) break;
#pragma unroll
        for (int a = 0; a < 2; ++a)
#pragma unroll
            for (int b = 0; b < 2; ++b)
#pragma unroll
                for (int m = 0; m < 4; ++m)
#pragma unroll
                    for (int n = 0; n < 2; ++n) acc[a][b][m][n] = (f32x4){0.f, 0.f, 0.f, 0.f};
        cur = nxt; cA = nA; cB = nB; ++ui;
#pragma unroll
        for (int q = 0; q < 4; ++q) vc[q] = vn[q];
        if (wr == 1) PG8_BAR;
    }
    PG8_WAIT_V(0);
    PG8_BAR;
#undef PG8_SA
#undef PG8_SB
#undef PG8_STAGE
#undef PG8_STAGE_A
#undef PG8_LDA
#undef PG8_LDB
#undef PG8_MMA
#undef PG8_WAIT_V
#undef PG8_WAIT_L
#undef PG8_BAR
#undef PG8_SCHED
}
}
namespace attn {
using bf16x8 = __attribute__((ext_vector_type(8))) short;
using s16x4 = __attribute__((ext_vector_type(4))) short;
using f32x16 = __attribute__((ext_vector_type(16))) float;
using u32x4 = __attribute__((ext_vector_type(4))) unsigned;
typedef unsigned short bf16_t;
constexpr int SEQ = 8192, NW = 8, QBLK = 32, QB = QBLK * NW, KVBLK = 64, NTILE = SEQ / KVBLK, PITCH = 512;
constexpr int KSLOT = 8192, VSLOT = 16384;
constexpr int LDS_K = 0, LDS_V = 3 * KSLOT, LDS_WS = LDS_V + 3 * VSLOT, LDS_OST = LDS_WS + NW * 256, LDS_BYTES = LDS_OST + NW * 8192;
#define SBAR() __builtin_amdgcn_sched_barrier(0)
#define PIN(x) asm volatile("" : "+v"(x))
#define MFMA32(a, b, c) __builtin_amdgcn_mfma_f32_32x32x16_bf16(a, b, c, 0, 0, 0)
#define WAIT_BAR(N) asm volatile("s_waitcnt vmcnt(" #N ") lgkmcnt(0)\n\ts_barrier" ::: "memory")
__device__ __forceinline__ constexpr int crow0(int r) { return (r & 3) + 8 * (r >> 2); }
__device__ __forceinline__ void glds16(const void* g, unsigned lds_base) {
    unsigned sv; asm volatile("s_mov_b32 %0, m0\n\ts_mov_b32 m0, %2\n\ts_nop 0\n\tglobal_load_lds_dwordx4 %1, off\n\ts_mov_b32 m0, %0" : "=&s"(sv) : "v"(g), "s"(lds_base) : "memory"); }
typedef float f32x2_t __attribute__((ext_vector_type(2))); typedef __bf16 bf16x2_t __attribute__((ext_vector_type(2)));
__device__ __forceinline__ unsigned cvtpk(float lo, float hi) { f32x2_t v = {lo, hi}; bf16x2_t b = __builtin_convertvector(v, bf16x2_t); return __builtin_bit_cast(unsigned, b); }
typedef __attribute__((address_space(3))) const char* lds_cptr;
typedef short v4i16_t __attribute__((ext_vector_type(4)));
__device__ __forceinline__ bf16x8 kld(lds_cptr p) { return *(const __attribute__((address_space(3))) bf16x8*)p; }
__device__ __forceinline__ s16x4 vtr(lds_cptr p) { return __builtin_bit_cast(s16x4, __builtin_amdgcn_ds_read_tr16_b64_v4i16((__attribute__((address_space(3))) v4i16_t*)p)); }
#define MX3(a, b, c) __builtin_fmaxf(__builtin_fmaxf((a), (b)), (c))
__device__ __forceinline__ float rowmax(const f32x16& p0, const f32x16& p1) {
    float a = MX3(p0[0], p0[1], p1[0]), b = MX3(p0[2], p0[3], p1[1]); a = MX3(a, p1[2], p1[3]);
#pragma unroll
    for (int r = 4; r < 16; r += 4) { a = MX3(a, p0[r], p0[r + 1]); b = MX3(b, p0[r + 2], p0[r + 3]); a = MX3(a, p1[r], p1[r + 1]); b = MX3(b, p1[r + 2], p1[r + 3]); }
    float m = __builtin_fmaxf(a, b); auto rr = __builtin_amdgcn_permlane32_swap(__float_as_uint(m), __float_as_uint(m), false, false);
    return __builtin_fmaxf(__uint_as_float(rr[0]), __uint_as_float(rr[1])); }
__device__ __forceinline__ float bf2f(short s) { return __uint_as_float(((unsigned)(unsigned short)s) << 16); }
__device__ __forceinline__ void build_c(f32x16& C, int side, float dj, float sg2, float mhat) {
    if (side == 0) {
#pragma unroll
        for (int r = 0; r < 16; ++r) C[r] = __builtin_fmaf(-sg2, __builtin_fabsf(dj + (float)crow0(r)), -mhat);
    } else {
        const float ss = (side > 0) ? -sg2 : sg2, cl = __builtin_fmaf(ss, dj, -mhat);
#pragma unroll
        for (int r = 0; r < 16; ++r) C[r] = __builtin_fmaf(ss, (float)crow0(r), cl);
    }
}

template <int THRL>
__device__ __forceinline__ void attn_unit(int b, int h, int c, int qb, int tlo, int thi, float sg2, const bf16_t* Q, const bf16_t* __restrict__ K, const bf16_t* __restrict__ V, bf16_t* AO, char* lds) {
    const int tid = threadIdx.x, lane = tid & 63, r32 = lane & 31, hi = lane >> 5; const int wid = __builtin_amdgcn_readfirstlane(tid >> 6);
    const long rowbase = (long)b * SEQ; const int q0 = qb * QB, iw0 = q0 + wid * QBLK, n = thi - tlo + 1;
    const bf16_t* Qw = Q + (rowbase + iw0) * PITCH + h * 128 + c * 64;
    const bf16_t* Kh = K + rowbase * PITCH + h * 128 + c * 64; const bf16_t* Vh = V + rowbase * PITCH + h * 128;
    const unsigned lds0 = (unsigned)(uintptr_t)lds; float* wsf = (float*)(lds + LDS_WS) + wid * 64;
    const bf16_t* ksrc = Kh + (long)tlo * KVBLK * PITCH + (long)lane * PITCH + wid * 8;
    const bf16_t* vsrc = Vh + (long)tlo * KVBLK * PITCH + (long)(32 * (wid & 1) + (lane >> 2)) * PITCH + (wid >> 1) * 32 + (lane & 3) * 8;
    const unsigned kdst = lds0 + LDS_K + wid * 1024, vdst = lds0 + LDS_V + wid * 2048;
#define DMA_K(s, slot) glds16(ksrc + (long)(s) * KVBLK * PITCH, (unsigned)__builtin_amdgcn_readfirstlane(kdst + (slot) * KSLOT))
#define DMA_V(s, slot) do { glds16(vsrc + (long)(s) * KVBLK * PITCH, (unsigned)__builtin_amdgcn_readfirstlane(vdst + (slot) * VSLOT)); \
                            glds16(vsrc + (long)(s) * KVBLK * PITCH + 16 * PITCH, (unsigned)__builtin_amdgcn_readfirstlane(vdst + (slot) * VSLOT + 1024)); } while (0)
    const lds_cptr vp0 = (lds_cptr)lds + LDS_V + ((lane >> 4) & 1) * 32 + (lane & 3) * 8 + (4 * hi + ((lane & 15) >> 2)) * 64;
    const lds_cptr kp0 = (lds_cptr)lds + LDS_K + hi * 1024 + r32 * 16;
    DMA_K(0, 0); DMA_V(0, 0); DMA_K(1, 1); DMA_K(2, 2);
    bf16x8 qr[4];
#pragma unroll
    for (int d0 = 0; d0 < 4; ++d0) qr[d0] = *reinterpret_cast<const bf16x8*>(&Qw[(long)r32 * PITCH + d0 * 16 + hi * 8]);
    float mhat;
    { const bf16_t* Kd = Kh + (long)(iw0 + r32) * PITCH; float s = 0.f;
#pragma unroll
      for (int d0 = 0; d0 < 4; ++d0) { const bf16x8 kk = *reinterpret_cast<const bf16x8*>(&Kd[d0 * 16 + hi * 8]);
#pragma unroll
          for (int j = 0; j < 8; ++j) s = __builtin_fmaf(bf2f(qr[d0][j]), bf2f(kk[j]), s); }
      auto rr = __builtin_amdgcn_permlane32_swap(__float_as_uint(s), __float_as_uint(s), false, false); mhat = __uint_as_float(rr[0]) + __uint_as_float(rr[1]); }
    float l_reg = 0.f; f32x16 o[4]; o[0] = f32x16{}; o[1] = f32x16{}; o[2] = f32x16{}; o[3] = f32x16{};
    const float fi = (float)(4 * hi - (iw0 + r32));
    bool resc = false;
    f32x16 C0, C1; bf16x8 kf[8]; u32x4 pw0, pw1, pw2, pw3;
    pw0 = u32x4{}; pw1 = u32x4{}; pw2 = u32x4{}; pw3 = u32x4{};
    int s_prev = 0, s_cur = 0, s_next = 1;
#define ROT() do { s_prev = s_cur; s_cur = s_next; s_next = (s_next == 2) ? 0 : s_next + 1; } while (0)
#define EX(v) __builtin_amdgcn_exp2f(v)
#define RESC() do { if (resc) { asm volatile("s_waitcnt lgkmcnt(0)" ::: "memory"); _Pragma("unroll") for (int d_ = 0; d_ < 4; ++d_) _Pragma("unroll") for (int r = 0; r < 16; ++r) o[d_][r] *= wsf[crow0(r) + 4 * hi]; } } while (0)
    asm volatile("s_waitcnt vmcnt(0) lgkmcnt(0)\n\ts_barrier" ::: "memory");
#pragma unroll
    for (int f = 0; f < 8; ++f) kf[f] = kld(kp0 + (f >> 1) * 2048 + (f & 1) * 512);
    asm volatile("s_waitcnt lgkmcnt(0)\n\ts_barrier" ::: "memory");
#define PKW(P, i) cvtpk(P[i], P[i + 1])
#define PAF(k) __builtin_bit_cast(bf16x8, pw##k)
#define VFRG(lo, hi_) (bf16x8){lo[0], lo[1], lo[2], lo[3], hi_[0], hi_[1], hi_[2], hi_[3]}
#define VRD(f) do { vlo[f] = vtr(vp_ + (((f) & 3) * 4096 + ((f) >> 2) * 1024)); vhi[f] = vtr(vp_ + (((f) & 3) * 4096 + ((f) >> 2) * 1024 + 512)); } while (0)
#define STEP(s, FIRST, GK, GV, GL) do { SBAR(); \
    const int jt_ = (tlo + (s)) * KVBLK; const lds_cptr vp_ = vp0 + s_prev * VSLOT; s16x4 vlo[16], vhi[16]; \
    { const int d0_ = jt_ - iw0, d1_ = jt_ + 32 - iw0; \
      build_c(C0, (d0_ > 0) - (d0_ < 0), (float)jt_ + fi, sg2, mhat); build_c(C1, (d1_ > 0) - (d1_ < 0), (float)(jt_ + 32) + fi, sg2, mhat); } \
    if (!(FIRST)) { VRD(0); VRD(1); } SBAR(); \
    C0 = MFMA32(kf[0], qr[0], C0); C1 = MFMA32(kf[1], qr[0], C1); SBAR(); \
    if (!(FIRST)) { VRD(2); VRD(3); } SBAR(); \
    C0 = MFMA32(kf[2], qr[1], C0); C1 = MFMA32(kf[3], qr[1], C1); SBAR(); \
    C0 = MFMA32(kf[4], qr[2], C0); C1 = MFMA32(kf[5], qr[2], C1); SBAR(); \
    C0 = MFMA32(kf[6], qr[3], C0); C1 = MFMA32(kf[7], qr[3], C1); SBAR(); \
    if (GK) DMA_K((s) + 3, s_cur); if (GV) DMA_V((s) + 1, s_next); \
    { const float rm = rowmax(C0, C1); resc = false; \
      if (__builtin_expect(__any(rm > (float)THRL), 0)) { const float dl = __builtin_fmaxf(rm, 0.f); mhat += dl; \
          _Pragma("unroll") for (int r = 0; r < 16; ++r) { C0[r] -= dl; C1[r] -= dl; } \
          const float f = EX(-dl); l_reg *= f; if (hi == 0) wsf[r32] = f; resc = true; } } \
    SBAR(); \
    float sacc = 0.f; u32x4 nw0, nw1, nw2, nw3; \
    _Pragma("unroll") for (int g = 0; g < 16; ++g) { \
        if (!(FIRST)) { const int ks_ = g >> 2, db_ = g & 3; \
            if (g + 4 < 16) { VRD(g + 4); } \
            const bf16x8 pa_ = (ks_ == 0) ? PAF(0) : (ks_ == 1) ? PAF(1) : (ks_ == 2) ? PAF(2) : PAF(3); \
            o[db_] = MFMA32(pa_, VFRG(vlo[g], vhi[g]), o[db_]); } \
        if (GL) { if (g >= 4 && g < 12) { kf[g - 4] = kld(kp0 + s_next * KSLOT + ((g - 4) >> 1) * 2048 + ((g - 4) & 1) * 512); } } \
        if (g < 8) { C0[2 * g] = EX(C0[2 * g]); C0[2 * g + 1] = EX(C0[2 * g + 1]); sacc += C0[2 * g]; sacc += C0[2 * g + 1]; } \
        else { C1[2 * g - 16] = EX(C1[2 * g - 16]); C1[2 * g - 15] = EX(C1[2 * g - 15]); sacc += C1[2 * g - 16]; sacc += C1[2 * g - 15]; } \
        if (g == 0) nw0[0] = PKW(C0, 0); if (g == 1) nw0[1] = PKW(C0, 2); if (g == 2) nw0[2] = PKW(C0, 4); if (g == 3) nw0[3] = PKW(C0, 6); \
        if (g == 4) nw1[0] = PKW(C0, 8); if (g == 5) nw1[1] = PKW(C0, 10); if (g == 6) nw1[2] = PKW(C0, 12); if (g == 7) nw1[3] = PKW(C0, 14); \
        if (g == 8) nw2[0] = PKW(C1, 0); if (g == 9) nw2[1] = PKW(C1, 2); if (g == 10) nw2[2] = PKW(C1, 4); if (g == 11) nw2[3] = PKW(C1, 6); \
        if (g == 12) nw3[0] = PKW(C1, 8); if (g == 13) nw3[1] = PKW(C1, 10); if (g == 14) nw3[2] = PKW(C1, 12); if (g == 15) nw3[3] = PKW(C1, 14); \
        PIN(sacc); SBAR(); } \
    l_reg += sacc; pw0 = nw0; pw1 = nw1; pw2 = nw2; pw3 = nw3; \
    } while (0)
    STEP(0, true, true, true, true); WAIT_BAR(3); RESC(); ROT();
    int s = 1;
    for (; s + 3 < n; ++s) { STEP(s, false, true, true, true); WAIT_BAR(3); RESC(); ROT(); }
    STEP(s, false, false, true, true); WAIT_BAR(2); RESC(); ROT(); ++s;
    STEP(s, false, false, true, true); WAIT_BAR(2); RESC(); ROT(); ++s;
    STEP(s, false, false, false, false); WAIT_BAR(0); RESC(); ROT();
    { const lds_cptr vp_ = vp0 + s_prev * VSLOT; s16x4 vlo[16], vhi[16];
#pragma unroll
      for (int g = 0; g < 16; ++g) VRD(g);
#pragma unroll
      for (int g = 0; g < 16; ++g) { const int ks_ = g >> 2, db_ = g & 3; const bf16x8 pa_ = (ks_ == 0) ? PAF(0) : (ks_ == 1) ? PAF(1) : (ks_ == 2) ? PAF(2) : PAF(3);
          o[db_] = MFMA32(pa_, VFRG(vlo[g], vhi[g]), o[db_]); } }
    { auto rr = __builtin_amdgcn_permlane32_swap(__float_as_uint(l_reg), __float_as_uint(l_reg), false, false); l_reg = __uint_as_float(rr[0]) + __uint_as_float(rr[1]); }
    if (hi == 0) wsf[32 + r32] = l_reg; asm volatile("s_waitcnt lgkmcnt(0)" ::: "memory");
    float rli[16];
#pragma unroll
    for (int r = 0; r < 16; ++r) rli[r] = __builtin_amdgcn_rcpf(wsf[32 + crow0(r) + 4 * hi]);
    bf16_t* Ow = AO + (rowbase + iw0) * PITCH + h * 128; __hip_bfloat16* stg = (__hip_bfloat16*)(lds + LDS_OST) + wid * 4096;
#pragma unroll
    for (int r = 0; r < 16; ++r) { const int orow = crow0(r) + 4 * hi;
#pragma unroll
        for (int db = 0; db < 4; ++db) stg[orow * 128 + db * 32 + r32] = __float2bfloat16(o[db][r] * rli[r]); }
    asm volatile("s_waitcnt lgkmcnt(0)" ::: "memory");
#pragma unroll
    for (int i = 0; i < 8; ++i) { const int row = i * 4 + (lane >> 4), ch = lane & 15; *(u32x4*)(Ow + (long)row * PITCH + ch * 8) = *(const u32x4*)(stg + row * 128 + ch * 8); }
    asm volatile("s_waitcnt lgkmcnt(0)\n\ts_barrier" ::: "memory");
#undef DMA_K
#undef DMA_V
#undef ROT
#undef EX
#undef RESC
#undef PKW
#undef PAF
#undef VFRG
#undef VRD
#undef STEP
}
#undef SBAR
#undef PIN
#undef MFMA32
#undef WAIT_BAR
#undef MX3
}
constexpr int NWAVES = 8;
constexpr int BATCH = 2, SEQ = 8192, DM = 1024, T = BATCH * SEQ, NEXP = 32, DEXP = 512;
constexpr float EPS = 1e-6f, LAM_INIT = 0.2f;
constexpr float C2 = 0.125f * 1.4426950408889634f;
constexpr float LOG2E = 1.4426950408889634f;
constexpr int ATT_THR = 8;

constexpr size_t MiB = 1u << 20;
constexpr size_t WS_CTL = 0, CTL_ZERO_BYTES = 65536;
constexpr size_t WS_LIST = 1 * MiB, WS_GLIST = 3 * MiB, WS_EPOS = 5 * MiB;
constexpr size_t WS_WIN = 6 * MiB, WS_WOUT = 10 * MiB, WS_WGU = 12 * MiB, WS_WD = 76 * MiB;
constexpr size_t WS_QKVU = 108 * MiB;
constexpr size_t WS_XN2 = 108 * MiB;
constexpr size_t WS_Y = 108 * MiB;
constexpr size_t WS_XN1 = 172 * MiB;
constexpr size_t WS_MIX = 172 * MiB;
constexpr size_t WS_AO = 204 * MiB;
constexpr size_t WS_HDN = 204 * MiB;
constexpr size_t WS_END = 244 * MiB;
constexpr int MAXROWS = 40960;
constexpr int CW_CNT = 64;
constexpr int CW_BAR = 4096;
constexpr int LDS_BYTES = 163840;
constexpr int MISC_OFF = LDS_BYTES - 256;
constexpr int MOE_TAB_OFF = 131072;
constexpr int RT_WR = 0, RT_SC = 148032, RT_SQ = 160320, RT_SR = 160576;

#define GAS __attribute__((address_space(1)))
#define LAS __attribute__((address_space(3)))
typedef unsigned short bf16;
typedef unsigned v4u __attribute__((ext_vector_type(4)));
typedef unsigned v2u __attribute__((ext_vector_type(2)));
typedef float f32x4 __attribute__((ext_vector_type(4)));
typedef GAS unsigned gu32;
#define RLX_AGENT __ATOMIC_RELAXED, __HIP_MEMORY_SCOPE_AGENT
#define LDS_WAIT() asm volatile("s_waitcnt lgkmcnt(0)" ::: "memory")
#define VM_WAIT() asm volatile("s_waitcnt vmcnt(0)" ::: "memory")
__device__ __forceinline__ unsigned f2bf(float f) { unsigned u = __builtin_bit_cast(unsigned, f); return (u + 0x7fffu + ((u >> 16) & 1u)) >> 16; }
__device__ __forceinline__ unsigned pk2(float lo, float hi) { return f2bf(lo) | (f2bf(hi) << 16); }
__device__ __forceinline__ float bflo(unsigned w) { return __uint_as_float(w << 16); }
__device__ __forceinline__ float bfhi(unsigned w) { return __uint_as_float(w & 0xffff0000u); }

#define XB_TMO      128
#define XB_XCNT(j)  (256  + 64 * (j))
#define XB_XSUB(j)  (1280 + 64 * (j))
#define XB_XGEN(j)  (2304 + 64 * (j))
#define XB_TOP      3328
#define XB_TOPGEN   3392
#define XCD_BAR_WORDS 3456
#define XB_SPIN_CAP (1u << 18)
__device__ __forceinline__ unsigned xb_ld(unsigned* p)              { return __hip_atomic_load(p, __ATOMIC_RELAXED, __HIP_MEMORY_SCOPE_AGENT); }
__device__ __forceinline__ unsigned xb_add(unsigned* p, unsigned v) { return __hip_atomic_fetch_add(p, v, __ATOMIC_RELAXED, __HIP_MEMORY_SCOPE_AGENT); }
__device__ __forceinline__ unsigned xb_xcc_id() { return (unsigned)__builtin_amdgcn_s_getreg((3 << 11) | 20) & 0xFu; }
#define XB_SPIN(cond, bar) do { unsigned _sp = 0; while (cond) { __builtin_amdgcn_s_sleep(1); \
    if ((++_sp & 255u) == 0u) { if (xb_ld(&(bar)[XB_TMO])) break; if (_sp > XB_SPIN_CAP) { atomicAdd(&(bar)[XB_TMO], 1u); break; } } } } while (0)
struct XcdBarrier { unsigned* bar; unsigned x; volatile LAS unsigned* st; };
__device__ __forceinline__ XcdBarrier xcd_barrier_post(unsigned* bar, volatile LAS unsigned* st) {
    XcdBarrier b; b.bar = bar; b.x = xb_xcc_id(); b.st = st;
    if (threadIdx.x == 0) (void)xb_add(&bar[XB_XCNT(b.x)], 1u);
    return b;
}
__device__ __forceinline__ void xcd_barrier_complete(unsigned* bar, unsigned x, unsigned& nloc, unsigned& nx) {
    const unsigned G = gridDim.x * gridDim.y * gridDim.z;
    unsigned sum, cnt, mine, sp = 0u;
    for (;;) {
        sum = 0u; cnt = 0u; mine = 0u;
#pragma unroll
        for (unsigned j = 0; j < 16; ++j) { const unsigned c = xb_ld(&bar[XB_XCNT(j)]); sum += c; cnt += (c > 0u) ? 1u : 0u; mine = (j == x) ? c : mine; }
        if (sum == G) break;
        __builtin_amdgcn_s_sleep(1);
        if ((++sp & 255u) == 0u) { if (xb_ld(&bar[XB_TMO])) break; if (sp > XB_SPIN_CAP) { atomicAdd(&bar[XB_TMO], 1u); break; } }
    }
    nloc = mine > 0u ? mine : 1u; nx = cnt > 0u ? cnt : 1u;
}
__device__ __forceinline__ void xcd_barrier(const XcdBarrier& b) {
    asm volatile("s_waitcnt vmcnt(0)" ::: "memory");
    __syncthreads();
    if (threadIdx.x == 0) {
        unsigned* bar = b.bar;
        __builtin_amdgcn_s_waitcnt(0);
        unsigned nloc = b.st[0], nx = b.st[1];
        if (nloc == 0u) { xcd_barrier_complete(bar, b.x, nloc, nx); b.st[0] = nloc; b.st[1] = nx; }
        const unsigned old = xb_add(&bar[XB_XSUB(b.x)], 1u);
        const unsigned gen = old / nloc;
        if (old + 1u == (gen + 1u) * nloc) {
            __builtin_amdgcn_fence(__ATOMIC_RELEASE, "agent");
            asm volatile("s_waitcnt vmcnt(0)" ::: "memory");
            const unsigned og = xb_add(&bar[XB_TOP], 1u);
            const unsigned tg = og / nx;
            if (og + 1u == (tg + 1u) * nx) xb_add(&bar[XB_TOPGEN], 1u);
            else XB_SPIN(xb_ld(&bar[XB_TOPGEN]) == tg, bar);
            __builtin_amdgcn_fence(__ATOMIC_ACQUIRE, "agent");
            xb_add(&bar[XB_XGEN(b.x)], 1u);
            asm volatile("s_waitcnt vmcnt(0)" ::: "memory");
        } else {
            XB_SPIN(xb_ld(&bar[XB_XGEN(b.x)]) == gen, bar);
            __builtin_amdgcn_fence(__ATOMIC_ACQUIRE, "agent");
            asm volatile("s_waitcnt vmcnt(0)" ::: "memory");
        }
    }
    __syncthreads();
}

__device__ __forceinline__ float wave_sum(float v) {
#pragma unroll
    for (int o = 1; o < 64; o <<= 1) v += __shfl_xor(v, o);
    return v;
}
struct TrItem { const float* src; int ldw; bf16* dst; size_t opitch; };
__device__ __forceinline__ void tr_load(const TrItem& I, float (&v)[32], int lane) {
#pragma unroll
    for (int i = 0; i < 32; ++i) v[i] = I.src[(size_t)(2 * i + (lane >> 5)) * I.ldw + (lane & 31)];
}
__device__ __forceinline__ void tr_finish(const TrItem& I, const float (&v)[32], LAS float* scr, int lane) {
#pragma unroll
    for (int i = 0; i < 32; ++i) scr[(2 * i + (lane >> 5)) * 33 + (lane & 31)] = v[i];
    LDS_WAIT(); asm volatile("" ::: "memory");
    const int c = lane & 7;
#pragma unroll
    for (int j = 0; j < 4; ++j) { const int n = (lane >> 3) + 8 * j; const LAS float* sp = scr + (8 * c) * 33 + n;
        v4u o; o.x = pk2(sp[0 * 33], sp[1 * 33]); o.y = pk2(sp[2 * 33], sp[3 * 33]); o.z = pk2(sp[4 * 33], sp[5 * 33]); o.w = pk2(sp[6 * 33], sp[7 * 33]);
        *(GAS v4u*)(I.dst + (size_t)n * I.opitch + 8 * c) = o; }
    LDS_WAIT(); asm volatile("" ::: "memory");
}
template <int NR> __device__ __forceinline__ void rms_rows_to_bf16(const float* x, const float* g, bf16* o, int m0, int stride, int mend, int lane) {
    f32x4 v[NR][4];
#pragma unroll
    for (int k = 0; k < NR; ++k) { const int m = m0 + k * stride; const GAS f32x4* xr = (const GAS f32x4*)(x + (size_t)(m < mend ? m : m0) * DM) + lane;
#pragma unroll
        for (int j = 0; j < 4; ++j) v[k][j] = xr[64 * j]; }
    const GAS f32x4* gr = (const GAS f32x4*)g + lane; f32x4 gg[4];
#pragma unroll
    for (int j = 0; j < 4; ++j) gg[j] = gr[64 * j];
#pragma unroll
    for (int k = 0; k < NR; ++k) { const int m = m0 + k * stride; float s = 0.f;
#pragma unroll
        for (int j = 0; j < 4; ++j) s += (v[k][j].x * v[k][j].x + v[k][j].y * v[k][j].y) + (v[k][j].z * v[k][j].z + v[k][j].w * v[k][j].w);
        const float rstd = 1.0f / sqrtf(wave_sum(s) * (1.f / DM) + EPS);
        if (m < mend) { GAS v2u* o8 = (GAS v2u*)(o + (size_t)m * DM) + lane;
#pragma unroll
            for (int j = 0; j < 4; ++j) { v2u w; w.x = pk2(v[k][j].x * rstd * gg[j].x, v[k][j].y * rstd * gg[j].y); w.y = pk2(v[k][j].z * rstd * gg[j].z, v[k][j].w * rstd * gg[j].w); o8[64 * j] = w; } } }
}

struct Args { const float* in[20]; float* out; unsigned char* ws; int ph_lo, ph_hi; };

__global__ void __launch_bounds__(NWAVES * 64, 2) mk_fwd(Args args) {
    extern __shared__ __attribute__((aligned(16))) unsigned char lds[];
    LAS unsigned char* L = (LAS unsigned char*)lds;
    volatile LAS unsigned* MISC = (volatile LAS unsigned*)(L + MISC_OFF);
    const int tid = threadIdx.x, lane = tid & 63, wave = __builtin_amdgcn_readfirstlane(tid >> 6);
    const int G = gridDim.x; const int bx = blockIdx.x; const int vcu = (G % 8 == 0) ? (bx % 8) * (G / 8) + bx / 8 : bx;
    unsigned char* ws = args.ws;
    gu32* ctl = (gu32*)(ws + WS_CTL);
    const float* x = args.in[0]; const float* n1g = args.in[1]; const float* w_in = args.in[2];
    const float* lq1 = args.in[3]; const float* lk1 = args.in[4]; const float* lq2 = args.in[5]; const float* lk2 = args.in[6];
    const float* subg = args.in[7]; const float* wpool = args.in[8]; const float* pscale = args.in[9]; const float* w_out = args.in[10];
    const float* n2g = args.in[11]; const float* wgr = args.in[12]; const float* bgr = args.in[13]; const float* wer = args.in[14];
    const float* ber = args.in[15]; const float* wgate = args.in[16]; const float* wup = args.in[17]; const float* wdown = args.in[18]; const float* fing = args.in[19];
    float* out = args.out;
    bf16* Win_t = (bf16*)(ws + WS_WIN); bf16* Wout_t = (bf16*)(ws + WS_WOUT); bf16* Wgu_t = (bf16*)(ws + WS_WGU); bf16* Wd_t = (bf16*)(ws + WS_WD);
    bf16* QKVU = (bf16*)(ws + WS_QKVU); bf16* XN1 = (bf16*)(ws + WS_XN1); bf16* MIX = (bf16*)(ws + WS_MIX); bf16* AO = (bf16*)(ws + WS_AO);
    bf16* XN2 = (bf16*)(ws + WS_XN2); bf16* HDN = (bf16*)(ws + WS_HDN); bf16* Y = (bf16*)(ws + WS_Y);
    int* list = (int*)(ws + WS_LIST); float* glist = (float*)(ws + WS_GLIST); int* epos = (int*)(ws + WS_EPOS);
    for (int u = tid; u < 64; u += NWAVES * 64) ((LAS unsigned*)(L + MISC_OFF))[u] = 0u;
    __syncthreads();
    XcdBarrier bar = xcd_barrier_post((unsigned*)(ctl + CW_BAR), MISC + 8);
    const int lo = args.ph_lo, hi = args.ph_hi;
#define IN(k) (lo <= (k) && (k) < hi)
#define SEAM(k) do { if (IN(k) && IN((k) + 1)) xcd_barrier(bar); } while (0)
    const int gw = vcu * NWAVES + wave, NGW = G * NWAVES;

    if (IN(0)) {
        LAS float* scr = (LAS float*)(L + wave * 16384);
        constexpr int I_WIN = 16 * 64, I_WO = 8 * 32, I_G = 16 * 16, I_D = 8 * 32;
        constexpr int NITEMS = I_WIN + I_WO + NEXP * (2 * I_G + I_D);
        auto decode = [&](int it) -> TrItem { TrItem I; int r = it;
            if (r < I_WIN) { const int kb = r / 64, nb = r % 64; I.src = w_in + (size_t)(64 * kb) * 2048 + 32 * nb; I.ldw = 2048; I.dst = Win_t + (size_t)(32 * nb) * 1024 + 64 * kb; I.opitch = 1024; return I; } r -= I_WIN;
            if (r < I_WO) { const int kb = r / 32, nb = r % 32; I.src = w_out + (size_t)(64 * kb) * 1024 + 32 * nb; I.ldw = 1024; I.dst = Wout_t + (size_t)(32 * nb) * 1024 + 64 * kb; I.opitch = 1024; return I; } r -= I_WO;
            const int e = r / (2 * I_G + I_D); r -= e * (2 * I_G + I_D);
            if (r < 2 * I_G) { const int up = r / I_G; r -= up * I_G; const int kb = r / 16, nb = r % 16, n0 = 32 * nb;
                I.src = (up ? wup : wgate) + (size_t)e * 1024 * 512 + (size_t)(64 * kb) * 512 + n0; I.ldw = 512;
                I.dst = Wgu_t + (size_t)e * 1024 * 1024 + (size_t)((n0 >> 7) * 256 + 128 * up + (n0 & 127)) * 1024 + 64 * kb; I.opitch = 1024; return I; }
            r -= 2 * I_G;
            { const int kb = r / 32, nb = r % 32; I.src = wdown + (size_t)e * 512 * 1024 + (size_t)(64 * kb) * 1024 + 32 * nb; I.ldw = 1024; I.dst = Wd_t + (size_t)e * 1024 * 512 + (size_t)(32 * nb) * 512 + 64 * kb; I.opitch = 512; return I; } };
        { float va[32], vb[32]; int it = gw; TrItem Ia, Ib;
          if (it < NITEMS) { Ia = decode(it); tr_load(Ia, va, lane); }
          while (it < NITEMS) {
              const int itb = it + NGW; if (itb < NITEMS) { Ib = decode(itb); tr_load(Ib, vb, lane); }
              tr_finish(Ia, va, scr, lane);
              if (itb >= NITEMS) break;
              const int itc = itb + NGW; if (itc < NITEMS) { Ia = decode(itc); tr_load(Ia, va, lane); }
              tr_finish(Ib, vb, scr, lane);
              it = itc; } }
        for (int m = gw; m < T; m += 4 * NGW) rms_rows_to_bf16<4>(x, n1g, XN1, m, NGW, T, lane);
        __syncthreads();
        for (int id = bx; id < 256; id += G) {
            const int g = id >> 6, kb = (id >> 4) & 3, nb = id & 15;
            LAS float* WoS = (LAS float*)L; LAS float* wps = (LAS float*)(L + 32768);
            { f32x4 t4[4];
#pragma unroll
              for (int q = 0; q < 4; ++q) { const int f = tid + 512 * q, dd = f >> 4, c4 = (f & 15) * 4; t4[q] = *(const GAS f32x4*)(w_out + (size_t)(512 + g * 128 + dd) * 1024 + nb * 64 + c4); }
              float w8[8], p8[8];
#pragma unroll
              for (int q = 0; q < 8; ++q) { const int f = tid + 512 * q, kk = f >> 7, dd = f & 127; w8[q] = wpool[(size_t)(g * 128 + kb * 32 + kk) * 128 + dd]; p8[q] = pscale[g * 128 + dd]; }
#pragma unroll
              for (int q = 0; q < 4; ++q) { const int f = tid + 512 * q; *(LAS f32x4*)(WoS + (f >> 4) * 64 + (f & 15) * 4) = t4[q]; }
#pragma unroll
              for (int q = 0; q < 8; ++q) { const int f = tid + 512 * q; wps[(f >> 7) * 129 + (f & 127)] = w8[q] * p8[q]; } }
            __syncthreads();
            { const int kk = tid >> 4, c4 = (tid & 15) * 4; f32x4 acc = {0.f, 0.f, 0.f, 0.f};
#pragma unroll 8
              for (int dd = 0; dd < 128; ++dd) { const float w = wps[kk * 129 + dd]; const f32x4 wo = *(const LAS f32x4*)(WoS + dd * 64 + c4); acc = acc + wo * w; }
              bf16* dst = Wout_t + (size_t)(nb * 64 + c4) * 1024 + 512 + g * 128 + kb * 32 + kk;
              dst[0] = (bf16)f2bf(acc.x); dst[1024] = (bf16)f2bf(acc.y); dst[2048] = (bf16)f2bf(acc.z); dst[3072] = (bf16)f2bf(acc.w); }
            __syncthreads();
        }
    }
    SEAM(0);
    if (IN(1)) {
        pg8::Gemm g{XN1, Win_t, T, 2048, DM}; pg8::StaticOrder S; S.init(g, G, bx);
        pg8::EpiBf16 E{QKVU, 512, 512, (size_t)T * 512, C2};
        pg8::gemm_phase<pg8::EpiBf16, pg8::StaticOrder, false>(L, DM, S, E);
    }
    SEAM(1);
    if (IN(2)) {
        const int bh = vcu >> 5, qb = vcu & 31, b = bh >> 2, h = bh & 3;
        const float slope = exp2f(-2.0f * (float)(h + 1)), sg2 = slope * LOG2E;
        if (vcu < 256) {
            for (int c = 0; c < 2; ++c)
                attn::attn_unit<ATT_THR>(b, h, c, qb, 0, attn::NTILE - 1, sg2, QKVU, QKVU + (size_t)T * 512, QKVU + (size_t)2 * T * 512, AO + (size_t)c * T * 512, (char*)lds);
        }
    }
    SEAM(2);
    if (IN(3)) {
        float s1 = wave_sum(lq1[lane] * lk1[lane]), s2 = wave_sum(lq2[lane] * lk2[lane]);
        const float lam = expf(s1) - expf(s2) + LAM_INIT;
        const bf16* U = QKVU + (size_t)3 * T * 512;
        float sg[8];
#pragma unroll
        for (int j = 0; j < 8; ++j) sg[j] = subg[(8 * lane + j) & 127] * (1.0f - LAM_INIT);
        for (int t0 = gw * 8; t0 < T; t0 += NGW * 8) {
            v4u a1[8], a2[8], ur[23];
#pragma unroll
            for (int q = 0; q < 8; ++q) { a1[q] = *(const GAS v4u*)(AO + (size_t)(t0 + q) * 512 + 8 * lane); a2[q] = *(const GAS v4u*)(AO + (size_t)(T + t0 + q) * 512 + 8 * lane); }
            const int tt0 = t0 & (SEQ - 1), tb = t0 - tt0;
#pragma unroll
            for (int k = 0; k < 23; ++k) { int j = tt0 - 8 + k; j = j < 0 ? 0 : (j > SEQ - 1 ? SEQ - 1 : j); ur[k] = *(const GAS v4u*)(U + (size_t)(tb + j) * 512 + 8 * lane); }
#pragma unroll
            for (int q = 0; q < 8; ++q) {
                float a[8];
#pragma unroll
                for (int j = 0; j < 4; ++j) { a[2 * j] = bflo(a1[q][j]) - lam * bflo(a2[q][j]); a[2 * j + 1] = bfhi(a1[q][j]) - lam * bfhi(a2[q][j]); }
                float ss = 0.f;
#pragma unroll
                for (int j = 0; j < 8; ++j) ss += a[j] * a[j];
                ss += __shfl_xor(ss, 1); ss += __shfl_xor(ss, 2); ss += __shfl_xor(ss, 4); ss += __shfl_xor(ss, 8);
                const float r = 1.0f / sqrtf(ss * (1.0f / 128.0f) + EPS);
                v4u o; o.x = pk2(a[0] * r * sg[0], a[1] * r * sg[1]); o.y = pk2(a[2] * r * sg[2], a[3] * r * sg[3]); o.z = pk2(a[4] * r * sg[4], a[5] * r * sg[5]); o.w = pk2(a[6] * r * sg[6], a[7] * r * sg[7]);
                *(GAS v4u*)(MIX + (size_t)(t0 + q) * 1024 + 8 * lane) = o;
            }
            const int hw = 1 << (lane >> 4);
#pragma unroll
            for (int q = 0; q < 8; ++q) {
                const int tt = tt0 + q; int jlo = tt - hw, jhi = tt + hw; jlo = jlo < 0 ? 0 : jlo; jhi = jhi > SEQ ? SEQ : jhi;
                float sm[8] = {0.f, 0.f, 0.f, 0.f, 0.f, 0.f, 0.f, 0.f};
#pragma unroll
                for (int k = q; k < q + 16; ++k) { const int j = tt0 - 8 + k; const float wgt = (j >= jlo && j < jhi) ? 1.0f : 0.0f;
#pragma unroll
                    for (int p = 0; p < 4; ++p) { sm[2 * p] = __builtin_fmaf(wgt, bflo(ur[k][p]), sm[2 * p]); sm[2 * p + 1] = __builtin_fmaf(wgt, bfhi(ur[k][p]), sm[2 * p + 1]); } }
                const float ic = 1.0f / (float)(jhi - jlo); const v4u ut = ur[8 + q];
                v4u d; d.x = pk2(sm[0] * ic - bflo(ut[0]), sm[1] * ic - bfhi(ut[0])); d.y = pk2(sm[2] * ic - bflo(ut[1]), sm[3] * ic - bfhi(ut[1]));
                d.z = pk2(sm[4] * ic - bflo(ut[2]), sm[5] * ic - bfhi(ut[2])); d.w = pk2(sm[6] * ic - bflo(ut[3]), sm[7] * ic - bfhi(ut[3]));
                *(GAS v4u*)(MIX + (size_t)(t0 + q) * 1024 + 512 + 8 * lane) = d;
            }
        }
    }
    SEAM(3);
    if (IN(4)) {
        pg8::Gemm g{MIX, Wout_t, T, DM, DM}; pg8::StaticOrder S; S.init(g, G, bx);
        pg8::EpiResF32 E{x, out, DM};
        pg8::gemm_phase<pg8::EpiResF32, pg8::StaticOrder, false>(L, DM, S, E);
    }
    SEAM(4);
    if (IN(5)) {
        LAS float* WR = (LAS float*)(L + RT_WR); LAS float* SC = (LAS float*)(L + RT_SC); LAS float* SQ = (LAS float*)(L + RT_SQ); LAS float* SR = (LAS float*)(L + RT_SR);
        { float wv[8], gv[8];
#pragma unroll
          for (int q = 0; q < 8; ++q) { const int idx = tid + 512 * q; wv[q] = wgr[idx]; gv[q] = n2g[idx >> 2]; }
#pragma unroll
          for (int q = 0; q < 8; ++q) { const int idx = tid + 512 * q; WR[(idx & 3) * 1028 + (idx >> 2)] = wv[q] * gv[q]; }
          for (int base = 0; base < 1024 * 32; base += 512 * 16) { float w16[16], g16[16];
#pragma unroll
              for (int q = 0; q < 16; ++q) { const int idx = base + tid + 512 * q; w16[q] = wer[idx]; g16[q] = n2g[idx >> 5]; }
#pragma unroll
              for (int q = 0; q < 16; ++q) { const int idx = base + tid + 512 * q; WR[(4 + (idx & 31)) * 1028 + (idx >> 5)] = w16[q] * g16[q]; } } }
        __syncthreads();
        const int gq = wave & 3, kh = wave >> 2, tk = lane & 15, kq = lane >> 4;
        for (int tb = vcu * 64; tb < T; tb += G * 64) {
            const float* hrow = out + (size_t)(tb + 16 * gq + tk) * DM + 512 * kh + 4 * kq;
            f32x4 acc[3] = {{0.f, 0.f, 0.f, 0.f}, {0.f, 0.f, 0.f, 0.f}, {0.f, 0.f, 0.f, 0.f}}; float ssq = 0.f;
            int nn[3];
#pragma unroll
            for (int nb = 0; nb < 3; ++nb) { const int n = 16 * nb + tk; nn[nb] = (n < 36 ? n : 35) * 1028 + 512 * kh + 4 * kq; }
#pragma unroll 8
            for (int s = 0; s < 32; ++s) {
                const f32x4 hv = *(const GAS f32x4*)(hrow + 16 * s);
                ssq += (hv.x * hv.x + hv.y * hv.y) + (hv.z * hv.z + hv.w * hv.w);
#pragma unroll
                for (int nb = 0; nb < 3; ++nb) { const f32x4 bv = *(const LAS f32x4*)(WR + nn[nb] + 16 * s);
                    acc[nb] = __builtin_amdgcn_mfma_f32_16x16x4f32(hv.x, bv.x, acc[nb], 0, 0, 0); acc[nb] = __builtin_amdgcn_mfma_f32_16x16x4f32(hv.y, bv.y, acc[nb], 0, 0, 0);
                    acc[nb] = __builtin_amdgcn_mfma_f32_16x16x4f32(hv.z, bv.z, acc[nb], 0, 0, 0); acc[nb] = __builtin_amdgcn_mfma_f32_16x16x4f32(hv.w, bv.w, acc[nb], 0, 0, 0); }
            }
            ssq += __shfl_xor(ssq, 16); ssq += __shfl_xor(ssq, 32);
            if (kh == 1) {
#pragma unroll
                for (int nb = 0; nb < 3; ++nb)
#pragma unroll
                    for (int r = 0; r < 4; ++r) SC[gq * 768 + (nb * 4 + r) * 64 + lane] = acc[nb][r];
                if (kq == 0) SQ[gq * 16 + tk] = ssq;
            }
            __syncthreads();
            if (kh == 0) {
#pragma unroll
                for (int nb = 0; nb < 3; ++nb)
#pragma unroll
                    for (int r = 0; r < 4; ++r) acc[nb][r] += SC[gq * 768 + (nb * 4 + r) * 64 + lane];
                const float sq2 = ssq + SQ[gq * 16 + tk];
                LDS_WAIT(); asm volatile("" ::: "memory");
#pragma unroll
                for (int nb = 0; nb < 3; ++nb)
#pragma unroll
                    for (int r = 0; r < 4; ++r) SC[gq * 768 + (4 * kq + r) * 48 + 16 * nb + tk] = acc[nb][r];
                LDS_WAIT(); asm volatile("" ::: "memory");
                if (lane < 16) {
                    const int t = tb + 16 * gq + lane; const float rstd = 1.0f / sqrtf(sq2 * (1.0f / DM) + EPS);
                    SR[gq * 16 + lane] = rstd;
                    const LAS float* lg = SC + gq * 768 + lane * 48;
                    float gl[4];
#pragma unroll
                    for (int g = 0; g < 4; ++g) gl[g] = lg[g] * rstd + bgr[g];
                    int gs = 0; float gm = gl[0];
#pragma unroll
                    for (int g = 1; g < 4; ++g) if (gl[g] > gm) { gm = gl[g]; gs = g; }
                    float den = 0.f;
#pragma unroll
                    for (int g = 0; g < 4; ++g) den += expf(gl[g] - gm);
                    const float pg = 1.0f / den;
                    float e8[8];
#pragma unroll
                    for (int i = 0; i < 8; ++i) e8[i] = lg[4 + gs * 8 + i] * rstd + ber[gs * 8 + i];
                    float v1 = e8[0]; int i1 = 0;
#pragma unroll
                    for (int i = 1; i < 8; ++i) if (e8[i] > v1) { v1 = e8[i]; i1 = i; }
                    float v2 = -3.0e38f; int i2 = 0;
#pragma unroll
                    for (int i = 0; i < 8; ++i) if (i != i1 && e8[i] > v2) { v2 = e8[i]; i2 = i; }
                    const float p2 = expf(v2 - v1), g1 = pg / (1.0f + p2), g2 = pg * p2 / (1.0f + p2);
                    const int ea = gs * 8 + i1, eb = gs * 8 + i2;
                    const int pa = (int)atomicAdd((unsigned*)(ctl + CW_CNT + ea), 1u), pb = (int)atomicAdd((unsigned*)(ctl + CW_CNT + eb), 1u);
                    list[(size_t)ea * 16384 + pa] = t; glist[(size_t)ea * 16384 + pa] = g1; list[(size_t)eb * 16384 + pb] = t; glist[(size_t)eb * 16384 + pb] = g2;
                    epos[t * 2] = (ea << 16) | pa; epos[t * 2 + 1] = (eb << 16) | pb;
                }
            }
            __syncthreads();
            { const GAS f32x4* gr = (const GAS f32x4*)n2g + lane; f32x4 gg[4];
#pragma unroll
              for (int j = 0; j < 4; ++j) gg[j] = gr[64 * j];
#pragma unroll
              for (int qb_ = 0; qb_ < 2; ++qb_) { f32x4 v[4][4];
#pragma unroll
                  for (int q = 0; q < 4; ++q) { const GAS f32x4* hr = (const GAS f32x4*)(out + (size_t)(tb + 8 * wave + 4 * qb_ + q) * DM) + lane;
#pragma unroll
                      for (int j = 0; j < 4; ++j) v[q][j] = hr[64 * j]; }
#pragma unroll
                  for (int q = 0; q < 4; ++q) { const int tl = 8 * wave + 4 * qb_ + q; const float rstd = SR[tl]; GAS v2u* o8 = (GAS v2u*)(XN2 + (size_t)(tb + tl) * DM) + lane;
#pragma unroll
                      for (int j = 0; j < 4; ++j) { v2u w; w.x = pk2(v[q][j].x * rstd * gg[j].x, v[q][j].y * rstd * gg[j].y); w.y = pk2(v[q][j].z * rstd * gg[j].z, v[q][j].w * rstd * gg[j].w); o8[64 * j] = w; } } } }
            __syncthreads();
        }
    }
    SEAM(5);
    LAS int* tstart = (LAS int*)(L + MOE_TAB_OFF); LAS int* ecnt = (LAS int*)(L + MOE_TAB_OFF + 256);
    if (IN(6) || IN(7) || IN(8)) {
        if (tid < 32) ecnt[tid] = (int)__hip_atomic_load(ctl + CW_CNT + tid, RLX_AGENT);
        __syncthreads();
        if (tid == 0) { int a = 0; for (int e = 0; e < 32; ++e) { tstart[e] = a; a += (ecnt[e] + 255) >> 8; } tstart[32] = a; }
        __syncthreads();
    }
    if (IN(6)) {
        pg8::MoeOrder<true> S; S.tstart = tstart; S.cnt = ecnt; S.ntiles = tstart[32]; S.G = G; S.c = vcu; S.A = XN2; S.Bt = Wgu_t; S.a_tstep = 0; S.b_estep = (size_t)1024 * 1024 * 2; S.b_tstep = (size_t)256 * 1024 * 2; S.list = list; S.Kb = 2048;
        pg8::EpiSwiGLU E{HDN};
        pg8::gemm_phase<pg8::EpiSwiGLU, pg8::MoeOrder<true>, true>(L, DM, S, E);
    }
    SEAM(6);
    if (IN(7)) {
        pg8::MoeOrder<false> S; S.tstart = tstart; S.cnt = ecnt; S.ntiles = tstart[32]; S.G = G; S.c = vcu; S.A = HDN; S.Bt = Wd_t; S.a_tstep = (size_t)256 * 512 * 2; S.b_estep = (size_t)1024 * 512 * 2; S.b_tstep = (size_t)256 * 512 * 2; S.list = list; S.Kb = 1024;
        pg8::EpiGateBf16 E{Y, glist};
        pg8::gemm_phase<pg8::EpiGateBf16, pg8::MoeOrder<false>, false>(L, DEXP, S, E);
    }
    SEAM(7);
    if (IN(8)) {
        const GAS f32x4* gr = (const GAS f32x4*)fing + lane; f32x4 gg[4];
#pragma unroll
        for (int j = 0; j < 4; ++j) gg[j] = gr[64 * j];
        for (int t0 = gw; t0 < T; t0 += 4 * NGW) {
            int pa[4], pb[4];
#pragma unroll
            for (int q = 0; q < 4; ++q) { const int t = t0 + q * NGW; pa[q] = epos[(t < T ? t : t0) * 2]; pb[q] = epos[(t < T ? t : t0) * 2 + 1]; }
            f32x4 v[4][4]; v2u ya[4][4], yb[4][4];
#pragma unroll
            for (int q = 0; q < 4; ++q) { const int t = (t0 + q * NGW < T) ? t0 + q * NGW : t0;
                const size_t ra = (size_t)tstart[pa[q] >> 16] * 256 + (pa[q] & 0xffff), rb = (size_t)tstart[pb[q] >> 16] * 256 + (pb[q] & 0xffff);
                const GAS f32x4* hr = (const GAS f32x4*)(out + (size_t)t * DM) + lane; const GAS v2u* pya = (const GAS v2u*)(Y + ra * 1024) + lane; const GAS v2u* pyb = (const GAS v2u*)(Y + rb * 1024) + lane;
#pragma unroll
                for (int j = 0; j < 4; ++j) { v[q][j] = hr[64 * j]; ya[q][j] = pya[64 * j]; yb[q][j] = pyb[64 * j]; } }
#pragma unroll
            for (int q = 0; q < 4; ++q) { const int t = t0 + q * NGW; float s = 0.f;
#pragma unroll
                for (int j = 0; j < 4; ++j) { const v2u a = ya[q][j], bq = yb[q][j];
                    v[q][j].x += bflo(a.x) + bflo(bq.x); v[q][j].y += bfhi(a.x) + bfhi(bq.x); v[q][j].z += bflo(a.y) + bflo(bq.y); v[q][j].w += bfhi(a.y) + bfhi(bq.y);
                    s += (v[q][j].x * v[q][j].x + v[q][j].y * v[q][j].y) + (v[q][j].z * v[q][j].z + v[q][j].w * v[q][j].w); }
                const float rstd = 1.0f / sqrtf(wave_sum(s) * (1.f / DM) + EPS);
                if (t < T) { GAS f32x4* orow = (GAS f32x4*)(out + (size_t)t * DM) + lane;
#pragma unroll
                    for (int j = 0; j < 4; ++j) orow[64 * j] = v[q][j] * rstd * gg[j]; } }
        }
    }
#undef IN
#undef SEAM
}

extern "C" void kernel_launch(void* const* d_in, const int* in_sizes, int n_in, void* d_out, int out_size, void* d_ws, size_t ws_size, hipStream_t stream) {
    static int grid = 0;
    if (grid == 0) {
        if (n_in != 20 || in_sizes[0] != T * DM || out_size != T * DM || ws_size < WS_END) { fprintf(stderr, "kernel_launch: unexpected shapes: n_in %d in0 %d out %d ws %zu; nothing launched\n", n_in, n_in > 0 ? in_sizes[0] : -1, out_size, ws_size); grid = -1; return; }
        int dev = 0, cus = 0;
        if (hipGetDevice(&dev) != hipSuccess || hipDeviceGetAttribute(&cus, hipDeviceAttributeMultiprocessorCount, dev) != hipSuccess) { grid = -1; return; }
        if (hipFuncSetAttribute((const void*)mk_fwd, hipFuncAttributeMaxDynamicSharedMemorySize, LDS_BYTES) != hipSuccess) { fprintf(stderr, "kernel_launch: hipFuncSetAttribute failed\n"); grid = -1; return; }
        (void)hipGetLastError();
        grid = cus;
    }
    if (grid < 0) return;
    (void)hipMemsetAsync((char*)d_ws + WS_CTL, 0, CTL_ZERO_BYTES, stream);
    Args a{};
    for (int i = 0; i < 20; ++i) a.in[i] = (const float*)d_in[i];
    a.out = (float*)d_out; a.ws = (unsigned char*)d_ws;
#ifndef MK_N_LAUNCHES
#define MK_N_LAUNCHES 1
#endif
    constexpr int NPH = 9;
    if (MK_N_LAUNCHES == 1) { a.ph_lo = 0; a.ph_hi = NPH; hipLaunchKernelGGL(mk_fwd, dim3(grid), dim3(NWAVES * 64), LDS_BYTES, stream, a); }
    else for (int p = 0; p < NPH; ++p) { a.ph_lo = p; a.ph_hi = p + 1; hipLaunchKernelGGL(mk_fwd, dim3(grid), dim3(NWAVES * 64), LDS_BYTES, stream, a); }
}
```

```cpp
#include <hip/hip_runtime.h>
#include <hip/hip_bf16.h>
#include <cstdio>
#include <cstdint>
#include <cmath>
namespace pg8 {
#define PG8_LAS __attribute__((address_space(3)))
typedef unsigned short bf16_t;
typedef short bf16x8 __attribute__((ext_vector_type(8)));
typedef float f32x4 __attribute__((ext_vector_type(4)));
typedef float f32x2 __attribute__((ext_vector_type(2)));
typedef unsigned u32x4 __attribute__((ext_vector_type(4)));
constexpr int BM = 256, BK = 64, HALF = 128, HTB = HALF * BK * 2  , STAGE_BYTES = 8 * HTB, NXCD = 8, WGM = 8;

__host__ __device__ __forceinline__ int lds_byte(int r, int c) { const int st = (r >> 4) * 2 + (c >> 5), rr = r & 15, cc = c & 31, ob = rr * 64 + cc * 2; return st * 1024 + (ob ^ (((ob >> 9) & 1) << 5)); }
__host__ __device__ __forceinline__ void stage_rc(int b, int& R, int& C) { const int st = b / 1024, sb = b % 1024, swz = sb ^ (((sb >> 9) & 1) << 5); R = (st >> 1) * 16 + swz / 64; C = (st & 1) * 32 + (swz % 64) / 2; }
__host__ __device__ __forceinline__ int perm32(int rho) { const int n = rho >> 4, i = rho & 15; return 8 * (i >> 2) + 4 * n + (i & 3); }

struct Unit { int pm, pn, e, lt, cnt; };
struct Gemm { const bf16_t* A; const bf16_t* Bt; int M, N, K; };

struct StaticOrder {
    int nM, nN, nwg, G, c; const bf16_t* A; const bf16_t* Bt; size_t tstep;
    __device__ void init(const Gemm& g, int G_, int c_) { nM = g.M / BM; nN = g.N / BM; nwg = nM * nN; G = G_; c = c_; A = g.A; Bt = g.Bt; tstep = (size_t)BM * g.K * 2; }
    __device__ bool next(int i, Unit& u) const {
        const long L = (long)i * G + c; if (L >= nwg) return false;
        int wgid = (int)L; { const int q = nwg / NXCD, r = nwg % NXCD, xcd = wgid % NXCD, off = wgid / NXCD; wgid = (xcd < r ? xcd * (q + 1) : r * (q + 1) + (xcd - r) * q) + off; }
        const int nig = WGM * nN, gid = wgid / nig, fm = gid * WGM, gsz = (nM - fm) < WGM ? (nM - fm) : WGM;
        u.pm = fm + ((wgid % nig) % gsz); u.pn = (wgid % nig) / gsz; u.e = 0; u.lt = 0; u.cnt = 0; return true;
    }
    __device__ __forceinline__ const char* a_base(const Unit& u) const { return (const char*)A + (size_t)u.pm * tstep; }
    __device__ __forceinline__ const char* b_base(const Unit& u) const { return (const char*)Bt + (size_t)u.pn * tstep; }
    __device__ __forceinline__ unsigned row_off(const Unit&, int) const { return 0u; }
};
template <bool GATHER> struct MoeOrder {
    const PG8_LAS int* tstart; const PG8_LAS int* cnt; int ntiles, G, c;
    const bf16_t* A; const bf16_t* Bt; size_t a_tstep, b_estep, b_tstep; const int* list; int Kb  ;
    __device__ bool next(int i, Unit& u) const {
        const long L = (long)i * G + c; if (L >= 4L * ntiles) return false;
        const int rt = (int)(L >> 2); u.pn = (int)(L & 3); u.pm = rt;
        int e = 0;
#pragma unroll
        for (int k = 1; k < 32; ++k) e += (rt >= tstart[k]) ? 1 : 0;
        e = __builtin_amdgcn_readfirstlane(e);
        u.e = e; u.lt = __builtin_amdgcn_readfirstlane(rt - tstart[e]); u.cnt = __builtin_amdgcn_readfirstlane(cnt[e]); return true;
    }
    __device__ __forceinline__ const char* a_base(const Unit& u) const { return GATHER ? (const char*)A : (const char*)A + (size_t)u.pm * a_tstep; }
    __device__ __forceinline__ const char* b_base(const Unit& u) const { return (const char*)Bt + (size_t)u.e * b_estep + (size_t)u.pn * b_tstep; }
    __device__ __forceinline__ unsigned row_off(const Unit& u, int R) const { const int pos = u.lt * BM + R; const int tok = (pos < u.cnt) ? list[(size_t)u.e * 16384 + pos] : 0; return (unsigned)tok * (unsigned)Kb; }
};

__device__ __forceinline__ unsigned cvt_pk_bf16(float lo, float hi) { unsigned r; asm volatile("v_cvt_pk_bf16_f32 %0, %1, %2" : "=v"(r) : "v"(lo), "v"(hi)); return r; }

struct EpiBf16 {
    static constexpr bool PERM = true;
    bf16_t* O; int ldc; int split_cols; size_t split_stride; float scale0;
    __device__ __forceinline__ void operator()(const f32x4 (&acc)[2][2][4][2], const Unit& u, int wr, int wc, int fr, int fq) const {
        const int row0 = u.pm * BM + wr * 64 + fr; int colt = u.pn * BM; bf16_t* base = O;
        float sc = 1.f; if (split_cols) { const int t = colt / split_cols; base += (size_t)t * split_stride; colt -= t * split_cols; if (t == 0) sc = scale0; }
        const int col0 = colt + wc * 32 + 8 * fq;
#pragma unroll
        for (int ai = 0; ai < 2; ++ai)
#pragma unroll
            for (int m = 0; m < 4; ++m) { bf16_t* rowp = base + (size_t)(row0 + ai * HALF + m * 16) * ldc + col0;
#pragma unroll
                for (int bj = 0; bj < 2; ++bj) { f32x4 v0 = acc[ai][bj][m][0] * sc, v1 = acc[ai][bj][m][1] * sc;
                    u32x4 w; w.x = cvt_pk_bf16(v0[0], v0[1]); w.y = cvt_pk_bf16(v0[2], v0[3]); w.z = cvt_pk_bf16(v1[0], v1[1]); w.w = cvt_pk_bf16(v1[2], v1[3]);
                    *(u32x4*)(rowp + bj * HALF) = w; } }
    }
};
struct EpiResF32 {
    static constexpr bool PERM = false;
    const float* base; float* out; int ldc;
    __device__ __forceinline__ void operator()(const f32x4 (&acc)[2][2][4][2], const Unit& u, int wr, int wc, int fr, int fq) const {
        const int col0 = u.pn * BM + wc * 32 + 4 * fq;
#pragma unroll
        for (int ai = 0; ai < 2; ++ai)
#pragma unroll
            for (int m = 0; m < 4; ++m) { const size_t off = (size_t)(u.pm * BM + ai * HALF + wr * 64 + m * 16 + fr) * ldc + col0;
#pragma unroll
                for (int bj = 0; bj < 2; ++bj)
#pragma unroll
                    for (int n = 0; n < 2; ++n) { const f32x4 bs = *(const f32x4*)(base + off + bj * HALF + n * 16); *(f32x4*)(out + off + bj * HALF + n * 16) = bs + acc[ai][bj][m][n]; } }
    }
};
struct EpiSwiGLU {
    static constexpr bool PERM = true;
    bf16_t* O;
    __device__ __forceinline__ void operator()(const f32x4 (&acc)[2][2][4][2], const Unit& u, int wr, int wc, int fr, int fq) const {
        const int row0 = u.pm * BM + wr * 64 + fr, col0 = u.pn * HALF + wc * 32 + 8 * fq;
#pragma unroll
        for (int ai = 0; ai < 2; ++ai)
#pragma unroll
            for (int m = 0; m < 4; ++m) { float hv[8];
#pragma unroll
                for (int n = 0; n < 2; ++n)
#pragma unroll
                    for (int j = 0; j < 4; ++j) { const float g = acc[ai][0][m][n][j], up = acc[ai][1][m][n][j];
                        const float sg = __builtin_amdgcn_rcpf(1.0f + __builtin_amdgcn_exp2f(-1.4426950408889634f * g)); hv[n * 4 + j] = g * sg * up; }
                u32x4 w; w.x = cvt_pk_bf16(hv[0], hv[1]); w.y = cvt_pk_bf16(hv[2], hv[3]); w.z = cvt_pk_bf16(hv[4], hv[5]); w.w = cvt_pk_bf16(hv[6], hv[7]);
                *(u32x4*)(O + (size_t)(row0 + ai * HALF + m * 16) * 512 + col0) = w; }
    }
};
struct EpiGateBf16 {
    static constexpr bool PERM = true;
    bf16_t* O; const float* glist;
    __device__ __forceinline__ void operator()(const f32x4 (&acc)[2][2][4][2], const Unit& u, int wr, int wc, int fr, int fq) const {
        const int col0 = u.pn * BM + wc * 32 + 8 * fq;
#pragma unroll
        for (int ai = 0; ai < 2; ++ai)
#pragma unroll
            for (int m = 0; m < 4; ++m) { const int R = ai * HALF + wr * 64 + m * 16 + fr, pos = u.lt * BM + R; const float gt = (pos < u.cnt) ? glist[(size_t)u.e * 16384 + pos] : 0.f;
                bf16_t* rowp = O + (size_t)(u.pm * BM + R) * 1024 + col0;
#pragma unroll
                for (int bj = 0; bj < 2; ++bj) { f32x4 v0 = acc[ai][bj][m][0] * gt, v1 = acc[ai][bj][m][1] * gt;
                    u32x4 w; w.x = cvt_pk_bf16(v0[0], v0[1]); w.y = cvt_pk_bf16(v0[2], v0[3]); w.z = cvt_pk_bf16(v1[0], v1[1]); w.w = cvt_pk_bf16(v1[2], v1[3]);
                    *(u32x4*)(rowp + bj * HALF) = w; } }
    }
};

template <class Epi, class Sched, bool GATHER>
__device__ __forceinline__ void gemm_phase(PG8_LAS unsigned char* lds, const int K, const Sched& S, const Epi& E) {
    const int tid = threadIdx.x, wid = __builtin_amdgcn_readfirstlane(tid >> 6), lane = tid & 63, wr = wid >> 2, wc = wid & 3, fr = lane & 15, fq = lane >> 4;
    const int nt = K / BK;
    unsigned voffA[2], voffB[2]; int rowA[2];
#pragma unroll
    for (int i = 0; i < 2; ++i) { int R, C; stage_rc(tid * 16 + i * 8192, R, C); const int Rb = Epi::PERM ? ((R & ~31) + perm32(R & 31)) : R;
        rowA[i] = R; voffA[i] = GATHER ? (unsigned)C * 2u : (unsigned)(R * K + C) * 2u; voffB[i] = (unsigned)(Rb * K + C) * 2u; }
    const size_t kstep = (size_t)(BK * 2);
    const size_t hstep = (size_t)HALF * K * 2;
    const size_t hstepA = GATHER ? 0 : hstep;
    const unsigned ldsw = (unsigned)wid * 1024u;
    const int aoff = lds_byte(wr * 64 + fr, fq * 8), boff = lds_byte(wc * 32 + fr, fq * 8);
#define PG8_SA(b, h) (((b) * 2 + (h)) * HTB)
#define PG8_SB(b, h) ((4 + (b) * 2 + (h)) * HTB)
#define PG8_STAGE(bufoff, gbase, voff) do { _Pragma("unroll") for (int _i = 0; _i < 2; ++_i) \
        __builtin_amdgcn_global_load_lds((const unsigned*)((const char*)(gbase) + (voff)[_i]), (PG8_LAS unsigned*)(lds + (bufoff) + ldsw + _i * 8192), 16, 0, 0); } while (0)
#define PG8_STAGE_A(bufoff, gbase, h, VO) do { _Pragma("unroll") for (int _i = 0; _i < 2; ++_i) \
        __builtin_amdgcn_global_load_lds((const unsigned*)((const char*)(gbase) + (size_t)(h) * hstepA + (GATHER ? (VO)[2 * (h) + _i] : voffA[_i])), (PG8_LAS unsigned*)(lds + (bufoff) + ldsw + _i * 8192), 16, 0, 0); } while (0)
#define PG8_LDA(dst, b, h) do { _Pragma("unroll") for (int m = 0; m < 4; ++m) _Pragma("unroll") for (int k = 0; k < 2; ++k) dst[m][k] = *(const PG8_LAS bf16x8*)(lds + PG8_SA(b, h) + aoff + m * 2048 + k * 1024); } while (0)
#define PG8_LDB(dst, b, h) do { _Pragma("unroll") for (int n = 0; n < 2; ++n) _Pragma("unroll") for (int k = 0; k < 2; ++k) dst[n][k] = *(const PG8_LAS bf16x8*)(lds + PG8_SB(b, h) + boff + n * 2048 + k * 1024); } while (0)
#define PG8_MMA(ai, bj, At, Bt) do { __builtin_amdgcn_s_setprio(1); _Pragma("unroll") for (int m = 0; m < 4; ++m) _Pragma("unroll") for (int n = 0; n < 2; ++n) _Pragma("unroll") for (int k = 0; k < 2; ++k) \
        acc[ai][bj][m][n] = __builtin_amdgcn_mfma_f32_16x16x32_bf16(Bt[n][k], At[m][k], acc[ai][bj][m][n], 0, 0, 0); __builtin_amdgcn_s_setprio(0); } while (0)
#define PG8_WAIT_V(n) asm volatile("s_waitcnt vmcnt(" #n ")" ::: "memory")
#define PG8_WAIT_L(n) asm volatile("s_waitcnt lgkmcnt(" #n ")" ::: "memory")
#define PG8_BAR __builtin_amdgcn_s_barrier()
#define PG8_SCHED __builtin_amdgcn_sched_barrier(0)
    Unit cur, nxt; int ui = 0;
    if (!S.next(0, cur)) return;
    f32x4 acc[2][2][4][2];
#pragma unroll
    for (int a = 0; a < 2; ++a)
#pragma unroll
        for (int b = 0; b < 2; ++b)
#pragma unroll
            for (int m = 0; m < 4; ++m)
#pragma unroll
                for (int n = 0; n < 2; ++n) acc[a][b][m][n] = (f32x4){0.f, 0.f, 0.f, 0.f};
    bf16x8 At[4][2], B0[2][2], B1[2][2];
    const char* cA = S.a_base(cur); const char* cB = S.b_base(cur);
    unsigned vc[4] = {0u, 0u, 0u, 0u}, vn[4] = {0u, 0u, 0u, 0u};
    if constexpr (GATHER) {
#pragma unroll
        for (int h = 0; h < 2; ++h)
#pragma unroll
            for (int i = 0; i < 2; ++i) vc[2 * h + i] = S.row_off(cur, h * HALF + rowA[i]) + voffA[i];
    }
    PG8_STAGE(PG8_SB(0, 0), cB, voffB); PG8_STAGE(PG8_SB(0, 1), cB + hstep, voffB); PG8_STAGE_A(PG8_SA(0, 0), cA, 0, vc); PG8_STAGE_A(PG8_SA(0, 1), cA, 1, vc);
    if (wr == 1) PG8_BAR;
    PG8_WAIT_V(2); PG8_BAR;
    PG8_STAGE(PG8_SB(1, 0), cB + kstep, voffB); PG8_STAGE_A(PG8_SA(1, 0), cA + kstep, 0, vc); PG8_STAGE(PG8_SB(1, 1), cB + hstep + kstep, voffB);
    PG8_WAIT_V(6); PG8_BAR;
    for (;;) {
        const bool has_next = S.next(ui + 1, nxt);
        const char* nA = has_next ? S.a_base(nxt) : cA; const char* nB = has_next ? S.b_base(nxt) : cB;
        if constexpr (GATHER) {
#pragma unroll
            for (int h = 0; h < 2; ++h)
#pragma unroll
                for (int i = 0; i < 2; ++i) vn[2 * h + i] = has_next ? (S.row_off(nxt, h * HALF + rowA[i]) + voffA[i]) : vc[2 * h + i];
        }
        for (int t = 0; t < nt; t += 2) {
            const bool last = (t == nt - 2);
            const char* a1 = cA + (size_t)(t + 1) * kstep;
            const char* a2 = last ? nA : cA + (size_t)(t + 2) * kstep; const char* b2 = last ? nB : cB + (size_t)(t + 2) * kstep;
            const char* a3 = a2 + kstep; const char* b3 = b2 + kstep;
            unsigned v2[4];
#pragma unroll
            for (int q = 0; q < 4; ++q) v2[q] = last ? vn[q] : vc[q];
            PG8_LDB(B0, 0, 0); PG8_LDB(B1, 0, 1); PG8_SCHED; PG8_LDA(At, 0, 0); PG8_STAGE_A(PG8_SA(1, 1), a1, 1, vc);
            PG8_WAIT_V(8); PG8_WAIT_L(0); PG8_BAR; PG8_MMA(0, 0, At, B0); PG8_MMA(0, 1, At, B1); PG8_BAR; PG8_SCHED;
            PG8_LDA(At, 0, 1); PG8_STAGE(PG8_SB(0, 0), b2, voffB); PG8_STAGE(PG8_SB(0, 1), b2 + hstep, voffB); PG8_STAGE_A(PG8_SA(0, 0), a2, 0, v2);
            PG8_WAIT_V(8); PG8_WAIT_L(0); PG8_BAR; PG8_MMA(1, 0, At, B0); PG8_MMA(1, 1, At, B1); PG8_BAR; PG8_SCHED;
            PG8_LDB(B0, 1, 0); PG8_LDB(B1, 1, 1); PG8_SCHED; PG8_LDA(At, 1, 0); PG8_STAGE_A(PG8_SA(0, 1), a2, 1, v2);
            PG8_WAIT_V(8); PG8_WAIT_L(0); PG8_BAR; PG8_MMA(0, 0, At, B0); PG8_MMA(0, 1, At, B1); PG8_BAR; PG8_SCHED;
            PG8_LDA(At, 1, 1); PG8_STAGE(PG8_SB(1, 0), b3, voffB); PG8_STAGE(PG8_SB(1, 1), b3 + hstep, voffB); PG8_STAGE_A(PG8_SA(1, 0), a3, 0, v2);
            PG8_WAIT_V(8); PG8_WAIT_L(0); PG8_BAR; PG8_MMA(1, 0, At, B0); PG8_MMA(1, 1, At, B1); PG8_BAR; PG8_SCHED;
        }
        if (wr == 0) PG8_BAR;
        E(acc, cur, wr, wc, fr, fq);
        if (!has_next) break;
#pragma unroll
        for (int a = 0; a < 2; ++a)
#pragma unroll
            for (int b = 0; b < 2; ++b)
#pragma unroll
                for (int m = 0; m < 4; ++m)
#pragma unroll
                    for (int n = 0; n < 2; ++n) acc[a][b][m][n] = (f32x4){0.f, 0.f, 0.f, 0.f};
        cur = nxt; cA = nA; cB = nB; ++ui;
#pragma unroll
        for (int q = 0; q < 4; ++q) vc[q] = vn[q];
        if (wr == 1) PG8_BAR;
    }
    PG8_WAIT_V(0);
    PG8_BAR;
#undef PG8_SA
#undef PG8_SB
#undef PG8_STAGE
#undef PG8_STAGE_A
#undef PG8_LDA
#undef PG8_LDB
#undef PG8_MMA
#undef PG8_WAIT_V
#undef PG8_WAIT_L
#undef PG8_BAR
#undef PG8_SCHED
}
}
namespace attn {
using bf16x8 = __attribute__((ext_vector_type(8))) short;
using s16x4 = __attribute__((ext_vector_type(4))) short;
using f32x16 = __attribute__((ext_vector_type(16))) float;
using u32x4 = __attribute__((ext_vector_type(4))) unsigned;
typedef unsigned short bf16_t;
constexpr int SEQ = 8192, NW = 8, QBLK = 32, QB = QBLK * NW, KVBLK = 64, NTILE = SEQ / KVBLK, PITCH = 512;
constexpr int KSLOT = 8192, VSLOT = 16384;
constexpr int LDS_K = 0, LDS_V = 3 * KSLOT, LDS_WS = LDS_V + 3 * VSLOT, LDS_OST = LDS_WS + NW * 256, LDS_BYTES = LDS_OST + NW * 8192;
#define SBAR() __builtin_amdgcn_sched_barrier(0)
#define PIN(x) asm volatile("" : "+v"(x))
#define MFMA32(a, b, c) __builtin_amdgcn_mfma_f32_32x32x16_bf16(a, b, c, 0, 0, 0)
#define WAIT_BAR(N) asm volatile("s_waitcnt vmcnt(" #N ") lgkmcnt(0)\n\ts_barrier" ::: "memory")
__device__ __forceinline__ constexpr int crow0(int r) { return (r & 3) + 8 * (r >> 2); }
__device__ __forceinline__ void glds16(const void* g, unsigned lds_base) {
    unsigned sv; asm volatile("s_mov_b32 %0, m0\n\ts_mov_b32 m0, %2\n\ts_nop 0\n\tglobal_load_lds_dwordx4 %1, off\n\ts_mov_b32 m0, %0" : "=&s"(sv) : "v"(g), "s"(lds_base) : "memory"); }
typedef float f32x2_t __attribute__((ext_vector_type(2))); typedef __bf16 bf16x2_t __attribute__((ext_vector_type(2)));
__device__ __forceinline__ unsigned cvtpk(float lo, float hi) { f32x2_t v = {lo, hi}; bf16x2_t b = __builtin_convertvector(v, bf16x2_t); return __builtin_bit_cast(unsigned, b); }
typedef __attribute__((address_space(3))) const char* lds_cptr;
typedef short v4i16_t __attribute__((ext_vector_type(4)));
__device__ __forceinline__ bf16x8 kld(lds_cptr p) { return *(const __attribute__((address_space(3))) bf16x8*)p; }
__device__ __forceinline__ s16x4 vtr(lds_cptr p) { return __builtin_bit_cast(s16x4, __builtin_amdgcn_ds_read_tr16_b64_v4i16((__attribute__((address_space(3))) v4i16_t*)p)); }
#define MX3(a, b, c) __builtin_fmaxf(__builtin_fmaxf((a), (b)), (c))
__device__ __forceinline__ float rowmax(const f32x16& p0, const f32x16& p1) {
    float a = MX3(p0[0], p0[1], p1[0]), b = MX3(p0[2], p0[3], p1[1]); a = MX3(a, p1[2], p1[3]);
#pragma unroll
    for (int r = 4; r < 16; r += 4) { a = MX3(a, p0[r], p0[r + 1]); b = MX3(b, p0[r + 2], p0[r + 3]); a = MX3(a, p1[r], p1[r + 1]); b = MX3(b, p1[r + 2], p1[r + 3]); }
    float m = __builtin_fmaxf(a, b); auto rr = __builtin_amdgcn_permlane32_swap(__float_as_uint(m), __float_as_uint(m), false, false);
    return __builtin_fmaxf(__uint_as_float(rr[0]), __uint_as_float(rr[1])); }
__device__ __forceinline__ float bf2f(short s) { return __uint_as_float(((unsigned)(unsigned short)s) << 16); }
__device__ __forceinline__ void build_c(f32x16& C, int side, float dj, float sg2, float mhat) {
    if (side == 0) {
#pragma unroll
        for (int r = 0; r < 16; ++r) C[r] = __builtin_fmaf(-sg2, __builtin_fabsf(dj + (float)crow0(r)), -mhat);
    } else {
        const float ss = (side > 0) ? -sg2 : sg2, cl = __builtin_fmaf(ss, dj, -mhat);
#pragma unroll
        for (int r = 0; r < 16; ++r) C[r] = __builtin_fmaf(ss, (float)crow0(r), cl);
    }
}

template <int THRL>
__device__ __forceinline__ void attn_unit(int b, int h, int c, int qb, int tlo, int thi, float sg2, const bf16_t* Q, const bf16_t* __restrict__ K, const bf16_t* __restrict__ V, bf16_t* AO, char* lds) {
    const int tid = threadIdx.x, lane = tid & 63, r32 = lane & 31, hi = lane >> 5; const int wid = __builtin_amdgcn_readfirstlane(tid >> 6);
    const long rowbase = (long)b * SEQ; const int q0 = qb * QB, iw0 = q0 + wid * QBLK, n = thi - tlo + 1;
    const bf16_t* Qw = Q + (rowbase + iw0) * PITCH + h * 128 + c * 64;
    const bf16_t* Kh = K + rowbase * PITCH + h * 128 + c * 64; const bf16_t* Vh = V + rowbase * PITCH + h * 128;
    const unsigned lds0 = (unsigned)(uintptr_t)lds; float* wsf = (float*)(lds + LDS_WS) + wid * 64;
    const bf16_t* ksrc = Kh + (long)tlo * KVBLK * PITCH + (long)lane * PITCH + wid * 8;
    const bf16_t* vsrc = Vh + (long)tlo * KVBLK * PITCH + (long)(32 * (wid & 1) + (lane >> 2)) * PITCH + (wid >> 1) * 32 + (lane & 3) * 8;
    const unsigned kdst = lds0 + LDS_K + wid * 1024, vdst = lds0 + LDS_V + wid * 2048;
#define DMA_K(s, slot) glds16(ksrc + (long)(s) * KVBLK * PITCH, (unsigned)__builtin_amdgcn_readfirstlane(kdst + (slot) * KSLOT))
#define DMA_V(s, slot) do { glds16(vsrc + (long)(s) * KVBLK * PITCH, (unsigned)__builtin_amdgcn_readfirstlane(vdst + (slot) * VSLOT)); \
                            glds16(vsrc + (long)(s) * KVBLK * PITCH + 16 * PITCH, (unsigned)__builtin_amdgcn_readfirstlane(vdst + (slot) * VSLOT + 1024)); } while (0)
    const lds_cptr vp0 = (lds_cptr)lds + LDS_V + ((lane >> 4) & 1) * 32 + (lane & 3) * 8 + (4 * hi + ((lane & 15) >> 2)) * 64;
    const lds_cptr kp0 = (lds_cptr)lds + LDS_K + hi * 1024 + r32 * 16;
    DMA_K(0, 0); DMA_V(0, 0); DMA_K(1, 1); DMA_K(2, 2);
    bf16x8 qr[4];
#pragma unroll
    for (int d0 = 0; d0 < 4; ++d0) qr[d0] = *reinterpret_cast<const bf16x8*>(&Qw[(long)r32 * PITCH + d0 * 16 + hi * 8]);
    float mhat;
    { const bf16_t* Kd = Kh + (long)(iw0 + r32) * PITCH; float s = 0.f;
#pragma unroll
      for (int d0 = 0; d0 < 4; ++d0) { const bf16x8 kk = *reinterpret_cast<const bf16x8*>(&Kd[d0 * 16 + hi * 8]);
#pragma unroll
          for (int j = 0; j < 8; ++j) s = __builtin_fmaf(bf2f(qr[d0][j]), bf2f(kk[j]), s); }
      auto rr = __builtin_amdgcn_permlane32_swap(__float_as_uint(s), __float_as_uint(s), false, false); mhat = __uint_as_float(rr[0]) + __uint_as_float(rr[1]); }
    float l_reg = 0.f; f32x16 o[4]; o[0] = f32x16{}; o[1] = f32x16{}; o[2] = f32x16{}; o[3] = f32x16{};
    const float fi = (float)(4 * hi - (iw0 + r32));
    bool resc = false;
    f32x16 C0, C1; bf16x8 kf[8]; u32x4 pw0, pw1, pw2, pw3;
    pw0 = u32x4{}; pw1 = u32x4{}; pw2 = u32x4{}; pw3 = u32x4{};
    int s_prev = 0, s_cur = 0, s_next = 1;
#define ROT() do { s_prev = s_cur; s_cur = s_next; s_next = (s_next == 2) ? 0 : s_next + 1; } while (0)
#define EX(v) __builtin_amdgcn_exp2f(v)
#define RESC() do { if (resc) { asm volatile("s_waitcnt lgkmcnt(0)" ::: "memory"); _Pragma("unroll") for (int d_ = 0; d_ < 4; ++d_) _Pragma("unroll") for (int r = 0; r < 16; ++r) o[d_][r] *= wsf[crow0(r) + 4 * hi]; } } while (0)
    asm volatile("s_waitcnt vmcnt(0) lgkmcnt(0)\n\ts_barrier" ::: "memory");
#pragma unroll
    for (int f = 0; f < 8; ++f) kf[f] = kld(kp0 + (f >> 1) * 2048 + (f & 1) * 512);
    asm volatile("s_waitcnt lgkmcnt(0)\n\ts_barrier" ::: "memory");
#define PKW(P, i) cvtpk(P[i], P[i + 1])
#define PAF(k) __builtin_bit_cast(bf16x8, pw##k)
#define VFRG(lo, hi_) (bf16x8){lo[0], lo[1], lo[2], lo[3], hi_[0], hi_[1], hi_[2], hi_[3]}
#define VRD(f) do { vlo[f] = vtr(vp_ + (((f) & 3) * 4096 + ((f) >> 2) * 1024)); vhi[f] = vtr(vp_ + (((f) & 3) * 4096 + ((f) >> 2) * 1024 + 512)); } while (0)
#define STEP(s, FIRST, GK, GV, GL) do { SBAR(); \
    const int jt_ = (tlo + (s)) * KVBLK; const lds_cptr vp_ = vp0 + s_prev * VSLOT; s16x4 vlo[16], vhi[16]; \
    { const int d0_ = jt_ - iw0, d1_ = jt_ + 32 - iw0; \
      build_c(C0, (d0_ > 0) - (d0_ < 0), (float)jt_ + fi, sg2, mhat); build_c(C1, (d1_ > 0) - (d1_ < 0), (float)(jt_ + 32) + fi, sg2, mhat); } \
    if (!(FIRST)) { VRD(0); VRD(1); } SBAR(); \
    C0 = MFMA32(kf[0], qr[0], C0); C1 = MFMA32(kf[1], qr[0], C1); SBAR(); \
    if (!(FIRST)) { VRD(2); VRD(3); } SBAR(); \
    C0 = MFMA32(kf[2], qr[1], C0); C1 = MFMA32(kf[3], qr[1], C1); SBAR(); \
    C0 = MFMA32(kf[4], qr[2], C0); C1 = MFMA32(kf[5], qr[2], C1); SBAR(); \
    C0 = MFMA32(kf[6], qr[3], C0); C1 = MFMA32(kf[7], qr[3], C1); SBAR(); \
    if (GK) DMA_K((s) + 3, s_cur); if (GV) DMA_V((s) + 1, s_next); \
    { const float rm = rowmax(C0, C1); resc = false; \
      if (__builtin_expect(__any(rm > (float)THRL), 0)) { const float dl = __builtin_fmaxf(rm, 0.f); mhat += dl; \
          _Pragma("unroll") for (int r = 0; r < 16; ++r) { C0[r] -= dl; C1[r] -= dl; } \
          const float f = EX(-dl); l_reg *= f; if (hi == 0) wsf[r32] = f; resc = true; } } \
    SBAR(); \
    float sacc = 0.f; u32x4 nw0, nw1, nw2, nw3; \
    _Pragma("unroll") for (int g = 0; g < 16; ++g) { \
        if (!(FIRST)) { const int ks_ = g >> 2, db_ = g & 3; \
            if (g + 4 < 16) { VRD(g + 4); } \
            const bf16x8 pa_ = (ks_ == 0) ? PAF(0) : (ks_ == 1) ? PAF(1) : (ks_ == 2) ? PAF(2) : PAF(3); \
            o[db_] = MFMA32(pa_, VFRG(vlo[g], vhi[g]), o[db_]); } \
        if (GL) { if (g >= 4 && g < 12) { kf[g - 4] = kld(kp0 + s_next * KSLOT + ((g - 4) >> 1) * 2048 + ((g - 4) & 1) * 512); } } \
        if (g < 8) { C0[2 * g] = EX(C0[2 * g]); C0[2 * g + 1] = EX(C0[2 * g + 1]); sacc += C0[2 * g]; sacc += C0[2 * g + 1]; } \
        else { C1[2 * g - 16] = EX(C1[2 * g - 16]); C1[2 * g - 15] = EX(C1[2 * g - 15]); sacc += C1[2 * g - 16]; sacc += C1[2 * g - 15]; } \
        if (g == 0) nw0[0] = PKW(C0, 0); if (g == 1) nw0[1] = PKW(C0, 2); if (g == 2) nw0[2] = PKW(C0, 4); if (g == 3) nw0[3] = PKW(C0, 6); \
        if (g == 4) nw1[0] = PKW(C0, 8); if (g == 5) nw1[1] = PKW(C0, 10); if (g == 6) nw1[2] = PKW(C0, 12); if (g == 7) nw1[3] = PKW(C0, 14); \
        if (g == 8) nw2[0] = PKW(C1, 0); if (g == 9) nw2[1] = PKW(C1, 2); if (g == 10) nw2[2] = PKW(C1, 4); if (g == 11) nw2[3] = PKW(C1, 6); \
        if (g == 12) nw3[0] = PKW(C1, 8); if (g == 13) nw3[1] = PKW(C1, 10); if (g == 14) nw3[2] = PKW(C1, 12); if (g == 15) nw3[3] = PKW(C1, 14); \
        PIN(sacc); SBAR(); } \
    l_reg += sacc; pw0 = nw0; pw1 = nw1; pw2 = nw2; pw3 = nw3; \
    } while (0)
    STEP(0, true, true, true, true); WAIT_BAR(3); RESC(); ROT();
    int s = 1;
    for (; s + 3 < n; ++s) { STEP(s, false, true, true, true); WAIT_BAR(3); RESC(); ROT(); }
    STEP(s, false, false, true, true); WAIT_BAR(2); RESC(); ROT(); ++s;
    STEP(s, false, false, true, true); WAIT_BAR(2); RESC(); ROT(); ++s;
    STEP(s, false, false, false, false); WAIT_BAR(0); RESC(); ROT();
    { const lds_cptr vp_ = vp0 + s_prev * VSLOT; s16x4 vlo[16], vhi[16];
#pragma unroll
      for (int g = 0; g < 16; ++g) VRD(g);
#pragma unroll
      for (int g = 0; g < 16; ++g) { const int ks_ = g >> 2, db_ = g & 3; const bf16x8 pa_ = (ks_ == 0) ? PAF(0) : (ks_ == 1) ? PAF(1) : (ks_ == 2) ? PAF(2) : PAF(3);
          o[db_] = MFMA32(pa_, VFRG(vlo[g], vhi[g]), o[db_]); } }
    { auto rr = __builtin_amdgcn_permlane32_swap(__float_as_uint(l_reg), __float_as_uint(l_reg), false, false); l_reg = __uint_as_float(rr[0]) + __uint_as_float(rr[1]); }
    if (hi == 0) wsf[32 + r32] = l_reg; asm volatile("s_waitcnt lgkmcnt(0)" ::: "memory");
    float rli[16];
#pragma unroll
    for (int r = 0; r < 16; ++r) rli[r] = __builtin_amdgcn_rcpf(wsf[32 + crow0(r) + 4 * hi]);
    bf16_t* Ow = AO + (rowbase + iw0) * PITCH + h * 128; __hip_bfloat16* stg = (__hip_bfloat16*)(lds + LDS_OST) + wid * 4096;
#pragma unroll
    for (int r = 0; r < 16; ++r) { const int orow = crow0(r) + 4 * hi;
#pragma unroll
        for (int db = 0; db < 4; ++db) stg[orow * 128 + db * 32 + r32] = __float2bfloat16(o[db][r] * rli[r]); }
    asm volatile("s_waitcnt lgkmcnt(0)" ::: "memory");
#pragma unroll
    for (int i = 0; i < 8; ++i) { const int row = i * 4 + (lane >> 4), ch = lane & 15; *(u32x4*)(Ow + (long)row * PITCH + ch * 8) = *(const u32x4*)(stg + row * 128 + ch * 8); }
    asm volatile("s_waitcnt lgkmcnt(0)\n\ts_barrier" ::: "memory");
#undef DMA_K
#undef DMA_V
#undef ROT
#undef EX
#undef RESC
#undef PKW
#undef PAF
#undef VFRG
#undef VRD
#undef STEP
}
#undef SBAR
#undef PIN
#undef MFMA32
#undef WAIT_BAR
#undef MX3
}
constexpr int NWAVES = 8;
constexpr int BATCH = 2, SEQ = 8192, DM = 1024, T = BATCH * SEQ, NEXP = 32, DEXP = 512;
constexpr float EPS = 1e-6f, LAM_INIT = 0.2f;
constexpr float C2 = 0.125f * 1.4426950408889634f;
constexpr float LOG2E = 1.4426950408889634f;
constexpr int ATT_THR = 8;

constexpr size_t MiB = 1u << 20;
constexpr size_t WS_CTL = 0, CTL_ZERO_BYTES = 65536;
constexpr size_t WS_LIST = 1 * MiB, WS_GLIST = 3 * MiB, WS_EPOS = 5 * MiB;
constexpr size_t WS_WIN = 6 * MiB, WS_WOUT = 10 * MiB, WS_WGU = 12 * MiB, WS_WD = 76 * MiB;
constexpr size_t WS_QKVU = 108 * MiB;
constexpr size_t WS_XN2 = 108 * MiB;
constexpr size_t WS_Y = 108 * MiB;
constexpr size_t WS_XN1 = 172 * MiB;
constexpr size_t WS_MIX = 172 * MiB;
constexpr size_t WS_AO = 204 * MiB;
constexpr size_t WS_HDN = 204 * MiB;
constexpr size_t WS_END = 244 * MiB;
constexpr int MAXROWS = 40960;
constexpr int CW_CNT = 64;
constexpr int CW_BAR = 4096;
constexpr int LDS_BYTES = 163840;
constexpr int MISC_OFF = LDS_BYTES - 256;
constexpr int MOE_TAB_OFF = 131072;
constexpr int RT_WR = 0, RT_SC = 148032, RT_SQ = 160320, RT_SR = 160576, RT_HI = 160832;

#define GAS __attribute__((address_space(1)))
#define LAS __attribute__((address_space(3)))
typedef unsigned short bf16;
typedef unsigned v4u __attribute__((ext_vector_type(4)));
typedef unsigned v2u __attribute__((ext_vector_type(2)));
typedef float f32x4 __attribute__((ext_vector_type(4)));
typedef GAS unsigned gu32;
#define RLX_AGENT __ATOMIC_RELAXED, __HIP_MEMORY_SCOPE_AGENT
#define LDS_WAIT() asm volatile("s_waitcnt lgkmcnt(0)" ::: "memory")
#define VM_WAIT() asm volatile("s_waitcnt vmcnt(0)" ::: "memory")
__device__ __forceinline__ unsigned f2bf(float f) { unsigned u = __builtin_bit_cast(unsigned, f); return (u + 0x7fffu + ((u >> 16) & 1u)) >> 16; }
__device__ __forceinline__ unsigned pk2(float lo, float hi) { return f2bf(lo) | (f2bf(hi) << 16); }
__device__ __forceinline__ float bflo(unsigned w) { return __uint_as_float(w << 16); }
__device__ __forceinline__ float bfhi(unsigned w) { return __uint_as_float(w & 0xffff0000u); }

#define XB_TMO      128
#define XB_XCNT(j)  (256  + 64 * (j))
#define XB_XSUB(j)  (1280 + 64 * (j))
#define XB_XGEN(j)  (2304 + 64 * (j))
#define XB_TOP      3328
#define XB_TOPGEN   3392
#define XCD_BAR_WORDS 3456
#define XB_SPIN_CAP (1u << 18)
__device__ __forceinline__ unsigned xb_ld(unsigned* p)              { return __hip_atomic_load(p, __ATOMIC_RELAXED, __HIP_MEMORY_SCOPE_AGENT); }
__device__ __forceinline__ unsigned xb_add(unsigned* p, unsigned v) { return __hip_atomic_fetch_add(p, v, __ATOMIC_RELAXED, __HIP_MEMORY_SCOPE_AGENT); }
__device__ __forceinline__ unsigned xb_xcc_id() { return (unsigned)__builtin_amdgcn_s_getreg((3 << 11) | 20) & 0xFu; }
#define XB_SPIN(cond, bar) do { unsigned _sp = 0; while (cond) { __builtin_amdgcn_s_sleep(1); \
    if ((++_sp & 255u) == 0u) { if (xb_ld(&(bar)[XB_TMO])) break; if (_sp > XB_SPIN_CAP) { atomicAdd(&(bar)[XB_TMO], 1u); break; } } } } while (0)
struct XcdBarrier { unsigned* bar; unsigned x; volatile LAS unsigned* st; };
__device__ __forceinline__ XcdBarrier xcd_barrier_post(unsigned* bar, volatile LAS unsigned* st) {
    XcdBarrier b; b.bar = bar; b.x = xb_xcc_id(); b.st = st;
    if (threadIdx.x == 0) (void)xb_add(&bar[XB_XCNT(b.x)], 1u);
    return b;
}
__device__ __forceinline__ void xcd_barrier_complete(unsigned* bar, unsigned x, unsigned& nloc, unsigned& nx) {
    const unsigned G = gridDim.x * gridDim.y * gridDim.z;
    unsigned sum, cnt, mine, sp = 0u;
    for (;;) {
        sum = 0u; cnt = 0u; mine = 0u;
#pragma unroll
        for (unsigned j = 0; j < 16; ++j) { const unsigned c = xb_ld(&bar[XB_XCNT(j)]); sum += c; cnt += (c > 0u) ? 1u : 0u; mine = (j == x) ? c : mine; }
        if (sum == G) break;
        __builtin_amdgcn_s_sleep(1);
        if ((++sp & 255u) == 0u) { if (xb_ld(&bar[XB_TMO])) break; if (sp > XB_SPIN_CAP) { atomicAdd(&bar[XB_TMO], 1u); break; } }
    }
    nloc = mine > 0u ? mine : 1u; nx = cnt > 0u ? cnt : 1u;
}
__device__ __forceinline__ void xcd_barrier(const XcdBarrier& b) {
    asm volatile("s_waitcnt vmcnt(0)" ::: "memory");
    __syncthreads();
    if (threadIdx.x == 0) {
        unsigned* bar = b.bar;
        __builtin_amdgcn_s_waitcnt(0);
        unsigned nloc = b.st[0], nx = b.st[1];
        if (nloc == 0u) { xcd_barrier_complete(bar, b.x, nloc, nx); b.st[0] = nloc; b.st[1] = nx; }
        const unsigned old = xb_add(&bar[XB_XSUB(b.x)], 1u);
        const unsigned gen = old / nloc;
        if (old + 1u == (gen + 1u) * nloc) {
            __builtin_amdgcn_fence(__ATOMIC_RELEASE, "agent");
            asm volatile("s_waitcnt vmcnt(0)" ::: "memory");
            const unsigned og = xb_add(&bar[XB_TOP], 1u);
            const unsigned tg = og / nx;
            if (og + 1u == (tg + 1u) * nx) xb_add(&bar[XB_TOPGEN], 1u);
            else XB_SPIN(xb_ld(&bar[XB_TOPGEN]) == tg, bar);
            __builtin_amdgcn_fence(__ATOMIC_ACQUIRE, "agent");
            xb_add(&bar[XB_XGEN(b.x)], 1u);
            asm volatile("s_waitcnt vmcnt(0)" ::: "memory");
        } else {
            XB_SPIN(xb_ld(&bar[XB_XGEN(b.x)]) == gen, bar);
            __builtin_amdgcn_fence(__ATOMIC_ACQUIRE, "agent");
            asm volatile("s_waitcnt vmcnt(0)" ::: "memory");
        }
    }
    __syncthreads();
}

__device__ __forceinline__ float wave_sum(float v) {
#pragma unroll
    for (int o = 1; o < 64; o <<= 1) v += __shfl_xor(v, o);
    return v;
}
struct TrItem { const float* src; int ldw; bf16* dst; size_t opitch; };
__device__ __forceinline__ void tr_load(const TrItem& I, float (&v)[32], int lane) {
#pragma unroll
    for (int i = 0; i < 32; ++i) v[i] = I.src[(size_t)(2 * i + (lane >> 5)) * I.ldw + (lane & 31)];
}
__device__ __forceinline__ void tr_finish(const TrItem& I, const float (&v)[32], LAS float* scr, int lane) {
#pragma unroll
    for (int i = 0; i < 32; ++i) scr[(2 * i + (lane >> 5)) * 33 + (lane & 31)] = v[i];
    LDS_WAIT(); asm volatile("" ::: "memory");
    const int c = lane & 7;
#pragma unroll
    for (int j = 0; j < 4; ++j) { const int n = (lane >> 3) + 8 * j; const LAS float* sp = scr + (8 * c) * 33 + n;
        v4u o; o.x = pk2(sp[0 * 33], sp[1 * 33]); o.y = pk2(sp[2 * 33], sp[3 * 33]); o.z = pk2(sp[4 * 33], sp[5 * 33]); o.w = pk2(sp[6 * 33], sp[7 * 33]);
        *(GAS v4u*)(I.dst + (size_t)n * I.opitch + 8 * c) = o; }
    LDS_WAIT(); asm volatile("" ::: "memory");
}
template <int NR> __device__ __forceinline__ void rms_rows_to_bf16(const float* x, const float* g, bf16* o, int m0, int stride, int mend, int lane) {
    f32x4 v[NR][4];
#pragma unroll
    for (int k = 0; k < NR; ++k) { const int m = m0 + k * stride; const GAS f32x4* xr = (const GAS f32x4*)(x + (size_t)(m < mend ? m : m0) * DM) + lane;
#pragma unroll
        for (int j = 0; j < 4; ++j) v[k][j] = xr[64 * j]; }
    const GAS f32x4* gr = (const GAS f32x4*)g + lane; f32x4 gg[4];
#pragma unroll
    for (int j = 0; j < 4; ++j) gg[j] = gr[64 * j];
#pragma unroll
    for (int k = 0; k < NR; ++k) { const int m = m0 + k * stride; float s = 0.f;
#pragma unroll
        for (int j = 0; j < 4; ++j) s += (v[k][j].x * v[k][j].x + v[k][j].y * v[k][j].y) + (v[k][j].z * v[k][j].z + v[k][j].w * v[k][j].w);
        const float rstd = 1.0f / sqrtf(wave_sum(s) * (1.f / DM) + EPS);
        if (m < mend) { GAS v2u* o8 = (GAS v2u*)(o + (size_t)m * DM) + lane;
#pragma unroll
            for (int j = 0; j < 4; ++j) { v2u w; w.x = pk2(v[k][j].x * rstd * gg[j].x, v[k][j].y * rstd * gg[j].y); w.y = pk2(v[k][j].z * rstd * gg[j].z, v[k][j].w * rstd * gg[j].w); o8[64 * j] = w; } } }
}

struct Args { const float* in[20]; float* out; unsigned char* ws; int ph_lo, ph_hi; };

__global__ void __launch_bounds__(NWAVES * 64, 2) mk_fwd(Args args) {
    extern __shared__ __attribute__((aligned(16))) unsigned char lds[];
    LAS unsigned char* L = (LAS unsigned char*)lds;
    volatile LAS unsigned* MISC = (volatile LAS unsigned*)(L + MISC_OFF);
    const int tid = threadIdx.x, lane = tid & 63, wave = __builtin_amdgcn_readfirstlane(tid >> 6);
    const int G = gridDim.x; const int bx = blockIdx.x; const int vcu = (G % 8 == 0) ? (bx % 8) * (G / 8) + bx / 8 : bx;
    unsigned char* ws = args.ws;
    gu32* ctl = (gu32*)(ws + WS_CTL);
    const float* x = args.in[0]; const float* n1g = args.in[1]; const float* w_in = args.in[2];
    const float* lq1 = args.in[3]; const float* lk1 = args.in[4]; const float* lq2 = args.in[5]; const float* lk2 = args.in[6];
    const float* subg = args.in[7]; const float* wpool = args.in[8]; const float* pscale = args.in[9]; const float* w_out = args.in[10];
    const float* n2g = args.in[11]; const float* wgr = args.in[12]; const float* bgr = args.in[13]; const float* wer = args.in[14];
    const float* ber = args.in[15]; const float* wgate = args.in[16]; const float* wup = args.in[17]; const float* wdown = args.in[18]; const float* fing = args.in[19];
    float* out = args.out;
    bf16* Win_t = (bf16*)(ws + WS_WIN); bf16* Wout_t = (bf16*)(ws + WS_WOUT); bf16* Wgu_t = (bf16*)(ws + WS_WGU); bf16* Wd_t = (bf16*)(ws + WS_WD);
    bf16* QKVU = (bf16*)(ws + WS_QKVU); bf16* XN1 = (bf16*)(ws + WS_XN1); bf16* MIX = (bf16*)(ws + WS_MIX); bf16* AO = (bf16*)(ws + WS_AO);
    bf16* XN2 = (bf16*)(ws + WS_XN2); bf16* HDN = (bf16*)(ws + WS_HDN); bf16* Y = (bf16*)(ws + WS_Y);
    int* list = (int*)(ws + WS_LIST); float* glist = (float*)(ws + WS_GLIST); int* epos = (int*)(ws + WS_EPOS);
    for (int u = tid; u < 64; u += NWAVES * 64) ((LAS unsigned*)(L + MISC_OFF))[u] = 0u;
    __syncthreads();
    XcdBarrier bar = xcd_barrier_post((unsigned*)(ctl + CW_BAR), MISC + 8);
    const int lo = args.ph_lo, hi = args.ph_hi;
#define IN(k) (lo <= (k) && (k) < hi)
#define SEAM(k) do { if (IN(k) && IN((k) + 1)) xcd_barrier(bar); } while (0)
    const int gw = vcu * NWAVES + wave, NGW = G * NWAVES;

    if (IN(0)) {
        LAS float* scr = (LAS float*)(L + wave * 16384);
        constexpr int I_WIN = 16 * 64, I_WO = 8 * 32, I_G = 16 * 16, I_D = 8 * 32;
        constexpr int NITEMS = I_WIN + I_WO + NEXP * (2 * I_G + I_D);
        auto decode = [&](int it) -> TrItem { TrItem I; int r = it;
            if (r < I_WIN) { const int kb = r / 64, nb = r % 64; I.src = w_in + (size_t)(64 * kb) * 2048 + 32 * nb; I.ldw = 2048; I.dst = Win_t + (size_t)(32 * nb) * 1024 + 64 * kb; I.opitch = 1024; return I; } r -= I_WIN;
            if (r < I_WO) { const int kb = r / 32, nb = r % 32; I.src = w_out + (size_t)(64 * kb) * 1024 + 32 * nb; I.ldw = 1024; I.dst = Wout_t + (size_t)(32 * nb) * 1024 + 64 * kb; I.opitch = 1024; return I; } r -= I_WO;
            const int e = r / (2 * I_G + I_D); r -= e * (2 * I_G + I_D);
            if (r < 2 * I_G) { const int up = r / I_G; r -= up * I_G; const int kb = r / 16, nb = r % 16, n0 = 32 * nb;
                I.src = (up ? wup : wgate) + (size_t)e * 1024 * 512 + (size_t)(64 * kb) * 512 + n0; I.ldw = 512;
                I.dst = Wgu_t + (size_t)e * 1024 * 1024 + (size_t)((n0 >> 7) * 256 + 128 * up + (n0 & 127)) * 1024 + 64 * kb; I.opitch = 1024; return I; }
            r -= 2 * I_G;
            { const int kb = r / 32, nb = r % 32; I.src = wdown + (size_t)e * 512 * 1024 + (size_t)(64 * kb) * 1024 + 32 * nb; I.ldw = 1024; I.dst = Wd_t + (size_t)e * 1024 * 512 + (size_t)(32 * nb) * 512 + 64 * kb; I.opitch = 512; return I; } };
        { float va[32], vb[32]; int it = gw; TrItem Ia, Ib;
          if (it < NITEMS) { Ia = decode(it); tr_load(Ia, va, lane); }
          while (it < NITEMS) {
              const int itb = it + NGW; if (itb < NITEMS) { Ib = decode(itb); tr_load(Ib, vb, lane); }
              tr_finish(Ia, va, scr, lane);
              if (itb >= NITEMS) break;
              const int itc = itb + NGW; if (itc < NITEMS) { Ia = decode(itc); tr_load(Ia, va, lane); }
              tr_finish(Ib, vb, scr, lane);
              it = itc; } }
        for (int m = gw; m < T; m += 4 * NGW) rms_rows_to_bf16<4>(x, n1g, XN1, m, NGW, T, lane);
        __syncthreads();
        for (int id = bx; id < 256; id += G) {
            const int g = id >> 6, kb = (id >> 4) & 3, nb = id & 15;
            LAS float* WoS = (LAS float*)L; LAS float* wps = (LAS float*)(L + 32768);
            { f32x4 t4[4];
#pragma unroll
              for (int q = 0; q < 4; ++q) { const int f = tid + 512 * q, dd = f >> 4, c4 = (f & 15) * 4; t4[q] = *(const GAS f32x4*)(w_out + (size_t)(512 + g * 128 + dd) * 1024 + nb * 64 + c4); }
              float w8[8], p8[8];
#pragma unroll
              for (int q = 0; q < 8; ++q) { const int f = tid + 512 * q, kk = f >> 7, dd = f & 127; w8[q] = wpool[(size_t)(g * 128 + kb * 32 + kk) * 128 + dd]; p8[q] = pscale[g * 128 + dd]; }
#pragma unroll
              for (int q = 0; q < 4; ++q) { const int f = tid + 512 * q; *(LAS f32x4*)(WoS + (f >> 4) * 64 + (f & 15) * 4) = t4[q]; }
#pragma unroll
              for (int q = 0; q < 8; ++q) { const int f = tid + 512 * q; wps[(f >> 7) * 129 + (f & 127)] = w8[q] * p8[q]; } }
            __syncthreads();
            { const int kk = tid >> 4, c4 = (tid & 15) * 4; f32x4 acc = {0.f, 0.f, 0.f, 0.f};
#pragma unroll 8
              for (int dd = 0; dd < 128; ++dd) { const float w = wps[kk * 129 + dd]; const f32x4 wo = *(const LAS f32x4*)(WoS + dd * 64 + c4); acc = acc + wo * w; }
              bf16* dst = Wout_t + (size_t)(nb * 64 + c4) * 1024 + 512 + g * 128 + kb * 32 + kk;
              dst[0] = (bf16)f2bf(acc.x); dst[1024] = (bf16)f2bf(acc.y); dst[2048] = (bf16)f2bf(acc.z); dst[3072] = (bf16)f2bf(acc.w); }
            __syncthreads();
        }
    }
    SEAM(0);
    if (IN(1)) {
        pg8::Gemm g{XN1, Win_t, T, 2048, DM}; pg8::StaticOrder S; S.init(g, G, bx);
        pg8::EpiBf16 E{QKVU, 512, 512, (size_t)T * 512, C2};
        pg8::gemm_phase<pg8::EpiBf16, pg8::StaticOrder, false>(L, DM, S, E);
    }
    SEAM(1);
    if (IN(2)) {
        const int bh = vcu >> 5, qb = vcu & 31, b = bh >> 2, h = bh & 3;
        const float slope = exp2f(-2.0f * (float)(h + 1)), sg2 = slope * LOG2E;
        if (vcu < 256) {
            for (int c = 0; c < 2; ++c)
                attn::attn_unit<ATT_THR>(b, h, c, qb, 0, attn::NTILE - 1, sg2, QKVU, QKVU + (size_t)T * 512, QKVU + (size_t)2 * T * 512, AO + (size_t)c * T * 512, (char*)lds);
        }
    }
    SEAM(2);
    if (IN(3)) {
        float s1 = wave_sum(lq1[lane] * lk1[lane]), s2 = wave_sum(lq2[lane] * lk2[lane]);
        const float lam = expf(s1) - expf(s2) + LAM_INIT;
        const bf16* U = QKVU + (size_t)3 * T * 512;
        float sg[8];
#pragma unroll
        for (int j = 0; j < 8; ++j) sg[j] = subg[(8 * lane + j) & 127] * (1.0f - LAM_INIT);
        for (int t0 = gw * 8; t0 < T; t0 += NGW * 8) {
            v4u a1[8], a2[8], ur[23];
#pragma unroll
            for (int q = 0; q < 8; ++q) { a1[q] = *(const GAS v4u*)(AO + (size_t)(t0 + q) * 512 + 8 * lane); a2[q] = *(const GAS v4u*)(AO + (size_t)(T + t0 + q) * 512 + 8 * lane); }
            const int tt0 = t0 & (SEQ - 1), tb = t0 - tt0;
#pragma unroll
            for (int k = 0; k < 23; ++k) { int j = tt0 - 8 + k; j = j < 0 ? 0 : (j > SEQ - 1 ? SEQ - 1 : j); ur[k] = *(const GAS v4u*)(U + (size_t)(tb + j) * 512 + 8 * lane); }
#pragma unroll
            for (int q = 0; q < 8; ++q) {
                float a[8];
#pragma unroll
                for (int j = 0; j < 4; ++j) { a[2 * j] = bflo(a1[q][j]) - lam * bflo(a2[q][j]); a[2 * j + 1] = bfhi(a1[q][j]) - lam * bfhi(a2[q][j]); }
                float ss = 0.f;
#pragma unroll
                for (int j = 0; j < 8; ++j) ss += a[j] * a[j];
                ss += __shfl_xor(ss, 1); ss += __shfl_xor(ss, 2); ss += __shfl_xor(ss, 4); ss += __shfl_xor(ss, 8);
                const float r = 1.0f / sqrtf(ss * (1.0f / 128.0f) + EPS);
                v4u o; o.x = pk2(a[0] * r * sg[0], a[1] * r * sg[1]); o.y = pk2(a[2] * r * sg[2], a[3] * r * sg[3]); o.z = pk2(a[4] * r * sg[4], a[5] * r * sg[5]); o.w = pk2(a[6] * r * sg[6], a[7] * r * sg[7]);
                *(GAS v4u*)(MIX + (size_t)(t0 + q) * 1024 + 8 * lane) = o;
            }
            const int hw = 1 << (lane >> 4);
#pragma unroll
            for (int q = 0; q < 8; ++q) {
                const int tt = tt0 + q; int jlo = tt - hw, jhi = tt + hw; jlo = jlo < 0 ? 0 : jlo; jhi = jhi > SEQ ? SEQ : jhi;
                float sm[8] = {0.f, 0.f, 0.f, 0.f, 0.f, 0.f, 0.f, 0.f};
#pragma unroll
                for (int k = q; k < q + 16; ++k) { const int j = tt0 - 8 + k; const float wgt = (j >= jlo && j < jhi) ? 1.0f : 0.0f;
#pragma unroll
                    for (int p = 0; p < 4; ++p) { sm[2 * p] = __builtin_fmaf(wgt, bflo(ur[k][p]), sm[2 * p]); sm[2 * p + 1] = __builtin_fmaf(wgt, bfhi(ur[k][p]), sm[2 * p + 1]); } }
                const float ic = 1.0f / (float)(jhi - jlo); const v4u ut = ur[8 + q];
                v4u d; d.x = pk2(sm[0] * ic - bflo(ut[0]), sm[1] * ic - bfhi(ut[0])); d.y = pk2(sm[2] * ic - bflo(ut[1]), sm[3] * ic - bfhi(ut[1]));
                d.z = pk2(sm[4] * ic - bflo(ut[2]), sm[5] * ic - bfhi(ut[2])); d.w = pk2(sm[6] * ic - bflo(ut[3]), sm[7] * ic - bfhi(ut[3]));
                *(GAS v4u*)(MIX + (size_t)(t0 + q) * 1024 + 512 + 8 * lane) = d;
            }
        }
    }
    SEAM(3);
    if (IN(4)) {
        pg8::Gemm g{MIX, Wout_t, T, DM, DM}; pg8::StaticOrder S; S.init(g, G, bx);
        pg8::EpiResF32 E{x, out, DM};
        pg8::gemm_phase<pg8::EpiResF32, pg8::StaticOrder, false>(L, DM, S, E);
    }
    SEAM(4);
    if (IN(5)) {
        LAS float* WR = (LAS float*)(L + RT_WR); LAS float* SC = (LAS float*)(L + RT_SC); LAS float* SQ = (LAS float*)(L + RT_SQ); LAS float* SR = (LAS float*)(L + RT_SR);
        { float wv[8], gv[8];
#pragma unroll
          for (int q = 0; q < 8; ++q) { const int idx = tid + 512 * q; wv[q] = wgr[idx]; gv[q] = n2g[idx >> 2]; }
#pragma unroll
          for (int q = 0; q < 8; ++q) { const int idx = tid + 512 * q; WR[(idx & 3) * 1028 + (idx >> 2)] = wv[q] * gv[q]; }
          for (int base = 0; base < 1024 * 32; base += 512 * 16) { float w16[16], g16[16];
#pragma unroll
              for (int q = 0; q < 16; ++q) { const int idx = base + tid + 512 * q; w16[q] = wer[idx]; g16[q] = n2g[idx >> 5]; }
#pragma unroll
              for (int q = 0; q < 16; ++q) { const int idx = base + tid + 512 * q; WR[(4 + (idx & 31)) * 1028 + (idx >> 5)] = w16[q] * g16[q]; } } }
        LAS unsigned* HI = (LAS unsigned*)(L + RT_HI); LAS unsigned* HB = HI + 32;
        if (tid < 32) HI[tid] = 0u;
        __syncthreads();
        const int gq = wave & 3, kh = wave >> 2, tk = lane & 15, kq = lane >> 4;
        for (int tb = vcu * 64; tb < T; tb += G * 64) {
            const float* hrow = out + (size_t)(tb + 16 * gq + tk) * DM + 512 * kh + 4 * kq;
            f32x4 acc[3] = {{0.f, 0.f, 0.f, 0.f}, {0.f, 0.f, 0.f, 0.f}, {0.f, 0.f, 0.f, 0.f}}; float ssq = 0.f;
            int r_ea = 0, r_eb = 0, r_pa = 0, r_pb = 0; float r_g1 = 0.f, r_g2 = 0.f;
            int nn[3];
#pragma unroll
            for (int nb = 0; nb < 3; ++nb) { const int n = 16 * nb + tk; nn[nb] = (n < 36 ? n : 35) * 1028 + 512 * kh + 4 * kq; }
#pragma unroll 8
            for (int s = 0; s < 32; ++s) {
                const f32x4 hv = *(const GAS f32x4*)(hrow + 16 * s);
                ssq += (hv.x * hv.x + hv.y * hv.y) + (hv.z * hv.z + hv.w * hv.w);
#pragma unroll
                for (int nb = 0; nb < 3; ++nb) { const f32x4 bv = *(const LAS f32x4*)(WR + nn[nb] + 16 * s);
                    acc[nb] = __builtin_amdgcn_mfma_f32_16x16x4f32(hv.x, bv.x, acc[nb], 0, 0, 0); acc[nb] = __builtin_amdgcn_mfma_f32_16x16x4f32(hv.y, bv.y, acc[nb], 0, 0, 0);
                    acc[nb] = __builtin_amdgcn_mfma_f32_16x16x4f32(hv.z, bv.z, acc[nb], 0, 0, 0); acc[nb] = __builtin_amdgcn_mfma_f32_16x16x4f32(hv.w, bv.w, acc[nb], 0, 0, 0); }
            }
            ssq += __shfl_xor(ssq, 16); ssq += __shfl_xor(ssq, 32);
            if (kh == 1) {
#pragma unroll
                for (int nb = 0; nb < 3; ++nb)
#pragma unroll
                    for (int r = 0; r < 4; ++r) SC[gq * 768 + (nb * 4 + r) * 64 + lane] = acc[nb][r];
                if (kq == 0) SQ[gq * 16 + tk] = ssq;
            }
            __syncthreads();
            if (kh == 0) {
#pragma unroll
                for (int nb = 0; nb < 3; ++nb)
#pragma unroll
                    for (int r = 0; r < 4; ++r) acc[nb][r] += SC[gq * 768 + (nb * 4 + r) * 64 + lane];
                const float sq2 = ssq + SQ[gq * 16 + tk];
                LDS_WAIT(); asm volatile("" ::: "memory");
#pragma unroll
                for (int nb = 0; nb < 3; ++nb)
#pragma unroll
                    for (int r = 0; r < 4; ++r) SC[gq * 768 + (4 * kq + r) * 48 + 16 * nb + tk] = acc[nb][r];
                LDS_WAIT(); asm volatile("" ::: "memory");
                if (lane < 16) {
                    const int t = tb + 16 * gq + lane; const float rstd = 1.0f / sqrtf(sq2 * (1.0f / DM) + EPS);
                    SR[gq * 16 + lane] = rstd;
                    const LAS float* lg = SC + gq * 768 + lane * 48;
                    float gl[4];
#pragma unroll
                    for (int g = 0; g < 4; ++g) gl[g] = lg[g] * rstd + bgr[g];
                    int gs = 0; float gm = gl[0];
#pragma unroll
                    for (int g = 1; g < 4; ++g) if (gl[g] > gm) { gm = gl[g]; gs = g; }
                    float den = 0.f;
#pragma unroll
                    for (int g = 0; g < 4; ++g) den += expf(gl[g] - gm);
                    const float pg = 1.0f / den;
                    float e8[8];
#pragma unroll
                    for (int i = 0; i < 8; ++i) e8[i] = lg[4 + gs * 8 + i] * rstd + ber[gs * 8 + i];
                    float v1 = e8[0]; int i1 = 0;
#pragma unroll
                    for (int i = 1; i < 8; ++i) if (e8[i] > v1) { v1 = e8[i]; i1 = i; }
                    float v2 = -3.0e38f; int i2 = 0;
#pragma unroll
                    for (int i = 0; i < 8; ++i) if (i != i1 && e8[i] > v2) { v2 = e8[i]; i2 = i; }
                    const float p2 = expf(v2 - v1), g1 = pg / (1.0f + p2), g2 = pg * p2 / (1.0f + p2);
                    const int ea = gs * 8 + i1, eb = gs * 8 + i2;
                    r_ea = ea; r_eb = eb; r_g1 = g1; r_g2 = g2;
                    r_pa = (int)__hip_atomic_fetch_add((LAS unsigned*)HI + ea, 1u, __ATOMIC_RELAXED, __HIP_MEMORY_SCOPE_WORKGROUP);
                    r_pb = (int)__hip_atomic_fetch_add((LAS unsigned*)HI + eb, 1u, __ATOMIC_RELAXED, __HIP_MEMORY_SCOPE_WORKGROUP);
                }
            }
            __syncthreads();
            if (tid < 32) { const unsigned c = HI[tid]; HB[tid] = c ? atomicAdd((unsigned*)(ctl + CW_CNT + 64 * tid), c) : 0u; }
            __syncthreads();
            if (kh == 0 && lane < 16) { const int t = tb + 16 * gq + lane; const int pa = r_pa + (int)HB[r_ea], pb = r_pb + (int)HB[r_eb];
                list[(size_t)r_ea * 16384 + pa] = t; glist[(size_t)r_ea * 16384 + pa] = r_g1; list[(size_t)r_eb * 16384 + pb] = t; glist[(size_t)r_eb * 16384 + pb] = r_g2;
                epos[t * 2] = (r_ea << 16) | pa; epos[t * 2 + 1] = (r_eb << 16) | pb; }
            if (tid < 32) HI[tid] = 0u;
            { const GAS f32x4* gr = (const GAS f32x4*)n2g + lane; f32x4 gg[4];
#pragma unroll
              for (int j = 0; j < 4; ++j) gg[j] = gr[64 * j];
#pragma unroll
              for (int qb_ = 0; qb_ < 2; ++qb_) { f32x4 v[4][4];
#pragma unroll
                  for (int q = 0; q < 4; ++q) { const GAS f32x4* hr = (const GAS f32x4*)(out + (size_t)(tb + 8 * wave + 4 * qb_ + q) * DM) + lane;
#pragma unroll
                      for (int j = 0; j < 4; ++j) v[q][j] = hr[64 * j]; }
#pragma unroll
                  for (int q = 0; q < 4; ++q) { const int tl = 8 * wave + 4 * qb_ + q; const float rstd = SR[tl]; GAS v2u* o8 = (GAS v2u*)(XN2 + (size_t)(tb + tl) * DM) + lane;
#pragma unroll
                      for (int j = 0; j < 4; ++j) { v2u w; w.x = pk2(v[q][j].x * rstd * gg[j].x, v[q][j].y * rstd * gg[j].y); w.y = pk2(v[q][j].z * rstd * gg[j].z, v[q][j].w * rstd * gg[j].w); o8[64 * j] = w; } } } }
            __syncthreads();
        }
    }
    SEAM(5);
    LAS int* tstart = (LAS int*)(L + MOE_TAB_OFF); LAS int* ecnt = (LAS int*)(L + MOE_TAB_OFF + 256);
    if (IN(6) || IN(7) || IN(8)) {
        if (tid < 32) ecnt[tid] = (int)__hip_atomic_load(ctl + CW_CNT + 64 * tid, RLX_AGENT);
        __syncthreads();
        if (tid == 0) { int a = 0; for (int e = 0; e < 32; ++e) { tstart[e] = a; a += (ecnt[e] + 255) >> 8; } tstart[32] = a; }
        __syncthreads();
    }
    if (IN(6)) {
        pg8::MoeOrder<true> S; S.tstart = tstart; S.cnt = ecnt; S.ntiles = tstart[32]; S.G = G; S.c = vcu; S.A = XN2; S.Bt = Wgu_t; S.a_tstep = 0; S.b_estep = (size_t)1024 * 1024 * 2; S.b_tstep = (size_t)256 * 1024 * 2; S.list = list; S.Kb = 2048;
        pg8::EpiSwiGLU E{HDN};
        pg8::gemm_phase<pg8::EpiSwiGLU, pg8::MoeOrder<true>, true>(L, DM, S, E);
    }
    SEAM(6);
    if (IN(7)) {
        pg8::MoeOrder<false> S; S.tstart = tstart; S.cnt = ecnt; S.ntiles = tstart[32]; S.G = G; S.c = vcu; S.A = HDN; S.Bt = Wd_t; S.a_tstep = (size_t)256 * 512 * 2; S.b_estep = (size_t)1024 * 512 * 2; S.b_tstep = (size_t)256 * 512 * 2; S.list = list; S.Kb = 1024;
        pg8::EpiGateBf16 E{Y, glist};
        pg8::gemm_phase<pg8::EpiGateBf16, pg8::MoeOrder<false>, false>(L, DEXP, S, E);
    }
    SEAM(7);
    if (IN(8)) {
        const GAS f32x4* gr = (const GAS f32x4*)fing + lane; f32x4 gg[4];
#pragma unroll
        for (int j = 0; j < 4; ++j) gg[j] = gr[64 * j];
        for (int t0 = gw; t0 < T; t0 += 4 * NGW) {
            int pa[4], pb[4];
#pragma unroll
            for (int q = 0; q < 4; ++q) { const int t = t0 + q * NGW; pa[q] = epos[(t < T ? t : t0) * 2]; pb[q] = epos[(t < T ? t : t0) * 2 + 1]; }
            f32x4 v[4][4]; v2u ya[4][4], yb[4][4];
#pragma unroll
            for (int q = 0; q < 4; ++q) { const int t = (t0 + q * NGW < T) ? t0 + q * NGW : t0;
                const size_t ra = (size_t)tstart[pa[q] >> 16] * 256 + (pa[q] & 0xffff), rb = (size_t)tstart[pb[q] >> 16] * 256 + (pb[q] & 0xffff);
                const GAS f32x4* hr = (const GAS f32x4*)(out + (size_t)t * DM) + lane; const GAS v2u* pya = (const GAS v2u*)(Y + ra * 1024) + lane; const GAS v2u* pyb = (const GAS v2u*)(Y + rb * 1024) + lane;
#pragma unroll
                for (int j = 0; j < 4; ++j) { v[q][j] = hr[64 * j]; ya[q][j] = pya[64 * j]; yb[q][j] = pyb[64 * j]; } }
#pragma unroll
            for (int q = 0; q < 4; ++q) { const int t = t0 + q * NGW; float s = 0.f;
#pragma unroll
                for (int j = 0; j < 4; ++j) { const v2u a = ya[q][j], bq = yb[q][j];
                    v[q][j].x += bflo(a.x) + bflo(bq.x); v[q][j].y += bfhi(a.x) + bfhi(bq.x); v[q][j].z += bflo(a.y) + bflo(bq.y); v[q][j].w += bfhi(a.y) + bfhi(bq.y);
                    s += (v[q][j].x * v[q][j].x + v[q][j].y * v[q][j].y) + (v[q][j].z * v[q][j].z + v[q][j].w * v[q][j].w); }
                const float rstd = 1.0f / sqrtf(wave_sum(s) * (1.f / DM) + EPS);
                if (t < T) { GAS f32x4* orow = (GAS f32x4*)(out + (size_t)t * DM) + lane;
#pragma unroll
                    for (int j = 0; j < 4; ++j) orow[64 * j] = v[q][j] * rstd * gg[j]; } }
        }
    }
#undef IN
#undef SEAM
}

extern "C" void kernel_launch(void* const* d_in, const int* in_sizes, int n_in, void* d_out, int out_size, void* d_ws, size_t ws_size, hipStream_t stream) {
    static int grid = 0;
    if (grid == 0) {
        if (n_in != 20 || in_sizes[0] != T * DM || out_size != T * DM || ws_size < WS_END) { fprintf(stderr, "kernel_launch: unexpected shapes: n_in %d in0 %d out %d ws %zu; nothing launched\n", n_in, n_in > 0 ? in_sizes[0] : -1, out_size, ws_size); grid = -1; return; }
        int dev = 0, cus = 0;
        if (hipGetDevice(&dev) != hipSuccess || hipDeviceGetAttribute(&cus, hipDeviceAttributeMultiprocessorCount, dev) != hipSuccess) { grid = -1; return; }
        if (hipFuncSetAttribute((const void*)mk_fwd, hipFuncAttributeMaxDynamicSharedMemorySize, LDS_BYTES) != hipSuccess) { fprintf(stderr, "kernel_launch: hipFuncSetAttribute failed\n"); grid = -1; return; }
        (void)hipGetLastError();
        grid = cus;
    }
    if (grid < 0) return;
    (void)hipMemsetAsync((char*)d_ws + WS_CTL, 0, CTL_ZERO_BYTES, stream);
    Args a{};
    for (int i = 0; i < 20; ++i) a.in[i] = (const float*)d_in[i];
    a.out = (float*)d_out; a.ws = (unsigned char*)d_ws;
#ifndef MK_N_LAUNCHES
#define MK_N_LAUNCHES 1
#endif
    constexpr int NPH = 9;
    if (MK_N_LAUNCHES == 1) { a.ph_lo = 0; a.ph_hi = NPH; hipLaunchKernelGGL(mk_fwd, dim3(grid), dim3(NWAVES * 64), LDS_BYTES, stream, a); }
    else for (int p = 0; p < NPH; ++p) { a.ph_lo = p; a.ph_hi = p + 1; hipLaunchKernelGGL(mk_fwd, dim3(grid), dim3(NWAVES * 64), LDS_BYTES, stream, a); }
}
```

```cpp
#include <hip/hip_runtime.h>
#include <hip/hip_bf16.h>
#include <cstdio>
#include <cstdint>
#include <cmath>
namespace pg8 {
#define PG8_LAS __attribute__((address_space(3)))
typedef unsigned short bf16_t;
typedef short bf16x8 __attribute__((ext_vector_type(8)));
typedef float f32x4 __attribute__((ext_vector_type(4)));
typedef float f32x2 __attribute__((ext_vector_type(2)));
typedef unsigned u32x4 __attribute__((ext_vector_type(4)));
constexpr int BM = 256, BK = 64, HALF = 128, HTB = HALF * BK * 2  , STAGE_BYTES = 8 * HTB, NXCD = 8, WGM = 8;

__host__ __device__ __forceinline__ int lds_byte(int r, int c) { const int st = (r >> 4) * 2 + (c >> 5), rr = r & 15, cc = c & 31, ob = rr * 64 + cc * 2; return st * 1024 + (ob ^ (((ob >> 9) & 1) << 5)); }
__host__ __device__ __forceinline__ void stage_rc(int b, int& R, int& C) { const int st = b / 1024, sb = b % 1024, swz = sb ^ (((sb >> 9) & 1) << 5); R = (st >> 1) * 16 + swz / 64; C = (st & 1) * 32 + (swz % 64) / 2; }
__host__ __device__ __forceinline__ int perm32(int rho) { const int n = rho >> 4, i = rho & 15; return 8 * (i >> 2) + 4 * n + (i & 3); }

struct Unit { int pm, pn, e, lt, cnt; };
struct Gemm { const bf16_t* A; const bf16_t* Bt; int M, N, K; };

struct StaticOrder {
    int nM, nN, nwg, G, c; const bf16_t* A; const bf16_t* Bt; size_t tstep;
    __device__ void init(const Gemm& g, int G_, int c_) { nM = g.M / BM; nN = g.N / BM; nwg = nM * nN; G = G_; c = c_; A = g.A; Bt = g.Bt; tstep = (size_t)BM * g.K * 2; }
    __device__ bool next(int i, Unit& u) const {
        const long L = (long)i * G + c; if (L >= nwg) return false;
        int wgid = (int)L; { const int q = nwg / NXCD, r = nwg % NXCD, xcd = wgid % NXCD, off = wgid / NXCD; wgid = (xcd < r ? xcd * (q + 1) : r * (q + 1) + (xcd - r) * q) + off; }
        const int nig = WGM * nN, gid = wgid / nig, fm = gid * WGM, gsz = (nM - fm) < WGM ? (nM - fm) : WGM;
        u.pm = fm + ((wgid % nig) % gsz); u.pn = (wgid % nig) / gsz; u.e = 0; u.lt = 0; u.cnt = 0; return true;
    }
    __device__ __forceinline__ const char* a_base(const Unit& u) const { return (const char*)A + (size_t)u.pm * tstep; }
    __device__ __forceinline__ const char* b_base(const Unit& u) const { return (const char*)Bt + (size_t)u.pn * tstep; }
    __device__ __forceinline__ unsigned row_off(const Unit&, int) const { return 0u; }
};
template <bool GATHER> struct MoeOrder {
    const PG8_LAS int* tstart; const PG8_LAS int* cnt; int ntiles, G, c;
    const bf16_t* A; const bf16_t* Bt; size_t a_tstep, b_estep, b_tstep; const int* list; int Kb  ;
    __device__ bool next(int i, Unit& u) const {
        const long L = (long)i * G + c; if (L >= 4L * ntiles) return false;
        const int rt = (int)(L >> 2); u.pn = (int)(L & 3); u.pm = rt;
        int e = 0;
#pragma unroll
        for (int k = 1; k < 32; ++k) e += (rt >= tstart[k]) ? 1 : 0;
        e = __builtin_amdgcn_readfirstlane(e);
        u.e = e; u.lt = __builtin_amdgcn_readfirstlane(rt - tstart[e]); u.cnt = __builtin_amdgcn_readfirstlane(cnt[e]); return true;
    }
    __device__ __forceinline__ const char* a_base(const Unit& u) const { return GATHER ? (const char*)A : (const char*)A + (size_t)u.pm * a_tstep; }
    __device__ __forceinline__ const char* b_base(const Unit& u) const { return (const char*)Bt + (size_t)u.e * b_estep + (size_t)u.pn * b_tstep; }
    __device__ __forceinline__ unsigned row_off(const Unit& u, int R) const { const int pos = u.lt * BM + R; const int tok = (pos < u.cnt) ? list[(size_t)u.e * 16384 + pos] : 0; return (unsigned)tok * (unsigned)Kb; }
};

__device__ __forceinline__ unsigned cvt_pk_bf16(float lo, float hi) { unsigned r; asm volatile("v_cvt_pk_bf16_f32 %0, %1, %2" : "=v"(r) : "v"(lo), "v"(hi)); return r; }

struct EpiBf16 {
    static constexpr bool PERM = true;
    bf16_t* O; int ldc; int split_cols; size_t split_stride; float scale0; unsigned* kmax;
    __device__ __forceinline__ void operator()(const f32x4 (&acc)[2][2][4][2], const Unit& u, int wr, int wc, int fr, int fq) const {
        const int row0 = u.pm * BM + wr * 64 + fr; int colt = u.pn * BM; bf16_t* base = O;
        float sc = 1.f; int tsplit = 0; if (split_cols) { const int t = colt / split_cols; tsplit = t; base += (size_t)t * split_stride; colt -= t * split_cols; if (t == 0) sc = scale0; }
        const int col0 = colt + wc * 32 + 8 * fq;
        if (kmax && tsplit == 1) {
#pragma unroll
            for (int ai = 0; ai < 2; ++ai)
#pragma unroll
                for (int bj = 0; bj < 2; ++bj) { float mx = 0.f;
#pragma unroll
                    for (int m = 0; m < 4; ++m) { const f32x4 a = acc[ai][bj][m][0], b = acc[ai][bj][m][1];
                        float ss = (a[0] * a[0] + a[1] * a[1]) + (a[2] * a[2] + a[3] * a[3]) + (b[0] * b[0] + b[1] * b[1]) + (b[2] * b[2] + b[3] * b[3]);
                        ss += __shfl_xor(ss, 16); ss += __shfl_xor(ss, 32); mx = __builtin_fmaxf(mx, ss); }
                    mx = __builtin_fmaxf(mx, __shfl_xor(mx, 1)); mx = __builtin_fmaxf(mx, __shfl_xor(mx, 2)); mx = __builtin_fmaxf(mx, __shfl_xor(mx, 4)); mx = __builtin_fmaxf(mx, __shfl_xor(mx, 8));
                    if (fr == 0 && fq == 0) atomicMax(kmax + (size_t)(u.pm * 4 + ai * 2 + wr) * 8 + (colt >> 6) + 2 * bj + (wc >> 1), __float_as_uint(mx)); }
        }
#pragma unroll
        for (int ai = 0; ai < 2; ++ai)
#pragma unroll
            for (int m = 0; m < 4; ++m) { bf16_t* rowp = base + (size_t)(row0 + ai * HALF + m * 16) * ldc + col0;
#pragma unroll
                for (int bj = 0; bj < 2; ++bj) { f32x4 v0 = acc[ai][bj][m][0] * sc, v1 = acc[ai][bj][m][1] * sc;
                    u32x4 w; w.x = cvt_pk_bf16(v0[0], v0[1]); w.y = cvt_pk_bf16(v0[2], v0[3]); w.z = cvt_pk_bf16(v1[0], v1[1]); w.w = cvt_pk_bf16(v1[2], v1[3]);
                    *(u32x4*)(rowp + bj * HALF) = w; } }
    }
};
struct EpiResF32 {
    static constexpr bool PERM = false;
    const float* base; float* out; int ldc;
    __device__ __forceinline__ void operator()(const f32x4 (&acc)[2][2][4][2], const Unit& u, int wr, int wc, int fr, int fq) const {
        const int col0 = u.pn * BM + wc * 32 + 4 * fq;
#pragma unroll
        for (int ai = 0; ai < 2; ++ai)
#pragma unroll
            for (int m = 0; m < 4; ++m) { const size_t off = (size_t)(u.pm * BM + ai * HALF + wr * 64 + m * 16 + fr) * ldc + col0;
#pragma unroll
                for (int bj = 0; bj < 2; ++bj)
#pragma unroll
                    for (int n = 0; n < 2; ++n) { const f32x4 bs = *(const f32x4*)(base + off + bj * HALF + n * 16); *(f32x4*)(out + off + bj * HALF + n * 16) = bs + acc[ai][bj][m][n]; } }
    }
};
struct EpiSwiGLU {
    static constexpr bool PERM = true;
    bf16_t* O;
    __device__ __forceinline__ void operator()(const f32x4 (&acc)[2][2][4][2], const Unit& u, int wr, int wc, int fr, int fq) const {
        const int row0 = u.pm * BM + wr * 64 + fr, col0 = u.pn * HALF + wc * 32 + 8 * fq;
#pragma unroll
        for (int ai = 0; ai < 2; ++ai)
#pragma unroll
            for (int m = 0; m < 4; ++m) { float hv[8];
#pragma unroll
                for (int n = 0; n < 2; ++n)
#pragma unroll
                    for (int j = 0; j < 4; ++j) { const float g = acc[ai][0][m][n][j], up = acc[ai][1][m][n][j];
                        const float sg = __builtin_amdgcn_rcpf(1.0f + __builtin_amdgcn_exp2f(-1.4426950408889634f * g)); hv[n * 4 + j] = g * sg * up; }
                u32x4 w; w.x = cvt_pk_bf16(hv[0], hv[1]); w.y = cvt_pk_bf16(hv[2], hv[3]); w.z = cvt_pk_bf16(hv[4], hv[5]); w.w = cvt_pk_bf16(hv[6], hv[7]);
                *(u32x4*)(O + (size_t)(row0 + ai * HALF + m * 16) * 512 + col0) = w; }
    }
};
struct EpiGateBf16 {
    static constexpr bool PERM = true;
    bf16_t* O; const float* glist;
    __device__ __forceinline__ void operator()(const f32x4 (&acc)[2][2][4][2], const Unit& u, int wr, int wc, int fr, int fq) const {
        const int col0 = u.pn * BM + wc * 32 + 8 * fq;
#pragma unroll
        for (int ai = 0; ai < 2; ++ai)
#pragma unroll
            for (int m = 0; m < 4; ++m) { const int R = ai * HALF + wr * 64 + m * 16 + fr, pos = u.lt * BM + R; const float gt = (pos < u.cnt) ? glist[(size_t)u.e * 16384 + pos] : 0.f;
                bf16_t* rowp = O + (size_t)(u.pm * BM + R) * 1024 + col0;
#pragma unroll
                for (int bj = 0; bj < 2; ++bj) { f32x4 v0 = acc[ai][bj][m][0] * gt, v1 = acc[ai][bj][m][1] * gt;
                    u32x4 w; w.x = cvt_pk_bf16(v0[0], v0[1]); w.y = cvt_pk_bf16(v0[2], v0[3]); w.z = cvt_pk_bf16(v1[0], v1[1]); w.w = cvt_pk_bf16(v1[2], v1[3]);
                    *(u32x4*)(rowp + bj * HALF) = w; } }
    }
};

template <class Epi, class Sched, bool GATHER>
__device__ __forceinline__ void gemm_phase(PG8_LAS unsigned char* lds, const int K, const Sched& S, const Epi& E) {
    const int tid = threadIdx.x, wid = __builtin_amdgcn_readfirstlane(tid >> 6), lane = tid & 63, wr = wid >> 2, wc = wid & 3, fr = lane & 15, fq = lane >> 4;
    const int nt = K / BK;
    unsigned voffA[2], voffB[2]; int rowA[2];
#pragma unroll
    for (int i = 0; i < 2; ++i) { int R, C; stage_rc(tid * 16 + i * 8192, R, C); const int Rb = Epi::PERM ? ((R & ~31) + perm32(R & 31)) : R;
        rowA[i] = R; voffA[i] = GATHER ? (unsigned)C * 2u : (unsigned)(R * K + C) * 2u; voffB[i] = (unsigned)(Rb * K + C) * 2u; }
    const size_t kstep = (size_t)(BK * 2);
    const size_t hstep = (size_t)HALF * K * 2;
    const size_t hstepA = GATHER ? 0 : hstep;
    const unsigned ldsw = (unsigned)wid * 1024u;
    const int aoff = lds_byte(wr * 64 + fr, fq * 8), boff = lds_byte(wc * 32 + fr, fq * 8);
#define PG8_SA(b, h) (((b) * 2 + (h)) * HTB)
#define PG8_SB(b, h) ((4 + (b) * 2 + (h)) * HTB)
#define PG8_STAGE(bufoff, gbase, voff) do { _Pragma("unroll") for (int _i = 0; _i < 2; ++_i) \
        __builtin_amdgcn_global_load_lds((const unsigned*)((const char*)(gbase) + (voff)[_i]), (PG8_LAS unsigned*)(lds + (bufoff) + ldsw + _i * 8192), 16, 0, 0); } while (0)
#define PG8_STAGE_A(bufoff, gbase, h, VO) do { _Pragma("unroll") for (int _i = 0; _i < 2; ++_i) \
        __builtin_amdgcn_global_load_lds((const unsigned*)((const char*)(gbase) + (size_t)(h) * hstepA + (GATHER ? (VO)[2 * (h) + _i] : voffA[_i])), (PG8_LAS unsigned*)(lds + (bufoff) + ldsw + _i * 8192), 16, 0, 0); } while (0)
#define PG8_LDA(dst, b, h) do { _Pragma("unroll") for (int m = 0; m < 4; ++m) _Pragma("unroll") for (int k = 0; k < 2; ++k) dst[m][k] = *(const PG8_LAS bf16x8*)(lds + PG8_SA(b, h) + aoff + m * 2048 + k * 1024); } while (0)
#define PG8_LDB(dst, b, h) do { _Pragma("unroll") for (int n = 0; n < 2; ++n) _Pragma("unroll") for (int k = 0; k < 2; ++k) dst[n][k] = *(const PG8_LAS bf16x8*)(lds + PG8_SB(b, h) + boff + n * 2048 + k * 1024); } while (0)
#define PG8_MMA(ai, bj, At, Bt) do { __builtin_amdgcn_s_setprio(1); _Pragma("unroll") for (int m = 0; m < 4; ++m) _Pragma("unroll") for (int n = 0; n < 2; ++n) _Pragma("unroll") for (int k = 0; k < 2; ++k) \
        acc[ai][bj][m][n] = __builtin_amdgcn_mfma_f32_16x16x32_bf16(Bt[n][k], At[m][k], acc[ai][bj][m][n], 0, 0, 0); __builtin_amdgcn_s_setprio(0); } while (0)
#define PG8_WAIT_V(n) asm volatile("s_waitcnt vmcnt(" #n ")" ::: "memory")
#define PG8_WAIT_L(n) asm volatile("s_waitcnt lgkmcnt(" #n ")" ::: "memory")
#define PG8_BAR __builtin_amdgcn_s_barrier()
#define PG8_SCHED __builtin_amdgcn_sched_barrier(0)
    Unit cur, nxt; int ui = 0;
    if (!S.next(0, cur)) return;
    f32x4 acc[2][2][4][2];
#pragma unroll
    for (int a = 0; a < 2; ++a)
#pragma unroll
        for (int b = 0; b < 2; ++b)
#pragma unroll
            for (int m = 0; m < 4; ++m)
#pragma unroll
                for (int n = 0; n < 2; ++n) acc[a][b][m][n] = (f32x4){0.f, 0.f, 0.f, 0.f};
    bf16x8 At[4][2], B0[2][2], B1[2][2];
    const char* cA = S.a_base(cur); const char* cB = S.b_base(cur);
    unsigned vc[4] = {0u, 0u, 0u, 0u}, vn[4] = {0u, 0u, 0u, 0u};
    if constexpr (GATHER) {
#pragma unroll
        for (int h = 0; h < 2; ++h)
#pragma unroll
            for (int i = 0; i < 2; ++i) vc[2 * h + i] = S.row_off(cur, h * HALF + rowA[i]) + voffA[i];
    }
    PG8_STAGE(PG8_SB(0, 0), cB, voffB); PG8_STAGE(PG8_SB(0, 1), cB + hstep, voffB); PG8_STAGE_A(PG8_SA(0, 0), cA, 0, vc); PG8_STAGE_A(PG8_SA(0, 1), cA, 1, vc);
    if (wr == 1) PG8_BAR;
    PG8_WAIT_V(2); PG8_BAR;
    PG8_STAGE(PG8_SB(1, 0), cB + kstep, voffB); PG8_STAGE_A(PG8_SA(1, 0), cA + kstep, 0, vc); PG8_STAGE(PG8_SB(1, 1), cB + hstep + kstep, voffB);
    PG8_WAIT_V(6); PG8_BAR;
    for (;;) {
        const bool has_next = S.next(ui + 1, nxt);
        const char* nA = has_next ? S.a_base(nxt) : cA; const char* nB = has_next ? S.b_base(nxt) : cB;
        if constexpr (GATHER) {
#pragma unroll
            for (int h = 0; h < 2; ++h)
#pragma unroll
                for (int i = 0; i < 2; ++i) vn[2 * h + i] = has_next ? (S.row_off(nxt, h * HALF + rowA[i]) + voffA[i]) : vc[2 * h + i];
        }
        for (int t = 0; t < nt; t += 2) {
            const bool last = (t == nt - 2);
            const char* a1 = cA + (size_t)(t + 1) * kstep;
            const char* a2 = last ? nA : cA + (size_t)(t + 2) * kstep; const char* b2 = last ? nB : cB + (size_t)(t + 2) * kstep;
            const char* a3 = a2 + kstep; const char* b3 = b2 + kstep;
            unsigned v2[4];
#pragma unroll
            for (int q = 0; q < 4; ++q) v2[q] = last ? vn[q] : vc[q];
            PG8_LDB(B0, 0, 0); PG8_LDB(B1, 0, 1); PG8_SCHED; PG8_LDA(At, 0, 0); PG8_STAGE_A(PG8_SA(1, 1), a1, 1, vc);
            PG8_WAIT_V(8); PG8_WAIT_L(0); PG8_BAR; PG8_MMA(0, 0, At, B0); PG8_MMA(0, 1, At, B1); PG8_BAR; PG8_SCHED;
            PG8_LDA(At, 0, 1); PG8_STAGE(PG8_SB(0, 0), b2, voffB); PG8_STAGE(PG8_SB(0, 1), b2 + hstep, voffB); PG8_STAGE_A(PG8_SA(0, 0), a2, 0, v2);
            PG8_WAIT_V(8); PG8_WAIT_L(0); PG8_BAR; PG8_MMA(1, 0, At, B0); PG8_MMA(1, 1, At, B1); PG8_BAR; PG8_SCHED;
            PG8_LDB(B0, 1, 0); PG8_LDB(B1, 1, 1); PG8_SCHED; PG8_LDA(At, 1, 0); PG8_STAGE_A(PG8_SA(0, 1), a2, 1, v2);
            PG8_WAIT_V(8); PG8_WAIT_L(0); PG8_BAR; PG8_MMA(0, 0, At, B0); PG8_MMA(0, 1, At, B1); PG8_BAR; PG8_SCHED;
            PG8_LDA(At, 1, 1); PG8_STAGE(PG8_SB(1, 0), b3, voffB); PG8_STAGE(PG8_SB(1, 1), b3 + hstep, voffB); PG8_STAGE_A(PG8_SA(1, 0), a3, 0, v2);
            PG8_WAIT_V(8); PG8_WAIT_L(0); PG8_BAR; PG8_MMA(1, 0, At, B0); PG8_MMA(1, 1, At, B1); PG8_BAR; PG8_SCHED;
        }
        if (wr == 0) PG8_BAR;
        E(acc, cur, wr, wc, fr, fq);
        if (!has_next) break;
#pragma unroll
        for (int a = 0; a < 2; ++a)
#pragma unroll
            for (int b = 0; b < 2; ++b)
#pragma unroll
                for (int m = 0; m < 4; ++m)
#pragma unroll
                    for (int n = 0; n < 2; ++n) acc[a][b][m][n] = (f32x4){0.f, 0.f, 0.f, 0.f};
        cur = nxt; cA = nA; cB = nB; ++ui;
#pragma unroll
        for (int q = 0; q < 4; ++q) vc[q] = vn[q];
        if (wr == 1) PG8_BAR;
    }
    PG8_WAIT_V(0);
    PG8_BAR;
#undef PG8_SA
#undef PG8_SB
#undef PG8_STAGE
#undef PG8_STAGE_A
#undef PG8_LDA
#undef PG8_LDB
#undef PG8_MMA
#undef PG8_WAIT_V
#undef PG8_WAIT_L
#undef PG8_BAR
#undef PG8_SCHED
}
}
namespace attn {
using bf16x8 = __attribute__((ext_vector_type(8))) short;
using s16x4 = __attribute__((ext_vector_type(4))) short;
using f32x16 = __attribute__((ext_vector_type(16))) float;
using u32x4 = __attribute__((ext_vector_type(4))) unsigned;
typedef unsigned short bf16_t;
constexpr int SEQ = 8192, NW = 8, QBLK = 32, QB = QBLK * NW, KVBLK = 64, NTILE = SEQ / KVBLK, PITCH = 512;
constexpr int KSLOT = 8192, VSLOT = 16384;
constexpr int LDS_K = 0, LDS_V = 3 * KSLOT, LDS_WS = LDS_V + 3 * VSLOT, LDS_OST = LDS_WS + NW * 256, LDS_BYTES = LDS_OST + NW * 8192;
#define SBAR() __builtin_amdgcn_sched_barrier(0)
#define PIN(x) asm volatile("" : "+v"(x))
#define MFMA32(a, b, c) __builtin_amdgcn_mfma_f32_32x32x16_bf16(a, b, c, 0, 0, 0)
#define WAIT_BAR(N) asm volatile("s_waitcnt vmcnt(" #N ") lgkmcnt(0)\n\ts_barrier" ::: "memory")
__device__ __forceinline__ constexpr int crow0(int r) { return (r & 3) + 8 * (r >> 2); }
__device__ __forceinline__ void glds16(const void* g, unsigned lds_base) {
    unsigned sv; asm volatile("s_mov_b32 %0, m0\n\ts_mov_b32 m0, %2\n\ts_nop 0\n\tglobal_load_lds_dwordx4 %1, off\n\ts_mov_b32 m0, %0" : "=&s"(sv) : "v"(g), "s"(lds_base) : "memory"); }
typedef float f32x2_t __attribute__((ext_vector_type(2))); typedef __bf16 bf16x2_t __attribute__((ext_vector_type(2)));
__device__ __forceinline__ unsigned cvtpk(float lo, float hi) { f32x2_t v = {lo, hi}; bf16x2_t b = __builtin_convertvector(v, bf16x2_t); return __builtin_bit_cast(unsigned, b); }
typedef __attribute__((address_space(3))) const char* lds_cptr;
typedef short v4i16_t __attribute__((ext_vector_type(4)));
__device__ __forceinline__ bf16x8 kld(lds_cptr p) { return *(const __attribute__((address_space(3))) bf16x8*)p; }
__device__ __forceinline__ s16x4 vtr(lds_cptr p) { return __builtin_bit_cast(s16x4, __builtin_amdgcn_ds_read_tr16_b64_v4i16((__attribute__((address_space(3))) v4i16_t*)p)); }
#define MX3(a, b, c) __builtin_fmaxf(__builtin_fmaxf((a), (b)), (c))
__device__ __forceinline__ float rowmax(const f32x16& p0, const f32x16& p1) {
    float a = MX3(p0[0], p0[1], p1[0]), b = MX3(p0[2], p0[3], p1[1]); a = MX3(a, p1[2], p1[3]);
#pragma unroll
    for (int r = 4; r < 16; r += 4) { a = MX3(a, p0[r], p0[r + 1]); b = MX3(b, p0[r + 2], p0[r + 3]); a = MX3(a, p1[r], p1[r + 1]); b = MX3(b, p1[r + 2], p1[r + 3]); }
    float m = __builtin_fmaxf(a, b); auto rr = __builtin_amdgcn_permlane32_swap(__float_as_uint(m), __float_as_uint(m), false, false);
    return __builtin_fmaxf(__uint_as_float(rr[0]), __uint_as_float(rr[1])); }
__device__ __forceinline__ float bf2f(short s) { return __uint_as_float(((unsigned)(unsigned short)s) << 16); }
__device__ __forceinline__ void build_c(f32x16& C, int side, float dj, float sg2, float mhat) {
    if (side == 0) {
#pragma unroll
        for (int r = 0; r < 16; ++r) C[r] = __builtin_fmaf(-sg2, __builtin_fabsf(dj + (float)crow0(r)), -mhat);
    } else {
        const float ss = (side > 0) ? -sg2 : sg2, cl = __builtin_fmaf(ss, dj, -mhat);
#pragma unroll
        for (int r = 0; r < 16; ++r) C[r] = __builtin_fmaf(ss, (float)crow0(r), cl);
    }
}

constexpr float SKIP_T = 150.0f;
template <int THRL>
__device__ __forceinline__ void attn_unit(int b, int h, int c, int qb, float sg2, const bf16_t* Q, const bf16_t* __restrict__ K, const bf16_t* __restrict__ V, bf16_t* AO, const unsigned* kb2, char* lds) {
    const int tid = threadIdx.x, lane = tid & 63, r32 = lane & 31, hi = lane >> 5; const int wid = __builtin_amdgcn_readfirstlane(tid >> 6);
    const long rowbase = (long)b * SEQ; const int q0 = qb * QB, iw0 = q0 + wid * QBLK;
    const bf16_t* Qw = Q + (rowbase + iw0) * PITCH + h * 128 + c * 64;
    const bf16_t* Kh = K + rowbase * PITCH + h * 128 + c * 64; const bf16_t* Vh = V + rowbase * PITCH + h * 128;
    const unsigned lds0 = (unsigned)(uintptr_t)lds; float* wsf = (float*)(lds + LDS_WS) + wid * 64;
    bf16x8 qr[4];
#pragma unroll
    for (int d0 = 0; d0 < 4; ++d0) qr[d0] = *reinterpret_cast<const bf16x8*>(&Qw[(long)r32 * PITCH + d0 * 16 + hi * 8]);
    float mhat; int tlo, thi;
    { const bf16_t* Kd = Kh + (long)(iw0 + r32) * PITCH; float s = 0.f, na = 0.f, nb = 0.f;
#pragma unroll
      for (int d0 = 0; d0 < 4; ++d0) { const bf16x8 kk = *reinterpret_cast<const bf16x8*>(&Kd[d0 * 16 + hi * 8]);
#pragma unroll
          for (int j = 0; j < 8; ++j) { const float qv = bf2f(qr[d0][j]); s = __builtin_fmaf(qv, bf2f(kk[j]), s); if (d0 < 2) na = __builtin_fmaf(qv, qv, na); else nb = __builtin_fmaf(qv, qv, nb); } }
      auto rr = __builtin_amdgcn_permlane32_swap(__float_as_uint(s), __float_as_uint(s), false, false); mhat = __uint_as_float(rr[0]) + __uint_as_float(rr[1]);
      auto ra = __builtin_amdgcn_permlane32_swap(__float_as_uint(na), __float_as_uint(na), false, false); na = __uint_as_float(ra[0]) + __uint_as_float(ra[1]);
      auto rb = __builtin_amdgcn_permlane32_swap(__float_as_uint(nb), __float_as_uint(nb), false, false); nb = __uint_as_float(rb[0]) + __uint_as_float(rb[1]);
      float qn = (sqrtf(na) + sqrtf(nb)) * 1.001f, sm = mhat;
#pragma unroll
      for (int o_ = 1; o_ < 32; o_ <<= 1) { qn = __builtin_fmaxf(qn, __shfl_xor(qn, o_)); sm = __builtin_fminf(sm, __shfl_xor(sm, o_)); }
      if (lane == 0) { wsf[48] = qn; wsf[49] = sm; }
      asm volatile("s_waitcnt lgkmcnt(0)\n\ts_barrier" ::: "memory");
      { const float* wsa = (const float*)(lds + LDS_WS);
#pragma unroll
        for (int w = 0; w < NW; ++w) { qn = __builtin_fmaxf(qn, wsa[w * 64 + 48]); sm = __builtin_fminf(sm, wsa[w * 64 + 49]); } }
      int lo_ = NTILE, hi_ = -1;
#pragma unroll
      for (int half = 0; half < 2; ++half) { const int J = lane + 64 * half; const float km = sqrtf(__uint_as_float(kb2[J * 8 + h * 2 + c])) * 1.01f;
          const int dl_ = q0 - (J * KVBLK + KVBLK - 1), dr_ = J * KVBLK - (q0 + QB - 1); const float dmin = (float)(dl_ > 0 ? dl_ : (dr_ > 0 ? dr_ : 0));
          const bool need = (qn * km - sg2 * dmin - sm >= -SKIP_T) || (dl_ <= 0 && dr_ <= 0);
          if (need) { lo_ = lo_ < J ? lo_ : J; hi_ = hi_ > J ? hi_ : J; } }
#pragma unroll
      for (int o_ = 1; o_ < 64; o_ <<= 1) { const int l2 = __shfl_xor(lo_, o_), h2 = __shfl_xor(hi_, o_); lo_ = lo_ < l2 ? lo_ : l2; hi_ = hi_ > h2 ? hi_ : h2; }
      tlo = __builtin_amdgcn_readfirstlane(lo_); thi = __builtin_amdgcn_readfirstlane(hi_); }
    const int n = thi - tlo + 1;
    const bf16_t* ksrc = Kh + (long)tlo * KVBLK * PITCH + (long)lane * PITCH + wid * 8;
    const bf16_t* vsrc = Vh + (long)tlo * KVBLK * PITCH + (long)(32 * (wid & 1) + (lane >> 2)) * PITCH + (wid >> 1) * 32 + (lane & 3) * 8;
    const unsigned kdst = lds0 + LDS_K + wid * 1024, vdst = lds0 + LDS_V + wid * 2048;
#define DMA_K(s, slot) glds16(ksrc + (long)(s) * KVBLK * PITCH, (unsigned)__builtin_amdgcn_readfirstlane(kdst + (slot) * KSLOT))
#define DMA_V(s, slot) do { glds16(vsrc + (long)(s) * KVBLK * PITCH, (unsigned)__builtin_amdgcn_readfirstlane(vdst + (slot) * VSLOT)); \
                            glds16(vsrc + (long)(s) * KVBLK * PITCH + 16 * PITCH, (unsigned)__builtin_amdgcn_readfirstlane(vdst + (slot) * VSLOT + 1024)); } while (0)
    const lds_cptr vp0 = (lds_cptr)lds + LDS_V + ((lane >> 4) & 1) * 32 + (lane & 3) * 8 + (4 * hi + ((lane & 15) >> 2)) * 64;
    const lds_cptr kp0 = (lds_cptr)lds + LDS_K + hi * 1024 + r32 * 16;
    DMA_K(0, 0); DMA_V(0, 0); DMA_K(1, 1); DMA_K(2, 2);
    float l_reg = 0.f; f32x16 o[4]; o[0] = f32x16{}; o[1] = f32x16{}; o[2] = f32x16{}; o[3] = f32x16{};
    const float fi = (float)(4 * hi - (iw0 + r32));
    bool resc = false;
    f32x16 C0, C1; bf16x8 kf[8]; u32x4 pw0, pw1, pw2, pw3;
    pw0 = u32x4{}; pw1 = u32x4{}; pw2 = u32x4{}; pw3 = u32x4{};
    int s_prev = 0, s_cur = 0, s_next = 1;
#define ROT() do { s_prev = s_cur; s_cur = s_next; s_next = (s_next == 2) ? 0 : s_next + 1; } while (0)
#define EX(v) __builtin_amdgcn_exp2f(v)
#define RESC() do { if (resc) { asm volatile("s_waitcnt lgkmcnt(0)" ::: "memory"); _Pragma("unroll") for (int d_ = 0; d_ < 4; ++d_) _Pragma("unroll") for (int r = 0; r < 16; ++r) o[d_][r] *= wsf[crow0(r) + 4 * hi]; } } while (0)
    asm volatile("s_waitcnt vmcnt(0) lgkmcnt(0)\n\ts_barrier" ::: "memory");
#pragma unroll
    for (int f = 0; f < 8; ++f) kf[f] = kld(kp0 + (f >> 1) * 2048 + (f & 1) * 512);
    asm volatile("s_waitcnt lgkmcnt(0)\n\ts_barrier" ::: "memory");
#define PKW(P, i) cvtpk(P[i], P[i + 1])
#define PAF(k) __builtin_bit_cast(bf16x8, pw##k)
#define VFRG(lo, hi_) (bf16x8){lo[0], lo[1], lo[2], lo[3], hi_[0], hi_[1], hi_[2], hi_[3]}
#define VRD(f) do { vlo[f] = vtr(vp_ + (((f) & 3) * 4096 + ((f) >> 2) * 1024)); vhi[f] = vtr(vp_ + (((f) & 3) * 4096 + ((f) >> 2) * 1024 + 512)); } while (0)
#define STEP(s, FIRST, GK, GV, GL) do { SBAR(); \
    const int jt_ = (tlo + (s)) * KVBLK; const lds_cptr vp_ = vp0 + s_prev * VSLOT; s16x4 vlo[16], vhi[16]; \
    { const int d0_ = jt_ - iw0, d1_ = jt_ + 32 - iw0; \
      build_c(C0, (d0_ > 0) - (d0_ < 0), (float)jt_ + fi, sg2, mhat); build_c(C1, (d1_ > 0) - (d1_ < 0), (float)(jt_ + 32) + fi, sg2, mhat); } \
    if (!(FIRST)) { VRD(0); VRD(1); } SBAR(); \
    C0 = MFMA32(kf[0], qr[0], C0); C1 = MFMA32(kf[1], qr[0], C1); SBAR(); \
    if (!(FIRST)) { VRD(2); VRD(3); } SBAR(); \
    C0 = MFMA32(kf[2], qr[1], C0); C1 = MFMA32(kf[3], qr[1], C1); SBAR(); \
    C0 = MFMA32(kf[4], qr[2], C0); C1 = MFMA32(kf[5], qr[2], C1); SBAR(); \
    C0 = MFMA32(kf[6], qr[3], C0); C1 = MFMA32(kf[7], qr[3], C1); SBAR(); \
    if (GK) DMA_K((s) + 3, s_cur); if (GV) DMA_V((s) + 1, s_next); \
    { const float rm = rowmax(C0, C1); resc = false; \
      if (__builtin_expect(__any(rm > (float)THRL), 0)) { const float dl = __builtin_fmaxf(rm, 0.f); mhat += dl; \
          _Pragma("unroll") for (int r = 0; r < 16; ++r) { C0[r] -= dl; C1[r] -= dl; } \
          const float f = EX(-dl); l_reg *= f; if (hi == 0) wsf[r32] = f; resc = true; } } \
    SBAR(); \
    float sacc = 0.f; u32x4 nw0, nw1, nw2, nw3; \
    _Pragma("unroll") for (int g = 0; g < 16; ++g) { \
        if (!(FIRST)) { const int ks_ = g >> 2, db_ = g & 3; \
            if (g + 4 < 16) { VRD(g + 4); } \
            const bf16x8 pa_ = (ks_ == 0) ? PAF(0) : (ks_ == 1) ? PAF(1) : (ks_ == 2) ? PAF(2) : PAF(3); \
            o[db_] = MFMA32(pa_, VFRG(vlo[g], vhi[g]), o[db_]); } \
        if (GL) { if (g >= 4 && g < 12) { kf[g - 4] = kld(kp0 + s_next * KSLOT + ((g - 4) >> 1) * 2048 + ((g - 4) & 1) * 512); } } \
        if (g < 8) { C0[2 * g] = EX(C0[2 * g]); C0[2 * g + 1] = EX(C0[2 * g + 1]); sacc += C0[2 * g]; sacc += C0[2 * g + 1]; } \
        else { C1[2 * g - 16] = EX(C1[2 * g - 16]); C1[2 * g - 15] = EX(C1[2 * g - 15]); sacc += C1[2 * g - 16]; sacc += C1[2 * g - 15]; } \
        if (g == 0) nw0[0] = PKW(C0, 0); if (g == 1) nw0[1] = PKW(C0, 2); if (g == 2) nw0[2] = PKW(C0, 4); if (g == 3) nw0[3] = PKW(C0, 6); \
        if (g == 4) nw1[0] = PKW(C0, 8); if (g == 5) nw1[1] = PKW(C0, 10); if (g == 6) nw1[2] = PKW(C0, 12); if (g == 7) nw1[3] = PKW(C0, 14); \
        if (g == 8) nw2[0] = PKW(C1, 0); if (g == 9) nw2[1] = PKW(C1, 2); if (g == 10) nw2[2] = PKW(C1, 4); if (g == 11) nw2[3] = PKW(C1, 6); \
        if (g == 12) nw3[0] = PKW(C1, 8); if (g == 13) nw3[1] = PKW(C1, 10); if (g == 14) nw3[2] = PKW(C1, 12); if (g == 15) nw3[3] = PKW(C1, 14); \
        PIN(sacc); SBAR(); } \
    l_reg += sacc; pw0 = nw0; pw1 = nw1; pw2 = nw2; pw3 = nw3; \
    } while (0)
    STEP(0, true, true, true, true); WAIT_BAR(3); RESC(); ROT();
    int s = 1;
    for (; s + 3 < n; ++s) { STEP(s, false, true, true, true); WAIT_BAR(3); RESC(); ROT(); }
    STEP(s, false, false, true, true); WAIT_BAR(2); RESC(); ROT(); ++s;
    STEP(s, false, false, true, true); WAIT_BAR(2); RESC(); ROT(); ++s;
    STEP(s, false, false, false, false); WAIT_BAR(0); RESC(); ROT();
    { const lds_cptr vp_ = vp0 + s_prev * VSLOT; s16x4 vlo[16], vhi[16];
#pragma unroll
      for (int g = 0; g < 16; ++g) VRD(g);
#pragma unroll
      for (int g = 0; g < 16; ++g) { const int ks_ = g >> 2, db_ = g & 3; const bf16x8 pa_ = (ks_ == 0) ? PAF(0) : (ks_ == 1) ? PAF(1) : (ks_ == 2) ? PAF(2) : PAF(3);
          o[db_] = MFMA32(pa_, VFRG(vlo[g], vhi[g]), o[db_]); } }
    { auto rr = __builtin_amdgcn_permlane32_swap(__float_as_uint(l_reg), __float_as_uint(l_reg), false, false); l_reg = __uint_as_float(rr[0]) + __uint_as_float(rr[1]); }
    if (hi == 0) wsf[32 + r32] = l_reg; asm volatile("s_waitcnt lgkmcnt(0)" ::: "memory");
    float rli[16];
#pragma unroll
    for (int r = 0; r < 16; ++r) rli[r] = __builtin_amdgcn_rcpf(wsf[32 + crow0(r) + 4 * hi]);
    bf16_t* Ow = AO + (rowbase + iw0) * PITCH + h * 128; __hip_bfloat16* stg = (__hip_bfloat16*)(lds + LDS_OST) + wid * 4096;
#pragma unroll
    for (int r = 0; r < 16; ++r) { const int orow = crow0(r) + 4 * hi;
#pragma unroll
        for (int db = 0; db < 4; ++db) stg[orow * 128 + db * 32 + r32] = __float2bfloat16(o[db][r] * rli[r]); }
    asm volatile("s_waitcnt lgkmcnt(0)" ::: "memory");
#pragma unroll
    for (int i = 0; i < 8; ++i) { const int row = i * 4 + (lane >> 4), ch = lane & 15; *(u32x4*)(Ow + (long)row * PITCH + ch * 8) = *(const u32x4*)(stg + row * 128 + ch * 8); }
    asm volatile("s_waitcnt lgkmcnt(0)\n\ts_barrier" ::: "memory");
#undef DMA_K
#undef DMA_V
#undef ROT
#undef EX
#undef RESC
#undef PKW
#undef PAF
#undef VFRG
#undef VRD
#undef STEP
}
#undef SBAR
#undef PIN
#undef MFMA32
#undef WAIT_BAR
#undef MX3
}
constexpr int NWAVES = 8;
constexpr int BATCH = 2, SEQ = 8192, DM = 1024, T = BATCH * SEQ, NEXP = 32, DEXP = 512;
constexpr float EPS = 1e-6f, LAM_INIT = 0.2f;
constexpr float C2 = 0.125f * 1.4426950408889634f;
constexpr float LOG2E = 1.4426950408889634f;
constexpr int ATT_THR = 8;

constexpr size_t MiB = 1u << 20;
constexpr size_t WS_CTL = 0, CTL_ZERO_BYTES = 65536;
constexpr size_t WS_LIST = 1 * MiB, WS_GLIST = 3 * MiB, WS_EPOS = 5 * MiB;
constexpr size_t WS_WIN = 6 * MiB, WS_WOUT = 10 * MiB, WS_WGU = 12 * MiB, WS_WD = 76 * MiB;
constexpr size_t WS_QKVU = 108 * MiB;
constexpr size_t WS_XN2 = 108 * MiB;
constexpr size_t WS_Y = 108 * MiB;
constexpr size_t WS_XN1 = 172 * MiB;
constexpr size_t WS_MIX = 172 * MiB;
constexpr size_t WS_AO = 204 * MiB;
constexpr size_t WS_HDN = 204 * MiB;
constexpr size_t WS_END = 244 * MiB;
constexpr int MAXROWS = 40960;
constexpr int CW_CNT = 64;
constexpr int CW_BAR = 4096;
constexpr int CW_KMAX = 8192;
constexpr int LDS_BYTES = 163840;
constexpr int MISC_OFF = LDS_BYTES - 256;
constexpr int MOE_TAB_OFF = 131072;
constexpr int RT_WR = 0, RT_SC = 148032, RT_SQ = 160320, RT_SR = 160576, RT_HI = 160832;

#define GAS __attribute__((address_space(1)))
#define LAS __attribute__((address_space(3)))
typedef unsigned short bf16;
typedef unsigned v4u __attribute__((ext_vector_type(4)));
typedef unsigned v2u __attribute__((ext_vector_type(2)));
typedef float f32x4 __attribute__((ext_vector_type(4)));
typedef GAS unsigned gu32;
#define RLX_AGENT __ATOMIC_RELAXED, __HIP_MEMORY_SCOPE_AGENT
#define LDS_WAIT() asm volatile("s_waitcnt lgkmcnt(0)" ::: "memory")
#define VM_WAIT() asm volatile("s_waitcnt vmcnt(0)" ::: "memory")
__device__ __forceinline__ unsigned f2bf(float f) { unsigned u = __builtin_bit_cast(unsigned, f); return (u + 0x7fffu + ((u >> 16) & 1u)) >> 16; }
__device__ __forceinline__ unsigned pk2(float lo, float hi) { return f2bf(lo) | (f2bf(hi) << 16); }
__device__ __forceinline__ float bflo(unsigned w) { return __uint_as_float(w << 16); }
__device__ __forceinline__ float bfhi(unsigned w) { return __uint_as_float(w & 0xffff0000u); }

#define XB_TMO      128
#define XB_XCNT(j)  (256  + 64 * (j))
#define XB_XSUB(j)  (1280 + 64 * (j))
#define XB_XGEN(j)  (2304 + 64 * (j))
#define XB_TOP      3328
#define XB_TOPGEN   3392
#define XCD_BAR_WORDS 3456
#define XB_SPIN_CAP (1u << 18)
__device__ __forceinline__ unsigned xb_ld(unsigned* p)              { return __hip_atomic_load(p, __ATOMIC_RELAXED, __HIP_MEMORY_SCOPE_AGENT); }
__device__ __forceinline__ unsigned xb_add(unsigned* p, unsigned v) { return __hip_atomic_fetch_add(p, v, __ATOMIC_RELAXED, __HIP_MEMORY_SCOPE_AGENT); }
__device__ __forceinline__ unsigned xb_xcc_id() { return (unsigned)__builtin_amdgcn_s_getreg((3 << 11) | 20) & 0xFu; }
#define XB_SPIN(cond, bar) do { unsigned _sp = 0; while (cond) { __builtin_amdgcn_s_sleep(1); \
    if ((++_sp & 255u) == 0u) { if (xb_ld(&(bar)[XB_TMO])) break; if (_sp > XB_SPIN_CAP) { atomicAdd(&(bar)[XB_TMO], 1u); break; } } } } while (0)
struct XcdBarrier { unsigned* bar; unsigned x; volatile LAS unsigned* st; };
__device__ __forceinline__ XcdBarrier xcd_barrier_post(unsigned* bar, volatile LAS unsigned* st) {
    XcdBarrier b; b.bar = bar; b.x = xb_xcc_id(); b.st = st;
    if (threadIdx.x == 0) (void)xb_add(&bar[XB_XCNT(b.x)], 1u);
    return b;
}
__device__ __forceinline__ void xcd_barrier_complete(unsigned* bar, unsigned x, unsigned& nloc, unsigned& nx) {
    const unsigned G = gridDim.x * gridDim.y * gridDim.z;
    unsigned sum, cnt, mine, sp = 0u;
    for (;;) {
        sum = 0u; cnt = 0u; mine = 0u;
#pragma unroll
        for (unsigned j = 0; j < 16; ++j) { const unsigned c = xb_ld(&bar[XB_XCNT(j)]); sum += c; cnt += (c > 0u) ? 1u : 0u; mine = (j == x) ? c : mine; }
        if (sum == G) break;
        __builtin_amdgcn_s_sleep(1);
        if ((++sp & 255u) == 0u) { if (xb_ld(&bar[XB_TMO])) break; if (sp > XB_SPIN_CAP) { atomicAdd(&bar[XB_TMO], 1u); break; } }
    }
    nloc = mine > 0u ? mine : 1u; nx = cnt > 0u ? cnt : 1u;
}
__device__ __forceinline__ void xcd_barrier(const XcdBarrier& b) {
    asm volatile("s_waitcnt vmcnt(0)" ::: "memory");
    __syncthreads();
    if (threadIdx.x == 0) {
        unsigned* bar = b.bar;
        __builtin_amdgcn_s_waitcnt(0);
        unsigned nloc = b.st[0], nx = b.st[1];
        if (nloc == 0u) { xcd_barrier_complete(bar, b.x, nloc, nx); b.st[0] = nloc; b.st[1] = nx; }
        const unsigned old = xb_add(&bar[XB_XSUB(b.x)], 1u);
        const unsigned gen = old / nloc;
        if (old + 1u == (gen + 1u) * nloc) {
            __builtin_amdgcn_fence(__ATOMIC_RELEASE, "agent");
            asm volatile("s_waitcnt vmcnt(0)" ::: "memory");
            const unsigned og = xb_add(&bar[XB_TOP], 1u);
            const unsigned tg = og / nx;
            if (og + 1u == (tg + 1u) * nx) xb_add(&bar[XB_TOPGEN], 1u);
            else XB_SPIN(xb_ld(&bar[XB_TOPGEN]) == tg, bar);
            __builtin_amdgcn_fence(__ATOMIC_ACQUIRE, "agent");
            xb_add(&bar[XB_XGEN(b.x)], 1u);
            asm volatile("s_waitcnt vmcnt(0)" ::: "memory");
        } else {
            XB_SPIN(xb_ld(&bar[XB_XGEN(b.x)]) == gen, bar);
            __builtin_amdgcn_fence(__ATOMIC_ACQUIRE, "agent");
            asm volatile("s_waitcnt vmcnt(0)" ::: "memory");
        }
    }
    __syncthreads();
}

__device__ __forceinline__ float wave_sum(float v) {
#pragma unroll
    for (int o = 1; o < 64; o <<= 1) v += __shfl_xor(v, o);
    return v;
}
struct TrItem { const float* src; int ldw; bf16* dst; size_t opitch; };
__device__ __forceinline__ void tr_load(const TrItem& I, float (&v)[32], int lane) {
#pragma unroll
    for (int i = 0; i < 32; ++i) v[i] = I.src[(size_t)(2 * i + (lane >> 5)) * I.ldw + (lane & 31)];
}
__device__ __forceinline__ void tr_finish(const TrItem& I, const float (&v)[32], LAS float* scr, int lane) {
#pragma unroll
    for (int i = 0; i < 32; ++i) scr[(2 * i + (lane >> 5)) * 33 + (lane & 31)] = v[i];
    LDS_WAIT(); asm volatile("" ::: "memory");
    const int c = lane & 7;
#pragma unroll
    for (int j = 0; j < 4; ++j) { const int n = (lane >> 3) + 8 * j; const LAS float* sp = scr + (8 * c) * 33 + n;
        v4u o; o.x = pk2(sp[0 * 33], sp[1 * 33]); o.y = pk2(sp[2 * 33], sp[3 * 33]); o.z = pk2(sp[4 * 33], sp[5 * 33]); o.w = pk2(sp[6 * 33], sp[7 * 33]);
        *(GAS v4u*)(I.dst + (size_t)n * I.opitch + 8 * c) = o; }
    LDS_WAIT(); asm volatile("" ::: "memory");
}
template <int NR> __device__ __forceinline__ void rms_rows_to_bf16(const float* x, const float* g, bf16* o, int m0, int stride, int mend, int lane) {
    f32x4 v[NR][4];
#pragma unroll
    for (int k = 0; k < NR; ++k) { const int m = m0 + k * stride; const GAS f32x4* xr = (const GAS f32x4*)(x + (size_t)(m < mend ? m : m0) * DM) + lane;
#pragma unroll
        for (int j = 0; j < 4; ++j) v[k][j] = xr[64 * j]; }
    const GAS f32x4* gr = (const GAS f32x4*)g + lane; f32x4 gg[4];
#pragma unroll
    for (int j = 0; j < 4; ++j) gg[j] = gr[64 * j];
#pragma unroll
    for (int k = 0; k < NR; ++k) { const int m = m0 + k * stride; float s = 0.f;
#pragma unroll
        for (int j = 0; j < 4; ++j) s += (v[k][j].x * v[k][j].x + v[k][j].y * v[k][j].y) + (v[k][j].z * v[k][j].z + v[k][j].w * v[k][j].w);
        const float rstd = 1.0f / sqrtf(wave_sum(s) * (1.f / DM) + EPS);
        if (m < mend) { GAS v2u* o8 = (GAS v2u*)(o + (size_t)m * DM) + lane;
#pragma unroll
            for (int j = 0; j < 4; ++j) { v2u w; w.x = pk2(v[k][j].x * rstd * gg[j].x, v[k][j].y * rstd * gg[j].y); w.y = pk2(v[k][j].z * rstd * gg[j].z, v[k][j].w * rstd * gg[j].w); o8[64 * j] = w; } } }
}

struct Args { const float* in[20]; float* out; unsigned char* ws; int ph_lo, ph_hi; };

__global__ void __launch_bounds__(NWAVES * 64, 2) mk_fwd(Args args) {
    extern __shared__ __attribute__((aligned(16))) unsigned char lds[];
    LAS unsigned char* L = (LAS unsigned char*)lds;
    volatile LAS unsigned* MISC = (volatile LAS unsigned*)(L + MISC_OFF);
    const int tid = threadIdx.x, lane = tid & 63, wave = __builtin_amdgcn_readfirstlane(tid >> 6);
    const int G = gridDim.x; const int bx = blockIdx.x; const int vcu = (G % 8 == 0) ? (bx % 8) * (G / 8) + bx / 8 : bx;
    unsigned char* ws = args.ws;
    gu32* ctl = (gu32*)(ws + WS_CTL);
    const float* x = args.in[0]; const float* n1g = args.in[1]; const float* w_in = args.in[2];
    const float* lq1 = args.in[3]; const float* lk1 = args.in[4]; const float* lq2 = args.in[5]; const float* lk2 = args.in[6];
    const float* subg = args.in[7]; const float* wpool = args.in[8]; const float* pscale = args.in[9]; const float* w_out = args.in[10];
    const float* n2g = args.in[11]; const float* wgr = args.in[12]; const float* bgr = args.in[13]; const float* wer = args.in[14];
    const float* ber = args.in[15]; const float* wgate = args.in[16]; const float* wup = args.in[17]; const float* wdown = args.in[18]; const float* fing = args.in[19];
    float* out = args.out;
    bf16* Win_t = (bf16*)(ws + WS_WIN); bf16* Wout_t = (bf16*)(ws + WS_WOUT); bf16* Wgu_t = (bf16*)(ws + WS_WGU); bf16* Wd_t = (bf16*)(ws + WS_WD);
    bf16* QKVU = (bf16*)(ws + WS_QKVU); bf16* XN1 = (bf16*)(ws + WS_XN1); bf16* MIX = (bf16*)(ws + WS_MIX); bf16* AO = (bf16*)(ws + WS_AO);
    bf16* XN2 = (bf16*)(ws + WS_XN2); bf16* HDN = (bf16*)(ws + WS_HDN); bf16* Y = (bf16*)(ws + WS_Y);
    int* list = (int*)(ws + WS_LIST); float* glist = (float*)(ws + WS_GLIST); int* epos = (int*)(ws + WS_EPOS);
    for (int u = tid; u < 64; u += NWAVES * 64) ((LAS unsigned*)(L + MISC_OFF))[u] = 0u;
    __syncthreads();
    XcdBarrier bar = xcd_barrier_post((unsigned*)(ctl + CW_BAR), MISC + 8);
    const int lo = args.ph_lo, hi = args.ph_hi;
#define IN(k) (lo <= (k) && (k) < hi)
#define SEAM(k) do { if (IN(k) && IN((k) + 1)) xcd_barrier(bar); } while (0)
    const int gw = vcu * NWAVES + wave, NGW = G * NWAVES;

    if (IN(0)) {
        LAS float* scr = (LAS float*)(L + wave * 16384);
        constexpr int I_WIN = 16 * 64, I_WO = 8 * 32, I_G = 16 * 16, I_D = 8 * 32;
        constexpr int NITEMS = I_WIN + I_WO + NEXP * (2 * I_G + I_D);
        auto decode = [&](int it) -> TrItem { TrItem I; int r = it;
            if (r < I_WIN) { const int kb = r / 64, nb = r % 64; I.src = w_in + (size_t)(64 * kb) * 2048 + 32 * nb; I.ldw = 2048; I.dst = Win_t + (size_t)(32 * nb) * 1024 + 64 * kb; I.opitch = 1024; return I; } r -= I_WIN;
            if (r < I_WO) { const int kb = r / 32, nb = r % 32; I.src = w_out + (size_t)(64 * kb) * 1024 + 32 * nb; I.ldw = 1024; I.dst = Wout_t + (size_t)(32 * nb) * 1024 + 64 * kb; I.opitch = 1024; return I; } r -= I_WO;
            const int e = r / (2 * I_G + I_D); r -= e * (2 * I_G + I_D);
            if (r < 2 * I_G) { const int up = r / I_G; r -= up * I_G; const int kb = r / 16, nb = r % 16, n0 = 32 * nb;
                I.src = (up ? wup : wgate) + (size_t)e * 1024 * 512 + (size_t)(64 * kb) * 512 + n0; I.ldw = 512;
                I.dst = Wgu_t + (size_t)e * 1024 * 1024 + (size_t)((n0 >> 7) * 256 + 128 * up + (n0 & 127)) * 1024 + 64 * kb; I.opitch = 1024; return I; }
            r -= 2 * I_G;
            { const int kb = r / 32, nb = r % 32; I.src = wdown + (size_t)e * 512 * 1024 + (size_t)(64 * kb) * 1024 + 32 * nb; I.ldw = 1024; I.dst = Wd_t + (size_t)e * 1024 * 512 + (size_t)(32 * nb) * 512 + 64 * kb; I.opitch = 512; return I; } };
        { float va[32], vb[32]; int it = gw; TrItem Ia, Ib;
          if (it < NITEMS) { Ia = decode(it); tr_load(Ia, va, lane); }
          while (it < NITEMS) {
              const int itb = it + NGW; if (itb < NITEMS) { Ib = decode(itb); tr_load(Ib, vb, lane); }
              tr_finish(Ia, va, scr, lane);
              if (itb >= NITEMS) break;
              const int itc = itb + NGW; if (itc < NITEMS) { Ia = decode(itc); tr_load(Ia, va, lane); }
              tr_finish(Ib, vb, scr, lane);
              it = itc; } }
        for (int m = gw; m < T; m += 4 * NGW) rms_rows_to_bf16<4>(x, n1g, XN1, m, NGW, T, lane);
        __syncthreads();
        for (int id = bx; id < 256; id += G) {
            const int g = id >> 6, kb = (id >> 4) & 3, nb = id & 15;
            LAS float* WoS = (LAS float*)L; LAS float* wps = (LAS float*)(L + 32768);
            { f32x4 t4[4];
#pragma unroll
              for (int q = 0; q < 4; ++q) { const int f = tid + 512 * q, dd = f >> 4, c4 = (f & 15) * 4; t4[q] = *(const GAS f32x4*)(w_out + (size_t)(512 + g * 128 + dd) * 1024 + nb * 64 + c4); }
              float w8[8], p8[8];
#pragma unroll
              for (int q = 0; q < 8; ++q) { const int f = tid + 512 * q, kk = f >> 7, dd = f & 127; w8[q] = wpool[(size_t)(g * 128 + kb * 32 + kk) * 128 + dd]; p8[q] = pscale[g * 128 + dd]; }
#pragma unroll
              for (int q = 0; q < 4; ++q) { const int f = tid + 512 * q; *(LAS f32x4*)(WoS + (f >> 4) * 64 + (f & 15) * 4) = t4[q]; }
#pragma unroll
              for (int q = 0; q < 8; ++q) { const int f = tid + 512 * q; wps[(f >> 7) * 129 + (f & 127)] = w8[q] * p8[q]; } }
            __syncthreads();
            { const int kk = tid >> 4, c4 = (tid & 15) * 4; f32x4 acc = {0.f, 0.f, 0.f, 0.f};
#pragma unroll 8
              for (int dd = 0; dd < 128; ++dd) { const float w = wps[kk * 129 + dd]; const f32x4 wo = *(const LAS f32x4*)(WoS + dd * 64 + c4); acc = acc + wo * w; }
              bf16* dst = Wout_t + (size_t)(nb * 64 + c4) * 1024 + 512 + g * 128 + kb * 32 + kk;
              dst[0] = (bf16)f2bf(acc.x); dst[1024] = (bf16)f2bf(acc.y); dst[2048] = (bf16)f2bf(acc.z); dst[3072] = (bf16)f2bf(acc.w); }
            __syncthreads();
        }
    }
    SEAM(0);
    if (IN(1)) {
        pg8::Gemm g{XN1, Win_t, T, 2048, DM}; pg8::StaticOrder S; S.init(g, G, bx);
        pg8::EpiBf16 E{QKVU, 512, 512, (size_t)T * 512, C2, (unsigned*)(ctl + CW_KMAX)};
        pg8::gemm_phase<pg8::EpiBf16, pg8::StaticOrder, false>(L, DM, S, E);
    }
    SEAM(1);
    if (IN(2)) {
        const int xg = vcu >> 5, i5 = vcu & 31, b = xg >> 2, ty = (xg >> 1) & 1, qb = 16 * (xg & 1) + (i5 >> 1), c = i5 & 1;
        if (vcu < 256) {
#pragma unroll 1
            for (int u = 0; u < 2; ++u) { const int h = (u == 0) ? (ty ? 2 : 3) : (ty ? 1 : 0);
                const float slope = exp2f(-2.0f * (float)(h + 1)), sg2 = slope * LOG2E;
                attn::attn_unit<ATT_THR>(b, h, c, qb, sg2, QKVU, QKVU + (size_t)T * 512, QKVU + (size_t)2 * T * 512, AO + (size_t)c * T * 512, (const unsigned*)(ctl + CW_KMAX) + (size_t)b * 128 * 8, (char*)lds); }
        }
    }
    SEAM(2);
    if (IN(3)) {
        float s1 = wave_sum(lq1[lane] * lk1[lane]), s2 = wave_sum(lq2[lane] * lk2[lane]);
        const float lam = expf(s1) - expf(s2) + LAM_INIT;
        const bf16* U = QKVU + (size_t)3 * T * 512;
        float sg[8];
#pragma unroll
        for (int j = 0; j < 8; ++j) sg[j] = subg[(8 * lane + j) & 127] * (1.0f - LAM_INIT);
        for (int t0 = gw * 8; t0 < T; t0 += NGW * 8) {
            v4u a1[8], a2[8], ur[23];
#pragma unroll
            for (int q = 0; q < 8; ++q) { a1[q] = *(const GAS v4u*)(AO + (size_t)(t0 + q) * 512 + 8 * lane); a2[q] = *(const GAS v4u*)(AO + (size_t)(T + t0 + q) * 512 + 8 * lane); }
            const int tt0 = t0 & (SEQ - 1), tb = t0 - tt0;
#pragma unroll
            for (int k = 0; k < 23; ++k) { int j = tt0 - 8 + k; j = j < 0 ? 0 : (j > SEQ - 1 ? SEQ - 1 : j); ur[k] = *(const GAS v4u*)(U + (size_t)(tb + j) * 512 + 8 * lane); }
#pragma unroll
            for (int q = 0; q < 8; ++q) {
                float a[8];
#pragma unroll
                for (int j = 0; j < 4; ++j) { a[2 * j] = bflo(a1[q][j]) - lam * bflo(a2[q][j]); a[2 * j + 1] = bfhi(a1[q][j]) - lam * bfhi(a2[q][j]); }
                float ss = 0.f;
#pragma unroll
                for (int j = 0; j < 8; ++j) ss += a[j] * a[j];
                ss += __shfl_xor(ss, 1); ss += __shfl_xor(ss, 2); ss += __shfl_xor(ss, 4); ss += __shfl_xor(ss, 8);
                const float r = 1.0f / sqrtf(ss * (1.0f / 128.0f) + EPS);
                v4u o; o.x = pk2(a[0] * r * sg[0], a[1] * r * sg[1]); o.y = pk2(a[2] * r * sg[2], a[3] * r * sg[3]); o.z = pk2(a[4] * r * sg[4], a[5] * r * sg[5]); o.w = pk2(a[6] * r * sg[6], a[7] * r * sg[7]);
                *(GAS v4u*)(MIX + (size_t)(t0 + q) * 1024 + 8 * lane) = o;
            }
            const int hw = 1 << (lane >> 4);
#pragma unroll
            for (int q = 0; q < 8; ++q) {
                const int tt = tt0 + q; int jlo = tt - hw, jhi = tt + hw; jlo = jlo < 0 ? 0 : jlo; jhi = jhi > SEQ ? SEQ : jhi;
                float sm[8] = {0.f, 0.f, 0.f, 0.f, 0.f, 0.f, 0.f, 0.f};
#pragma unroll
                for (int k = q; k < q + 16; ++k) { const int j = tt0 - 8 + k; const float wgt = (j >= jlo && j < jhi) ? 1.0f : 0.0f;
#pragma unroll
                    for (int p = 0; p < 4; ++p) { sm[2 * p] = __builtin_fmaf(wgt, bflo(ur[k][p]), sm[2 * p]); sm[2 * p + 1] = __builtin_fmaf(wgt, bfhi(ur[k][p]), sm[2 * p + 1]); } }
                const float ic = 1.0f / (float)(jhi - jlo); const v4u ut = ur[8 + q];
                v4u d; d.x = pk2(sm[0] * ic - bflo(ut[0]), sm[1] * ic - bfhi(ut[0])); d.y = pk2(sm[2] * ic - bflo(ut[1]), sm[3] * ic - bfhi(ut[1]));
                d.z = pk2(sm[4] * ic - bflo(ut[2]), sm[5] * ic - bfhi(ut[2])); d.w = pk2(sm[6] * ic - bflo(ut[3]), sm[7] * ic - bfhi(ut[3]));
                *(GAS v4u*)(MIX + (size_t)(t0 + q) * 1024 + 512 + 8 * lane) = d;
            }
        }
    }
    SEAM(3);
    if (IN(4)) {
        pg8::Gemm g{MIX, Wout_t, T, DM, DM}; pg8::StaticOrder S; S.init(g, G, bx);
        pg8::EpiResF32 E{x, out, DM};
        pg8::gemm_phase<pg8::EpiResF32, pg8::StaticOrder, false>(L, DM, S, E);
    }
    SEAM(4);
    if (IN(5)) {
        LAS float* WR = (LAS float*)(L + RT_WR); LAS float* SC = (LAS float*)(L + RT_SC); LAS float* SQ = (LAS float*)(L + RT_SQ); LAS float* SR = (LAS float*)(L + RT_SR);
        { float wv[8], gv[8];
#pragma unroll
          for (int q = 0; q < 8; ++q) { const int idx = tid + 512 * q; wv[q] = wgr[idx]; gv[q] = n2g[idx >> 2]; }
#pragma unroll
          for (int q = 0; q < 8; ++q) { const int idx = tid + 512 * q; WR[(idx & 3) * 1028 + (idx >> 2)] = wv[q] * gv[q]; }
          for (int base = 0; base < 1024 * 32; base += 512 * 16) { float w16[16], g16[16];
#pragma unroll
              for (int q = 0; q < 16; ++q) { const int idx = base + tid + 512 * q; w16[q] = wer[idx]; g16[q] = n2g[idx >> 5]; }
#pragma unroll
              for (int q = 0; q < 16; ++q) { const int idx = base + tid + 512 * q; WR[(4 + (idx & 31)) * 1028 + (idx >> 5)] = w16[q] * g16[q]; } } }
        LAS unsigned* HI = (LAS unsigned*)(L + RT_HI); LAS unsigned* HB = HI + 32;
        if (tid < 32) HI[tid] = 0u;
        __syncthreads();
        const int gq = wave & 3, kh = wave >> 2, tk = lane & 15, kq = lane >> 4;
        for (int tb = vcu * 64; tb < T; tb += G * 64) {
            const float* hrow = out + (size_t)(tb + 16 * gq + tk) * DM + 512 * kh + 4 * kq;
            f32x4 acc[3] = {{0.f, 0.f, 0.f, 0.f}, {0.f, 0.f, 0.f, 0.f}, {0.f, 0.f, 0.f, 0.f}}; float ssq = 0.f;
            int r_ea = 0, r_eb = 0, r_pa = 0, r_pb = 0; float r_g1 = 0.f, r_g2 = 0.f;
            int nn[3];
#pragma unroll
            for (int nb = 0; nb < 3; ++nb) { const int n = 16 * nb + tk; nn[nb] = (n < 36 ? n : 35) * 1028 + 512 * kh + 4 * kq; }
#pragma unroll 8
            for (int s = 0; s < 32; ++s) {
                const f32x4 hv = *(const GAS f32x4*)(hrow + 16 * s);
                ssq += (hv.x * hv.x + hv.y * hv.y) + (hv.z * hv.z + hv.w * hv.w);
#pragma unroll
                for (int nb = 0; nb < 3; ++nb) { const f32x4 bv = *(const LAS f32x4*)(WR + nn[nb] + 16 * s);
                    acc[nb] = __builtin_amdgcn_mfma_f32_16x16x4f32(hv.x, bv.x, acc[nb], 0, 0, 0); acc[nb] = __builtin_amdgcn_mfma_f32_16x16x4f32(hv.y, bv.y, acc[nb], 0, 0, 0);
                    acc[nb] = __builtin_amdgcn_mfma_f32_16x16x4f32(hv.z, bv.z, acc[nb], 0, 0, 0); acc[nb] = __builtin_amdgcn_mfma_f32_16x16x4f32(hv.w, bv.w, acc[nb], 0, 0, 0); }
            }
            ssq += __shfl_xor(ssq, 16); ssq += __shfl_xor(ssq, 32);
            if (kh == 1) {
#pragma unroll
                for (int nb = 0; nb < 3; ++nb)
#pragma unroll
                    for (int r = 0; r < 4; ++r) SC[gq * 768 + (nb * 4 + r) * 64 + lane] = acc[nb][r];
                if (kq == 0) SQ[gq * 16 + tk] = ssq;
            }
            __syncthreads();
            if (kh == 0) {
#pragma unroll
                for (int nb = 0; nb < 3; ++nb)
#pragma unroll
                    for (int r = 0; r < 4; ++r) acc[nb][r] += SC[gq * 768 + (nb * 4 + r) * 64 + lane];
                const float sq2 = ssq + SQ[gq * 16 + tk];
                LDS_WAIT(); asm volatile("" ::: "memory");
#pragma unroll
                for (int nb = 0; nb < 3; ++nb)
#pragma unroll
                    for (int r = 0; r < 4; ++r) SC[gq * 768 + (4 * kq + r) * 48 + 16 * nb + tk] = acc[nb][r];
                LDS_WAIT(); asm volatile("" ::: "memory");
                if (lane < 16) {
                    const int t = tb + 16 * gq + lane; const float rstd = 1.0f / sqrtf(sq2 * (1.0f / DM) + EPS);
                    SR[gq * 16 + lane] = rstd;
                    const LAS float* lg = SC + gq * 768 + lane * 48;
                    float gl[4];
#pragma unroll
                    for (int g = 0; g < 4; ++g) gl[g] = lg[g] * rstd + bgr[g];
                    int gs = 0; float gm = gl[0];
#pragma unroll
                    for (int g = 1; g < 4; ++g) if (gl[g] > gm) { gm = gl[g]; gs = g; }
                    float den = 0.f;
#pragma unroll
                    for (int g = 0; g < 4; ++g) den += expf(gl[g] - gm);
                    const float pg = 1.0f / den;
                    float e8[8];
#pragma unroll
                    for (int i = 0; i < 8; ++i) e8[i] = lg[4 + gs * 8 + i] * rstd + ber[gs * 8 + i];
                    float v1 = e8[0]; int i1 = 0;
#pragma unroll
                    for (int i = 1; i < 8; ++i) if (e8[i] > v1) { v1 = e8[i]; i1 = i; }
                    float v2 = -3.0e38f; int i2 = 0;
#pragma unroll
                    for (int i = 0; i < 8; ++i) if (i != i1 && e8[i] > v2) { v2 = e8[i]; i2 = i; }
                    const float p2 = expf(v2 - v1), g1 = pg / (1.0f + p2), g2 = pg * p2 / (1.0f + p2);
                    const int ea = gs * 8 + i1, eb = gs * 8 + i2;
                    r_ea = ea; r_eb = eb; r_g1 = g1; r_g2 = g2;
                    r_pa = (int)__hip_atomic_fetch_add((LAS unsigned*)HI + ea, 1u, __ATOMIC_RELAXED, __HIP_MEMORY_SCOPE_WORKGROUP);
                    r_pb = (int)__hip_atomic_fetch_add((LAS unsigned*)HI + eb, 1u, __ATOMIC_RELAXED, __HIP_MEMORY_SCOPE_WORKGROUP);
                }
            }
            __syncthreads();
            if (tid < 32) { const unsigned c = HI[tid]; HB[tid] = c ? atomicAdd((unsigned*)(ctl + CW_CNT + 64 * tid), c) : 0u; }
            __syncthreads();
            if (kh == 0 && lane < 16) { const int t = tb + 16 * gq + lane; const int pa = r_pa + (int)HB[r_ea], pb = r_pb + (int)HB[r_eb];
                list[(size_t)r_ea * 16384 + pa] = t; glist[(size_t)r_ea * 16384 + pa] = r_g1; list[(size_t)r_eb * 16384 + pb] = t; glist[(size_t)r_eb * 16384 + pb] = r_g2;
                epos[t * 2] = (r_ea << 16) | pa; epos[t * 2 + 1] = (r_eb << 16) | pb; }
            if (tid < 32) HI[tid] = 0u;
            { const GAS f32x4* gr = (const GAS f32x4*)n2g + lane; f32x4 gg[4];
#pragma unroll
              for (int j = 0; j < 4; ++j) gg[j] = gr[64 * j];
#pragma unroll
              for (int qb_ = 0; qb_ < 2; ++qb_) { f32x4 v[4][4];
#pragma unroll
                  for (int q = 0; q < 4; ++q) { const GAS f32x4* hr = (const GAS f32x4*)(out + (size_t)(tb + 8 * wave + 4 * qb_ + q) * DM) + lane;
#pragma unroll
                      for (int j = 0; j < 4; ++j) v[q][j] = hr[64 * j]; }
#pragma unroll
                  for (int q = 0; q < 4; ++q) { const int tl = 8 * wave + 4 * qb_ + q; const float rstd = SR[tl]; GAS v2u* o8 = (GAS v2u*)(XN2 + (size_t)(tb + tl) * DM) + lane;
#pragma unroll
                      for (int j = 0; j < 4; ++j) { v2u w; w.x = pk2(v[q][j].x * rstd * gg[j].x, v[q][j].y * rstd * gg[j].y); w.y = pk2(v[q][j].z * rstd * gg[j].z, v[q][j].w * rstd * gg[j].w); o8[64 * j] = w; } } } }
            __syncthreads();
        }
    }
    SEAM(5);
    LAS int* tstart = (LAS int*)(L + MOE_TAB_OFF); LAS int* ecnt = (LAS int*)(L + MOE_TAB_OFF + 256);
    if (IN(6) || IN(7) || IN(8)) {
        if (tid < 32) ecnt[tid] = (int)__hip_atomic_load(ctl + CW_CNT + 64 * tid, RLX_AGENT);
        __syncthreads();
        if (tid == 0) { int a = 0; for (int e = 0; e < 32; ++e) { tstart[e] = a; a += (ecnt[e] + 255) >> 8; } tstart[32] = a; }
        __syncthreads();
    }
    if (IN(6)) {
        pg8::MoeOrder<true> S; S.tstart = tstart; S.cnt = ecnt; S.ntiles = tstart[32]; S.G = G; S.c = vcu; S.A = XN2; S.Bt = Wgu_t; S.a_tstep = 0; S.b_estep = (size_t)1024 * 1024 * 2; S.b_tstep = (size_t)256 * 1024 * 2; S.list = list; S.Kb = 2048;
        pg8::EpiSwiGLU E{HDN};
        pg8::gemm_phase<pg8::EpiSwiGLU, pg8::MoeOrder<true>, true>(L, DM, S, E);
    }
    SEAM(6);
    if (IN(7)) {
        pg8::MoeOrder<false> S; S.tstart = tstart; S.cnt = ecnt; S.ntiles = tstart[32]; S.G = G; S.c = vcu; S.A = HDN; S.Bt = Wd_t; S.a_tstep = (size_t)256 * 512 * 2; S.b_estep = (size_t)1024 * 512 * 2; S.b_tstep = (size_t)256 * 512 * 2; S.list = list; S.Kb = 1024;
        pg8::EpiGateBf16 E{Y, glist};
        pg8::gemm_phase<pg8::EpiGateBf16, pg8::MoeOrder<false>, false>(L, DEXP, S, E);
    }
    SEAM(7);
    if (IN(8)) {
        const GAS f32x4* gr = (const GAS f32x4*)fing + lane; f32x4 gg[4];
#pragma unroll
        for (int j = 0; j < 4; ++j) gg[j] = gr[64 * j];
        for (int t0 = gw; t0 < T; t0 += 4 * NGW) {
            int pa[4], pb[4];
#pragma unroll
            for (int q = 0; q < 4; ++q) { const int t = t0 + q * NGW; pa[q] = epos[(t < T ? t : t0) * 2]; pb[q] = epos[(t < T ? t : t0) * 2 + 1]; }
            f32x4 v[4][4]; v2u ya[4][4], yb[4][4];
#pragma unroll
            for (int q = 0; q < 4; ++q) { const int t = (t0 + q * NGW < T) ? t0 + q * NGW : t0;
                const size_t ra = (size_t)tstart[pa[q] >> 16] * 256 + (pa[q] & 0xffff), rb = (size_t)tstart[pb[q] >> 16] * 256 + (pb[q] & 0xffff);
                const GAS f32x4* hr = (const GAS f32x4*)(out + (size_t)t * DM) + lane; const GAS v2u* pya = (const GAS v2u*)(Y + ra * 1024) + lane; const GAS v2u* pyb = (const GAS v2u*)(Y + rb * 1024) + lane;
#pragma unroll
                for (int j = 0; j < 4; ++j) { v[q][j] = hr[64 * j]; ya[q][j] = pya[64 * j]; yb[q][j] = pyb[64 * j]; } }
#pragma unroll
            for (int q = 0; q < 4; ++q) { const int t = t0 + q * NGW; float s = 0.f;
#pragma unroll
                for (int j = 0; j < 4; ++j) { const v2u a = ya[q][j], bq = yb[q][j];
                    v[q][j].x += bflo(a.x) + bflo(bq.x); v[q][j].y += bfhi(a.x) + bfhi(bq.x); v[q][j].z += bflo(a.y) + bflo(bq.y); v[q][j].w += bfhi(a.y) + bfhi(bq.y);
                    s += (v[q][j].x * v[q][j].x + v[q][j].y * v[q][j].y) + (v[q][j].z * v[q][j].z + v[q][j].w * v[q][j].w); }
                const float rstd = 1.0f / sqrtf(wave_sum(s) * (1.f / DM) + EPS);
                if (t < T) { GAS f32x4* orow = (GAS f32x4*)(out + (size_t)t * DM) + lane;
#pragma unroll
                    for (int j = 0; j < 4; ++j) orow[64 * j] = v[q][j] * rstd * gg[j]; } }
        }
    }
#undef IN
#undef SEAM
}

extern "C" void kernel_launch(void* const* d_in, const int* in_sizes, int n_in, void* d_out, int out_size, void* d_ws, size_t ws_size, hipStream_t stream) {
    static int grid = 0;
    if (grid == 0) {
        if (n_in != 20 || in_sizes[0] != T * DM || out_size != T * DM || ws_size < WS_END) { fprintf(stderr, "kernel_launch: unexpected shapes: n_in %d in0 %d out %d ws %zu; nothing launched\n", n_in, n_in > 0 ? in_sizes[0] : -1, out_size, ws_size); grid = -1; return; }
        int dev = 0, cus = 0;
        if (hipGetDevice(&dev) != hipSuccess || hipDeviceGetAttribute(&cus, hipDeviceAttributeMultiprocessorCount, dev) != hipSuccess) { grid = -1; return; }
        if (hipFuncSetAttribute((const void*)mk_fwd, hipFuncAttributeMaxDynamicSharedMemorySize, LDS_BYTES) != hipSuccess) { fprintf(stderr, "kernel_launch: hipFuncSetAttribute failed\n"); grid = -1; return; }
        (void)hipGetLastError();
        grid = cus;
    }
    if (grid < 0) return;
    (void)hipMemsetAsync((char*)d_ws + WS_CTL, 0, CTL_ZERO_BYTES, stream);
    Args a{};
    for (int i = 0; i < 20; ++i) a.in[i] = (const float*)d_in[i];
    a.out = (float*)d_out; a.ws = (unsigned char*)d_ws;
#ifndef MK_N_LAUNCHES
#define MK_N_LAUNCHES 1
#endif
    constexpr int NPH = 9;
    if (MK_N_LAUNCHES == 1) { a.ph_lo = 0; a.ph_hi = NPH; hipLaunchKernelGGL(mk_fwd, dim3(grid), dim3(NWAVES * 64), LDS_BYTES, stream, a); }
    else for (int p = 0; p < NPH; ++p) { a.ph_lo = p; a.ph_hi = p + 1; hipLaunchKernelGGL(mk_fwd, dim3(grid), dim3(NWAVES * 64), LDS_BYTES, stream, a); }
}
```

```cpp
#include <hip/hip_runtime.h>
#include <hip/hip_bf16.h>
#include <cstdio>
#include <cstdint>
#include <cmath>
namespace pg8 {
#define PG8_LAS __attribute__((address_space(3)))
typedef unsigned short bf16_t;
typedef short bf16x8 __attribute__((ext_vector_type(8)));
typedef float f32x4 __attribute__((ext_vector_type(4)));
typedef float f32x2 __attribute__((ext_vector_type(2)));
typedef unsigned u32x4 __attribute__((ext_vector_type(4)));
constexpr int BM = 256, BK = 64, HALF = 128, HTB = HALF * BK * 2  , STAGE_BYTES = 8 * HTB, NXCD = 8, WGM = 8;

__host__ __device__ __forceinline__ int lds_byte(int r, int c) { const int st = (r >> 4) * 2 + (c >> 5), rr = r & 15, cc = c & 31, ob = rr * 64 + cc * 2; return st * 1024 + (ob ^ (((ob >> 9) & 1) << 5)); }
__host__ __device__ __forceinline__ void stage_rc(int b, int& R, int& C) { const int st = b / 1024, sb = b % 1024, swz = sb ^ (((sb >> 9) & 1) << 5); R = (st >> 1) * 16 + swz / 64; C = (st & 1) * 32 + (swz % 64) / 2; }
__host__ __device__ __forceinline__ int perm32(int rho) { const int n = rho >> 4, i = rho & 15; return 8 * (i >> 2) + 4 * n + (i & 3); }

struct Unit { int pm, pn, e, lt, cnt; };
struct Gemm { const bf16_t* A; const bf16_t* Bt; int M, N, K; };

struct StaticOrder {
    int nM, nN, nwg, G, c; const bf16_t* A; const bf16_t* Bt; size_t tstep;
    __device__ void init(const Gemm& g, int G_, int c_) { nM = g.M / BM; nN = g.N / BM; nwg = nM * nN; G = G_; c = c_; A = g.A; Bt = g.Bt; tstep = (size_t)BM * g.K * 2; }
    __device__ bool next(int i, Unit& u) const {
        const long L = (long)i * G + c; if (L >= nwg) return false;
        int wgid = (int)L; { const int q = nwg / NXCD, r = nwg % NXCD, xcd = wgid % NXCD, off = wgid / NXCD; wgid = (xcd < r ? xcd * (q + 1) : r * (q + 1) + (xcd - r) * q) + off; }
        const int nig = WGM * nN, gid = wgid / nig, fm = gid * WGM, gsz = (nM - fm) < WGM ? (nM - fm) : WGM;
        u.pm = fm + ((wgid % nig) % gsz); u.pn = (wgid % nig) / gsz; u.e = 0; u.lt = 0; u.cnt = 0; return true;
    }
    __device__ __forceinline__ const char* a_base(const Unit& u) const { return (const char*)A + (size_t)u.pm * tstep; }
    __device__ __forceinline__ const char* b_base(const Unit& u) const { return (const char*)Bt + (size_t)u.pn * tstep; }
    __device__ __forceinline__ unsigned row_off(const Unit&, int) const { return 0u; }
};
template <bool GATHER> struct MoeOrder {
    const PG8_LAS int* tstart; const PG8_LAS int* cnt; int ntiles, G, c;
    const bf16_t* A; const bf16_t* Bt; size_t a_tstep, b_estep, b_tstep; const int* list; int Kb  ;
    __device__ bool next(int i, Unit& u) const {
        const long L = (long)i * G + c; if (L >= 4L * ntiles) return false;
        const int rt = (int)(L >> 2); u.pn = (int)(L & 3); u.pm = rt;
        int e = 0;
#pragma unroll
        for (int k = 1; k < 32; ++k) e += (rt >= tstart[k]) ? 1 : 0;
        e = __builtin_amdgcn_readfirstlane(e);
        u.e = e; u.lt = __builtin_amdgcn_readfirstlane(rt - tstart[e]); u.cnt = __builtin_amdgcn_readfirstlane(cnt[e]); return true;
    }
    __device__ __forceinline__ const char* a_base(const Unit& u) const { return GATHER ? (const char*)A : (const char*)A + (size_t)u.pm * a_tstep; }
    __device__ __forceinline__ const char* b_base(const Unit& u) const { return (const char*)Bt + (size_t)u.e * b_estep + (size_t)u.pn * b_tstep; }
    __device__ __forceinline__ unsigned row_off(const Unit& u, int R) const { const int pos = u.lt * BM + R; const int tok = (pos < u.cnt) ? list[(size_t)u.e * 16384 + pos] : 0; return (unsigned)tok * (unsigned)Kb; }
};

__device__ __forceinline__ unsigned cvt_pk_bf16(float lo, float hi) { unsigned r; asm volatile("v_cvt_pk_bf16_f32 %0, %1, %2" : "=v"(r) : "v"(lo), "v"(hi)); return r; }

struct EpiBf16 {
    static constexpr bool PERM = true;
    bf16_t* O; int ldc; int split_cols; size_t split_stride; float scale0; unsigned* kmax;
    __device__ __forceinline__ void operator()(const f32x4 (&acc)[2][2][4][2], const Unit& u, int wr, int wc, int fr, int fq) const {
        const int row0 = u.pm * BM + wr * 64 + fr; int colt = u.pn * BM; bf16_t* base = O;
        float sc = 1.f; int tsplit = 0; if (split_cols) { const int t = colt / split_cols; tsplit = t; base += (size_t)t * split_stride; colt -= t * split_cols; if (t == 0) sc = scale0; }
        const int col0 = colt + wc * 32 + 8 * fq;
        if (kmax && tsplit == 1) {
#pragma unroll
            for (int ai = 0; ai < 2; ++ai)
#pragma unroll
                for (int bj = 0; bj < 2; ++bj) { float mx = 0.f;
#pragma unroll
                    for (int m = 0; m < 4; ++m) { const f32x4 a = acc[ai][bj][m][0], b = acc[ai][bj][m][1];
                        float ss = (a[0] * a[0] + a[1] * a[1]) + (a[2] * a[2] + a[3] * a[3]) + (b[0] * b[0] + b[1] * b[1]) + (b[2] * b[2] + b[3] * b[3]);
                        ss += __shfl_xor(ss, 16); ss += __shfl_xor(ss, 32); mx = __builtin_fmaxf(mx, ss); }
                    mx = __builtin_fmaxf(mx, __shfl_xor(mx, 1)); mx = __builtin_fmaxf(mx, __shfl_xor(mx, 2)); mx = __builtin_fmaxf(mx, __shfl_xor(mx, 4)); mx = __builtin_fmaxf(mx, __shfl_xor(mx, 8));
                    if (fr == 0 && fq == 0) atomicMax(kmax + (size_t)(u.pm * 4 + ai * 2 + wr) * 8 + (colt >> 6) + 2 * bj + (wc >> 1), __float_as_uint(mx)); }
        }
#pragma unroll
        for (int ai = 0; ai < 2; ++ai)
#pragma unroll
            for (int m = 0; m < 4; ++m) { bf16_t* rowp = base + (size_t)(row0 + ai * HALF + m * 16) * ldc + col0;
#pragma unroll
                for (int bj = 0; bj < 2; ++bj) { f32x4 v0 = acc[ai][bj][m][0] * sc, v1 = acc[ai][bj][m][1] * sc;
                    u32x4 w; w.x = cvt_pk_bf16(v0[0], v0[1]); w.y = cvt_pk_bf16(v0[2], v0[3]); w.z = cvt_pk_bf16(v1[0], v1[1]); w.w = cvt_pk_bf16(v1[2], v1[3]);
                    *(u32x4*)(rowp + bj * HALF) = w; } }
    }
};
struct EpiResF32 {
    static constexpr bool PERM = false;
    const float* base; float* out; int ldc;
    __device__ __forceinline__ void operator()(const f32x4 (&acc)[2][2][4][2], const Unit& u, int wr, int wc, int fr, int fq) const {
        const int col0 = u.pn * BM + wc * 32 + 4 * fq;
#pragma unroll
        for (int ai = 0; ai < 2; ++ai)
#pragma unroll
            for (int m = 0; m < 4; ++m) { const size_t off = (size_t)(u.pm * BM + ai * HALF + wr * 64 + m * 16 + fr) * ldc + col0;
#pragma unroll
                for (int bj = 0; bj < 2; ++bj)
#pragma unroll
                    for (int n = 0; n < 2; ++n) { const f32x4 bs = *(const f32x4*)(base + off + bj * HALF + n * 16); *(f32x4*)(out + off + bj * HALF + n * 16) = bs + acc[ai][bj][m][n]; } }
    }
};
struct EpiSwiGLU {
    static constexpr bool PERM = true;
    bf16_t* O;
    __device__ __forceinline__ void operator()(const f32x4 (&acc)[2][2][4][2], const Unit& u, int wr, int wc, int fr, int fq) const {
        const int row0 = u.pm * BM + wr * 64 + fr, col0 = u.pn * HALF + wc * 32 + 8 * fq;
#pragma unroll
        for (int ai = 0; ai < 2; ++ai)
#pragma unroll
            for (int m = 0; m < 4; ++m) { float hv[8];
#pragma unroll
                for (int n = 0; n < 2; ++n)
#pragma unroll
                    for (int j = 0; j < 4; ++j) { const float g = acc[ai][0][m][n][j], up = acc[ai][1][m][n][j];
                        const float sg = __builtin_amdgcn_rcpf(1.0f + __builtin_amdgcn_exp2f(-1.4426950408889634f * g)); hv[n * 4 + j] = g * sg * up; }
                u32x4 w; w.x = cvt_pk_bf16(hv[0], hv[1]); w.y = cvt_pk_bf16(hv[2], hv[3]); w.z = cvt_pk_bf16(hv[4], hv[5]); w.w = cvt_pk_bf16(hv[6], hv[7]);
                *(u32x4*)(O + (size_t)(row0 + ai * HALF + m * 16) * 512 + col0) = w; }
    }
};
struct EpiGateBf16 {
    static constexpr bool PERM = true;
    bf16_t* O; const float* glist;
    __device__ __forceinline__ void operator()(const f32x4 (&acc)[2][2][4][2], const Unit& u, int wr, int wc, int fr, int fq) const {
        const int col0 = u.pn * BM + wc * 32 + 8 * fq;
#pragma unroll
        for (int ai = 0; ai < 2; ++ai)
#pragma unroll
            for (int m = 0; m < 4; ++m) { const int R = ai * HALF + wr * 64 + m * 16 + fr, pos = u.lt * BM + R; const float gt = (pos < u.cnt) ? glist[(size_t)u.e * 16384 + pos] : 0.f;
                bf16_t* rowp = O + (size_t)(u.pm * BM + R) * 1024 + col0;
#pragma unroll
                for (int bj = 0; bj < 2; ++bj) { f32x4 v0 = acc[ai][bj][m][0] * gt, v1 = acc[ai][bj][m][1] * gt;
                    u32x4 w; w.x = cvt_pk_bf16(v0[0], v0[1]); w.y = cvt_pk_bf16(v0[2], v0[3]); w.z = cvt_pk_bf16(v1[0], v1[1]); w.w = cvt_pk_bf16(v1[2], v1[3]);
                    *(u32x4*)(rowp + bj * HALF) = w; } }
    }
};

template <class Epi, class Sched, bool GATHER>
__device__ __forceinline__ void gemm_phase(PG8_LAS unsigned char* lds, const int K, const Sched& S, const Epi& E) {
    const int tid = threadIdx.x, wid = __builtin_amdgcn_readfirstlane(tid >> 6), lane = tid & 63, wr = wid >> 2, wc = wid & 3, fr = lane & 15, fq = lane >> 4;
    const int nt = K / BK;
    unsigned voffA[2], voffB[2]; int rowA[2];
#pragma unroll
    for (int i = 0; i < 2; ++i) { int R, C; stage_rc(tid * 16 + i * 8192, R, C); const int Rb = Epi::PERM ? ((R & ~31) + perm32(R & 31)) : R;
        rowA[i] = R; voffA[i] = GATHER ? (unsigned)C * 2u : (unsigned)(R * K + C) * 2u; voffB[i] = (unsigned)(Rb * K + C) * 2u; }
    const size_t kstep = (size_t)(BK * 2);
    const size_t hstep = (size_t)HALF * K * 2;
    const size_t hstepA = GATHER ? 0 : hstep;
    const unsigned ldsw = (unsigned)wid * 1024u;
    const int aoff = lds_byte(wr * 64 + fr, fq * 8), boff = lds_byte(wc * 32 + fr, fq * 8);
#define PG8_SA(b, h) (((b) * 2 + (h)) * HTB)
#define PG8_SB(b, h) ((4 + (b) * 2 + (h)) * HTB)
#define PG8_STAGE(bufoff, gbase, voff) do { _Pragma("unroll") for (int _i = 0; _i < 2; ++_i) \
        __builtin_amdgcn_global_load_lds((const unsigned*)((const char*)(gbase) + (voff)[_i]), (PG8_LAS unsigned*)(lds + (bufoff) + ldsw + _i * 8192), 16, 0, 0); } while (0)
#define PG8_STAGE_A(bufoff, gbase, h, VO) do { _Pragma("unroll") for (int _i = 0; _i < 2; ++_i) \
        __builtin_amdgcn_global_load_lds((const unsigned*)((const char*)(gbase) + (size_t)(h) * hstepA + (GATHER ? (VO)[2 * (h) + _i] : voffA[_i])), (PG8_LAS unsigned*)(lds + (bufoff) + ldsw + _i * 8192), 16, 0, 0); } while (0)
#define PG8_LDA(dst, b, h) do { _Pragma("unroll") for (int m = 0; m < 4; ++m) _Pragma("unroll") for (int k = 0; k < 2; ++k) dst[m][k] = *(const PG8_LAS bf16x8*)(lds + PG8_SA(b, h) + aoff + m * 2048 + k * 1024); } while (0)
#define PG8_LDB(dst, b, h) do { _Pragma("unroll") for (int n = 0; n < 2; ++n) _Pragma("unroll") for (int k = 0; k < 2; ++k) dst[n][k] = *(const PG8_LAS bf16x8*)(lds + PG8_SB(b, h) + boff + n * 2048 + k * 1024); } while (0)
#define PG8_MMA(ai, bj, At, Bt) do { __builtin_amdgcn_s_setprio(1); _Pragma("unroll") for (int m = 0; m < 4; ++m) _Pragma("unroll") for (int n = 0; n < 2; ++n) _Pragma("unroll") for (int k = 0; k < 2; ++k) \
        acc[ai][bj][m][n] = __builtin_amdgcn_mfma_f32_16x16x32_bf16(Bt[n][k], At[m][k], acc[ai][bj][m][n], 0, 0, 0); __builtin_amdgcn_s_setprio(0); } while (0)
#define PG8_WAIT_V(n) asm volatile("s_waitcnt vmcnt(" #n ")" ::: "memory")
#define PG8_WAIT_L(n) asm volatile("s_waitcnt lgkmcnt(" #n ")" ::: "memory")
#define PG8_BAR __builtin_amdgcn_s_barrier()
#define PG8_SCHED __builtin_amdgcn_sched_barrier(0)
    Unit cur, nxt; int ui = 0;
    if (!S.next(0, cur)) return;
    f32x4 acc[2][2][4][2];
#pragma unroll
    for (int a = 0; a < 2; ++a)
#pragma unroll
        for (int b = 0; b < 2; ++b)
#pragma unroll
            for (int m = 0; m < 4; ++m)
#pragma unroll
                for (int n = 0; n < 2; ++n) acc[a][b][m][n] = (f32x4){0.f, 0.f, 0.f, 0.f};
    bf16x8 At[4][2], B0[2][2], B1[2][2];
    const char* cA = S.a_base(cur); const char* cB = S.b_base(cur);
    unsigned vc[4] = {0u, 0u, 0u, 0u}, vn[4] = {0u, 0u, 0u, 0u};
    if constexpr (GATHER) {
#pragma unroll
        for (int h = 0; h < 2; ++h)
#pragma unroll
            for (int i = 0; i < 2; ++i) vc[2 * h + i] = S.row_off(cur, h * HALF + rowA[i]) + voffA[i];
    }
    PG8_STAGE(PG8_SB(0, 0), cB, voffB); PG8_STAGE(PG8_SB(0, 1), cB + hstep, voffB); PG8_STAGE_A(PG8_SA(0, 0), cA, 0, vc); PG8_STAGE_A(PG8_SA(0, 1), cA, 1, vc);
    if (wr == 1) PG8_BAR;
    PG8_WAIT_V(2); PG8_BAR;
    PG8_STAGE(PG8_SB(1, 0), cB + kstep, voffB); PG8_STAGE_A(PG8_SA(1, 0), cA + kstep, 0, vc); PG8_STAGE(PG8_SB(1, 1), cB + hstep + kstep, voffB);
    PG8_WAIT_V(6); PG8_BAR;
    for (;;) {
        const bool has_next = S.next(ui + 1, nxt);
        const char* nA = has_next ? S.a_base(nxt) : cA; const char* nB = has_next ? S.b_base(nxt) : cB;
        if constexpr (GATHER) {
#pragma unroll
            for (int h = 0; h < 2; ++h)
#pragma unroll
                for (int i = 0; i < 2; ++i) vn[2 * h + i] = has_next ? (S.row_off(nxt, h * HALF + rowA[i]) + voffA[i]) : vc[2 * h + i];
        }
        for (int t = 0; t < nt; t += 2) {
            const bool last = (t == nt - 2);
            const char* a1 = cA + (size_t)(t + 1) * kstep;
            const char* a2 = last ? nA : cA + (size_t)(t + 2) * kstep; const char* b2 = last ? nB : cB + (size_t)(t + 2) * kstep;
            const char* a3 = a2 + kstep; const char* b3 = b2 + kstep;
            unsigned v2[4];
#pragma unroll
            for (int q = 0; q < 4; ++q) v2[q] = last ? vn[q] : vc[q];
            PG8_LDB(B0, 0, 0); PG8_LDB(B1, 0, 1); PG8_SCHED; PG8_LDA(At, 0, 0); PG8_STAGE_A(PG8_SA(1, 1), a1, 1, vc);
            PG8_WAIT_V(8); PG8_WAIT_L(0); PG8_BAR; PG8_MMA(0, 0, At, B0); PG8_MMA(0, 1, At, B1); PG8_BAR; PG8_SCHED;
            PG8_LDA(At, 0, 1); PG8_STAGE(PG8_SB(0, 0), b2, voffB); PG8_STAGE(PG8_SB(0, 1), b2 + hstep, voffB); PG8_STAGE_A(PG8_SA(0, 0), a2, 0, v2);
            PG8_WAIT_V(8); PG8_WAIT_L(0); PG8_BAR; PG8_MMA(1, 0, At, B0); PG8_MMA(1, 1, At, B1); PG8_BAR; PG8_SCHED;
            PG8_LDB(B0, 1, 0); PG8_LDB(B1, 1, 1); PG8_SCHED; PG8_LDA(At, 1, 0); PG8_STAGE_A(PG8_SA(0, 1), a2, 1, v2);
            PG8_WAIT_V(8); PG8_WAIT_L(0); PG8_BAR; PG8_MMA(0, 0, At, B0); PG8_MMA(0, 1, At, B1); PG8_BAR; PG8_SCHED;
            PG8_LDA(At, 1, 1); PG8_STAGE(PG8_SB(1, 0), b3, voffB); PG8_STAGE(PG8_SB(1, 1), b3 + hstep, voffB); PG8_STAGE_A(PG8_SA(1, 0), a3, 0, v2);
            PG8_WAIT_V(8); PG8_WAIT_L(0); PG8_BAR; PG8_MMA(1, 0, At, B0); PG8_MMA(1, 1, At, B1); PG8_BAR; PG8_SCHED;
        }
        if (wr == 0) PG8_BAR;
        E(acc, cur, wr, wc, fr, fq);
        if (!has_next) break;
#pragma unroll
        for (int a = 0; a < 2; ++a)
#pragma unroll
            for (int b = 0; b < 2; ++b)
#pragma unroll
                for (int m = 0; m < 4; ++m)
#pragma unroll
                    for (int n = 0; n < 2; ++n) acc[a][b][m][n] = (f32x4){0.f, 0.f, 0.f, 0.f};
        cur = nxt; cA = nA; cB = nB; ++ui;
#pragma unroll
        for (int q = 0; q < 4; ++q) vc[q] = vn[q];
        if (wr == 1) PG8_BAR;
    }
    PG8_WAIT_V(0);
    PG8_BAR;
#undef PG8_SA
#undef PG8_SB
#undef PG8_STAGE
#undef PG8_STAGE_A
#undef PG8_LDA
#undef PG8_LDB
#undef PG8_MMA
#undef PG8_WAIT_V
#undef PG8_WAIT_L
#undef PG8_BAR
#undef PG8_SCHED
}
}
namespace attn {
using bf16x8 = __attribute__((ext_vector_type(8))) short;
using s16x4 = __attribute__((ext_vector_type(4))) short;
using f32x16 = __attribute__((ext_vector_type(16))) float;
using u32x4 = __attribute__((ext_vector_type(4))) unsigned;
typedef unsigned short bf16_t;
constexpr int SEQ = 8192, NW = 8, QBLK = 32, QB = QBLK * NW, KVBLK = 64, NTILE = SEQ / KVBLK, PITCH = 512;
constexpr int KSLOT = 8192, VSLOT = 16384;
constexpr int LDS_K = 0, LDS_V = 3 * KSLOT, LDS_WS = LDS_V + 3 * VSLOT, LDS_OST = LDS_WS + NW * 256, LDS_BYTES = LDS_OST + NW * 8192;
#define SBAR() __builtin_amdgcn_sched_barrier(0)
#define PIN(x) asm volatile("" : "+v"(x))
#define MFMA32(a, b, c) __builtin_amdgcn_mfma_f32_32x32x16_bf16(a, b, c, 0, 0, 0)
#define WAIT_BAR(N) asm volatile("s_waitcnt vmcnt(" #N ") lgkmcnt(0)\n\ts_barrier" ::: "memory")
__device__ __forceinline__ constexpr int crow0(int r) { return (r & 3) + 8 * (r >> 2); }
__device__ __forceinline__ void glds16(const void* g, unsigned lds_base) {
    unsigned sv; asm volatile("s_mov_b32 %0, m0\n\ts_mov_b32 m0, %2\n\ts_nop 0\n\tglobal_load_lds_dwordx4 %1, off\n\ts_mov_b32 m0, %0" : "=&s"(sv) : "v"(g), "s"(lds_base) : "memory"); }
typedef float f32x2_t __attribute__((ext_vector_type(2))); typedef __bf16 bf16x2_t __attribute__((ext_vector_type(2)));
__device__ __forceinline__ unsigned cvtpk(float lo, float hi) { f32x2_t v = {lo, hi}; bf16x2_t b = __builtin_convertvector(v, bf16x2_t); return __builtin_bit_cast(unsigned, b); }
typedef __attribute__((address_space(3))) const char* lds_cptr;
typedef short v4i16_t __attribute__((ext_vector_type(4)));
__device__ __forceinline__ bf16x8 kld(lds_cptr p) { return *(const __attribute__((address_space(3))) bf16x8*)p; }
__device__ __forceinline__ s16x4 vtr(lds_cptr p) { return __builtin_bit_cast(s16x4, __builtin_amdgcn_ds_read_tr16_b64_v4i16((__attribute__((address_space(3))) v4i16_t*)p)); }
#define MX3(a, b, c) __builtin_fmaxf(__builtin_fmaxf((a), (b)), (c))
__device__ __forceinline__ float rowmax(const f32x16& p0, const f32x16& p1) {
    float a = MX3(p0[0], p0[1], p1[0]), b = MX3(p0[2], p0[3], p1[1]); a = MX3(a, p1[2], p1[3]);
#pragma unroll
    for (int r = 4; r < 16; r += 4) { a = MX3(a, p0[r], p0[r + 1]); b = MX3(b, p0[r + 2], p0[r + 3]); a = MX3(a, p1[r], p1[r + 1]); b = MX3(b, p1[r + 2], p1[r + 3]); }
    float m = __builtin_fmaxf(a, b); auto rr = __builtin_amdgcn_permlane32_swap(__float_as_uint(m), __float_as_uint(m), false, false);
    return __builtin_fmaxf(__uint_as_float(rr[0]), __uint_as_float(rr[1])); }
__device__ __forceinline__ float bf2f(short s) { return __uint_as_float(((unsigned)(unsigned short)s) << 16); }
__device__ __forceinline__ void build_c(f32x16& C, int side, float dj, float sg2, float mhat) {
    if (side == 0) {
#pragma unroll
        for (int r = 0; r < 16; ++r) C[r] = __builtin_fmaf(-sg2, __builtin_fabsf(dj + (float)crow0(r)), -mhat);
    } else {
        const float ss = (side > 0) ? -sg2 : sg2, cl = __builtin_fmaf(ss, dj, -mhat);
#pragma unroll
        for (int r = 0; r < 16; ++r) C[r] = __builtin_fmaf(ss, (float)crow0(r), cl);
    }
}

constexpr float SKIP_T = 150.0f;
template <int THRL>
__device__ __forceinline__ void attn_unit(int b, int h, int c, int qb, float sg2, const bf16_t* Q, const bf16_t* __restrict__ K, const bf16_t* __restrict__ V, bf16_t* AO, const unsigned* kb2, char* lds) {
    const int tid = threadIdx.x, lane = tid & 63, r32 = lane & 31, hi = lane >> 5; const int wid = __builtin_amdgcn_readfirstlane(tid >> 6);
    const long rowbase = (long)b * SEQ; const int q0 = qb * QB, iw0 = q0 + wid * QBLK;
    const bf16_t* Qw = Q + (rowbase + iw0) * PITCH + h * 128 + c * 64;
    const bf16_t* Kh = K + rowbase * PITCH + h * 128 + c * 64; const bf16_t* Vh = V + rowbase * PITCH + h * 128;
    const unsigned lds0 = (unsigned)(uintptr_t)lds; float* wsf = (float*)(lds + LDS_WS) + wid * 64;
    bf16x8 qr[4];
#pragma unroll
    for (int d0 = 0; d0 < 4; ++d0) qr[d0] = *reinterpret_cast<const bf16x8*>(&Qw[(long)r32 * PITCH + d0 * 16 + hi * 8]);
    float mhat; int tlo, thi;
    { const bf16_t* Kd = Kh + (long)(iw0 + r32) * PITCH; float s = 0.f, na = 0.f, nb = 0.f;
#pragma unroll
      for (int d0 = 0; d0 < 4; ++d0) { const bf16x8 kk = *reinterpret_cast<const bf16x8*>(&Kd[d0 * 16 + hi * 8]);
#pragma unroll
          for (int j = 0; j < 8; ++j) { const float qv = bf2f(qr[d0][j]); s = __builtin_fmaf(qv, bf2f(kk[j]), s); if (d0 < 2) na = __builtin_fmaf(qv, qv, na); else nb = __builtin_fmaf(qv, qv, nb); } }
      auto rr = __builtin_amdgcn_permlane32_swap(__float_as_uint(s), __float_as_uint(s), false, false); mhat = __uint_as_float(rr[0]) + __uint_as_float(rr[1]);
      auto ra = __builtin_amdgcn_permlane32_swap(__float_as_uint(na), __float_as_uint(na), false, false); na = __uint_as_float(ra[0]) + __uint_as_float(ra[1]);
      auto rb = __builtin_amdgcn_permlane32_swap(__float_as_uint(nb), __float_as_uint(nb), false, false); nb = __uint_as_float(rb[0]) + __uint_as_float(rb[1]);
      float qn = (sqrtf(na) + sqrtf(nb)) * 1.001f, sm = mhat;
#pragma unroll
      for (int o_ = 1; o_ < 32; o_ <<= 1) { qn = __builtin_fmaxf(qn, __shfl_xor(qn, o_)); sm = __builtin_fminf(sm, __shfl_xor(sm, o_)); }
      if (lane == 0) { wsf[48] = qn; wsf[49] = sm; }
      asm volatile("s_waitcnt lgkmcnt(0)\n\ts_barrier" ::: "memory");
      { const float* wsa = (const float*)(lds + LDS_WS);
#pragma unroll
        for (int w = 0; w < NW; ++w) { qn = __builtin_fmaxf(qn, wsa[w * 64 + 48]); sm = __builtin_fminf(sm, wsa[w * 64 + 49]); } }
      int lo_ = NTILE, hi_ = -1;
#pragma unroll
      for (int half = 0; half < 2; ++half) { const int J = lane + 64 * half; const float km = sqrtf(__uint_as_float(kb2[J * 8 + h * 2 + c])) * 1.01f;
          const int dl_ = q0 - (J * KVBLK + KVBLK - 1), dr_ = J * KVBLK - (q0 + QB - 1); const float dmin = (float)(dl_ > 0 ? dl_ : (dr_ > 0 ? dr_ : 0));
          const bool need = (qn * km - sg2 * dmin - sm >= -SKIP_T) || (dl_ <= 0 && dr_ <= 0);
          if (need) { lo_ = lo_ < J ? lo_ : J; hi_ = hi_ > J ? hi_ : J; } }
#pragma unroll
      for (int o_ = 1; o_ < 64; o_ <<= 1) { const int l2 = __shfl_xor(lo_, o_), h2 = __shfl_xor(hi_, o_); lo_ = lo_ < l2 ? lo_ : l2; hi_ = hi_ > h2 ? hi_ : h2; }
      tlo = __builtin_amdgcn_readfirstlane(lo_); thi = __builtin_amdgcn_readfirstlane(hi_); }
    const int n = thi - tlo + 1;
    const bf16_t* ksrc = Kh + (long)tlo * KVBLK * PITCH + (long)lane * PITCH + wid * 8;
    const bf16_t* vsrc = Vh + (long)tlo * KVBLK * PITCH + (long)(32 * (wid & 1) + (lane >> 2)) * PITCH + (wid >> 1) * 32 + (lane & 3) * 8;
    const unsigned kdst = lds0 + LDS_K + wid * 1024, vdst = lds0 + LDS_V + wid * 2048;
#define DMA_K(s, slot) glds16(ksrc + (long)(s) * KVBLK * PITCH, (unsigned)__builtin_amdgcn_readfirstlane(kdst + (slot) * KSLOT))
#define DMA_V(s, slot) do { glds16(vsrc + (long)(s) * KVBLK * PITCH, (unsigned)__builtin_amdgcn_readfirstlane(vdst + (slot) * VSLOT)); \
                            glds16(vsrc + (long)(s) * KVBLK * PITCH + 16 * PITCH, (unsigned)__builtin_amdgcn_readfirstlane(vdst + (slot) * VSLOT + 1024)); } while (0)
    const lds_cptr vp0 = (lds_cptr)lds + LDS_V + ((lane >> 4) & 1) * 32 + (lane & 3) * 8 + (4 * hi + ((lane & 15) >> 2)) * 64;
    const lds_cptr kp0 = (lds_cptr)lds + LDS_K + hi * 1024 + r32 * 16;
    DMA_K(0, 0); DMA_V(0, 0); DMA_K(1, 1); DMA_K(2, 2);
    float l_reg = 0.f; f32x16 o[4]; o[0] = f32x16{}; o[1] = f32x16{}; o[2] = f32x16{}; o[3] = f32x16{};
    const float fi = (float)(4 * hi - (iw0 + r32));
    bool resc = false;
    f32x16 C0, C1; bf16x8 kf[8]; u32x4 pw0, pw1, pw2, pw3;
    pw0 = u32x4{}; pw1 = u32x4{}; pw2 = u32x4{}; pw3 = u32x4{};
    int s_prev = 0, s_cur = 0, s_next = 1;
#define ROT() do { s_prev = s_cur; s_cur = s_next; s_next = (s_next == 2) ? 0 : s_next + 1; } while (0)
#define EX(v) __builtin_amdgcn_exp2f(v)
#define RESC() do { if (resc) { asm volatile("s_waitcnt lgkmcnt(0)" ::: "memory"); _Pragma("unroll") for (int d_ = 0; d_ < 4; ++d_) _Pragma("unroll") for (int r = 0; r < 16; ++r) o[d_][r] *= wsf[crow0(r) + 4 * hi]; } } while (0)
    asm volatile("s_waitcnt vmcnt(0) lgkmcnt(0)\n\ts_barrier" ::: "memory");
#pragma unroll
    for (int f = 0; f < 8; ++f) kf[f] = kld(kp0 + (f >> 1) * 2048 + (f & 1) * 512);
    asm volatile("s_waitcnt lgkmcnt(0)\n\ts_barrier" ::: "memory");
#define PKW(P, i) cvtpk(P[i], P[i + 1])
#define PAF(k) __builtin_bit_cast(bf16x8, pw##k)
#define VFRG(lo, hi_) (bf16x8){lo[0], lo[1], lo[2], lo[3], hi_[0], hi_[1], hi_[2], hi_[3]}
#define VRD(f) do { vlo[f] = vtr(vp_ + (((f) & 3) * 4096 + ((f) >> 2) * 1024)); vhi[f] = vtr(vp_ + (((f) & 3) * 4096 + ((f) >> 2) * 1024 + 512)); } while (0)
#define STEP(s, FIRST, GK, GV, GL) do { SBAR(); \
    const int jt_ = (tlo + (s)) * KVBLK; const lds_cptr vp_ = vp0 + s_prev * VSLOT; s16x4 vlo[16], vhi[16]; \
    { const int d0_ = jt_ - iw0, d1_ = jt_ + 32 - iw0; \
      build_c(C0, (d0_ > 0) - (d0_ < 0), (float)jt_ + fi, sg2, mhat); build_c(C1, (d1_ > 0) - (d1_ < 0), (float)(jt_ + 32) + fi, sg2, mhat); } \
    if (!(FIRST)) { VRD(0); VRD(1); } SBAR(); \
    C0 = MFMA32(kf[0], qr[0], C0); C1 = MFMA32(kf[1], qr[0], C1); SBAR(); \
    if (!(FIRST)) { VRD(2); VRD(3); } SBAR(); \
    C0 = MFMA32(kf[2], qr[1], C0); C1 = MFMA32(kf[3], qr[1], C1); SBAR(); \
    C0 = MFMA32(kf[4], qr[2], C0); C1 = MFMA32(kf[5], qr[2], C1); SBAR(); \
    C0 = MFMA32(kf[6], qr[3], C0); C1 = MFMA32(kf[7], qr[3], C1); SBAR(); \
    if (GK) DMA_K((s) + 3, s_cur); if (GV) DMA_V((s) + 1, s_next); \
    { const float rm = rowmax(C0, C1); resc = false; \
      if (__builtin_expect(__any(rm > (float)THRL), 0)) { const float dl = __builtin_fmaxf(rm, 0.f); mhat += dl; \
          _Pragma("unroll") for (int r = 0; r < 16; ++r) { C0[r] -= dl; C1[r] -= dl; } \
          const float f = EX(-dl); l_reg *= f; if (hi == 0) wsf[r32] = f; resc = true; } } \
    SBAR(); \
    float sacc = 0.f; u32x4 nw0, nw1, nw2, nw3; \
    _Pragma("unroll") for (int g = 0; g < 16; ++g) { \
        if (!(FIRST)) { const int ks_ = g >> 2, db_ = g & 3; \
            if (g + 4 < 16) { VRD(g + 4); } \
            const bf16x8 pa_ = (ks_ == 0) ? PAF(0) : (ks_ == 1) ? PAF(1) : (ks_ == 2) ? PAF(2) : PAF(3); \
            o[db_] = MFMA32(pa_, VFRG(vlo[g], vhi[g]), o[db_]); } \
        if (GL) { if (g >= 4 && g < 12) { kf[g - 4] = kld(kp0 + s_next * KSLOT + ((g - 4) >> 1) * 2048 + ((g - 4) & 1) * 512); } } \
        if (g < 8) { C0[2 * g] = EX(C0[2 * g]); C0[2 * g + 1] = EX(C0[2 * g + 1]); sacc += C0[2 * g]; sacc += C0[2 * g + 1]; } \
        else { C1[2 * g - 16] = EX(C1[2 * g - 16]); C1[2 * g - 15] = EX(C1[2 * g - 15]); sacc += C1[2 * g - 16]; sacc += C1[2 * g - 15]; } \
        if (g == 0) nw0[0] = PKW(C0, 0); if (g == 1) nw0[1] = PKW(C0, 2); if (g == 2) nw0[2] = PKW(C0, 4); if (g == 3) nw0[3] = PKW(C0, 6); \
        if (g == 4) nw1[0] = PKW(C0, 8); if (g == 5) nw1[1] = PKW(C0, 10); if (g == 6) nw1[2] = PKW(C0, 12); if (g == 7) nw1[3] = PKW(C0, 14); \
        if (g == 8) nw2[0] = PKW(C1, 0); if (g == 9) nw2[1] = PKW(C1, 2); if (g == 10) nw2[2] = PKW(C1, 4); if (g == 11) nw2[3] = PKW(C1, 6); \
        if (g == 12) nw3[0] = PKW(C1, 8); if (g == 13) nw3[1] = PKW(C1, 10); if (g == 14) nw3[2] = PKW(C1, 12); if (g == 15) nw3[3] = PKW(C1, 14); \
        PIN(sacc); SBAR(); } \
    l_reg += sacc; pw0 = nw0; pw1 = nw1; pw2 = nw2; pw3 = nw3; \
    } while (0)
    STEP(0, true, true, true, true); WAIT_BAR(3); RESC(); ROT();
    int s = 1;
    for (; s + 3 < n; ++s) { STEP(s, false, true, true, true); WAIT_BAR(3); RESC(); ROT(); }
    STEP(s, false, false, true, true); WAIT_BAR(2); RESC(); ROT(); ++s;
    STEP(s, false, false, true, true); WAIT_BAR(2); RESC(); ROT(); ++s;
    STEP(s, false, false, false, false); WAIT_BAR(0); RESC(); ROT();
    { const lds_cptr vp_ = vp0 + s_prev * VSLOT; s16x4 vlo[16], vhi[16];
#pragma unroll
      for (int g = 0; g < 16; ++g) VRD(g);
#pragma unroll
      for (int g = 0; g < 16; ++g) { const int ks_ = g >> 2, db_ = g & 3; const bf16x8 pa_ = (ks_ == 0) ? PAF(0) : (ks_ == 1) ? PAF(1) : (ks_ == 2) ? PAF(2) : PAF(3);
          o[db_] = MFMA32(pa_, VFRG(vlo[g], vhi[g]), o[db_]); } }
    { auto rr = __builtin_amdgcn_permlane32_swap(__float_as_uint(l_reg), __float_as_uint(l_reg), false, false); l_reg = __uint_as_float(rr[0]) + __uint_as_float(rr[1]); }
    if (hi == 0) wsf[32 + r32] = l_reg; asm volatile("s_waitcnt lgkmcnt(0)" ::: "memory");
    float rli[16];
#pragma unroll
    for (int r = 0; r < 16; ++r) rli[r] = __builtin_amdgcn_rcpf(wsf[32 + crow0(r) + 4 * hi]);
    bf16_t* Ow = AO + (rowbase + iw0) * PITCH + h * 128; __hip_bfloat16* stg = (__hip_bfloat16*)(lds + LDS_OST) + wid * 4096;
#pragma unroll
    for (int r = 0; r < 16; ++r) { const int orow = crow0(r) + 4 * hi;
#pragma unroll
        for (int db = 0; db < 4; ++db) stg[orow * 128 + db * 32 + r32] = __float2bfloat16(o[db][r] * rli[r]); }
    asm volatile("s_waitcnt lgkmcnt(0)" ::: "memory");
#pragma unroll
    for (int i = 0; i < 8; ++i) { const int row = i * 4 + (lane >> 4), ch = lane & 15; *(u32x4*)(Ow + (long)row * PITCH + ch * 8) = *(const u32x4*)(stg + row * 128 + ch * 8); }
    asm volatile("s_waitcnt lgkmcnt(0)\n\ts_barrier" ::: "memory");
#undef DMA_K
#undef DMA_V
#undef ROT
#undef EX
#undef RESC
#undef PKW
#undef PAF
#undef VFRG
#undef VRD
#undef STEP
}
#undef SBAR
#undef PIN
#undef MFMA32
#undef WAIT_BAR
#undef MX3
}
constexpr int NWAVES = 8;
constexpr int BATCH = 2, SEQ = 8192, DM = 1024, T = BATCH * SEQ, NEXP = 32, DEXP = 512;
constexpr float EPS = 1e-6f, LAM_INIT = 0.2f;
constexpr float C2 = 0.125f * 1.4426950408889634f;
constexpr float LOG2E = 1.4426950408889634f;
constexpr int ATT_THR = 8;

constexpr size_t MiB = 1u << 20;
constexpr size_t WS_CTL = 0, CTL_ZERO_BYTES = 65536;
constexpr size_t WS_LIST = 1 * MiB, WS_GLIST = 3 * MiB, WS_EPOS = 5 * MiB;
constexpr size_t WS_WIN = 6 * MiB, WS_WOUT = 10 * MiB, WS_WGU = 12 * MiB, WS_WD = 76 * MiB;
constexpr size_t WS_QKVU = 108 * MiB;
constexpr size_t WS_XN2 = 108 * MiB;
constexpr size_t WS_Y = 108 * MiB;
constexpr size_t WS_XN1 = 172 * MiB;
constexpr size_t WS_MIX = 172 * MiB;
constexpr size_t WS_AO = 204 * MiB;
constexpr size_t WS_HDN = 204 * MiB;
constexpr size_t WS_END = 244 * MiB;
constexpr int MAXROWS = 40960;
constexpr int CW_CNT = 64;
constexpr int CW_BAR = 4096;
constexpr int CW_QUEUE = 3968;
constexpr int CW_KMAX = 8192;
constexpr int LDS_BYTES = 163840;
constexpr int MISC_OFF = LDS_BYTES - 256;
constexpr int MOE_TAB_OFF = 131072;
constexpr int RT_WR = 0, RT_SC = 148032, RT_SQ = 160320, RT_SR = 160576, RT_HI = 160832;

#define GAS __attribute__((address_space(1)))
#define LAS __attribute__((address_space(3)))
typedef unsigned short bf16;
typedef unsigned v4u __attribute__((ext_vector_type(4)));
typedef unsigned v2u __attribute__((ext_vector_type(2)));
typedef float f32x4 __attribute__((ext_vector_type(4)));
typedef GAS unsigned gu32;
#define RLX_AGENT __ATOMIC_RELAXED, __HIP_MEMORY_SCOPE_AGENT
#define LDS_WAIT() asm volatile("s_waitcnt lgkmcnt(0)" ::: "memory")
#define VM_WAIT() asm volatile("s_waitcnt vmcnt(0)" ::: "memory")
__device__ __forceinline__ unsigned f2bf(float f) { unsigned u = __builtin_bit_cast(unsigned, f); return (u + 0x7fffu + ((u >> 16) & 1u)) >> 16; }
__device__ __forceinline__ unsigned pk2(float lo, float hi) { return f2bf(lo) | (f2bf(hi) << 16); }
__device__ __forceinline__ float bflo(unsigned w) { return __uint_as_float(w << 16); }
__device__ __forceinline__ float bfhi(unsigned w) { return __uint_as_float(w & 0xffff0000u); }

#define XB_TMO      128
#define XB_XCNT(j)  (256  + 64 * (j))
#define XB_XSUB(j)  (1280 + 64 * (j))
#define XB_XGEN(j)  (2304 + 64 * (j))
#define XB_TOP      3328
#define XB_TOPGEN   3392
#define XCD_BAR_WORDS 3456
#define XB_SPIN_CAP (1u << 18)
__device__ __forceinline__ unsigned xb_ld(unsigned* p)              { return __hip_atomic_load(p, __ATOMIC_RELAXED, __HIP_MEMORY_SCOPE_AGENT); }
__device__ __forceinline__ unsigned xb_add(unsigned* p, unsigned v) { return __hip_atomic_fetch_add(p, v, __ATOMIC_RELAXED, __HIP_MEMORY_SCOPE_AGENT); }
__device__ __forceinline__ unsigned xb_xcc_id() { return (unsigned)__builtin_amdgcn_s_getreg((3 << 11) | 20) & 0xFu; }
#define XB_SPIN(cond, bar) do { unsigned _sp = 0; while (cond) { __builtin_amdgcn_s_sleep(1); \
    if ((++_sp & 255u) == 0u) { if (xb_ld(&(bar)[XB_TMO])) break; if (_sp > XB_SPIN_CAP) { atomicAdd(&(bar)[XB_TMO], 1u); break; } } } } while (0)
struct XcdBarrier { unsigned* bar; unsigned x; volatile LAS unsigned* st; };
__device__ __forceinline__ XcdBarrier xcd_barrier_post(unsigned* bar, volatile LAS unsigned* st) {
    XcdBarrier b; b.bar = bar; b.x = xb_xcc_id(); b.st = st;
    if (threadIdx.x == 0) (void)xb_add(&bar[XB_XCNT(b.x)], 1u);
    return b;
}
__device__ __forceinline__ void xcd_barrier_complete(unsigned* bar, unsigned x, unsigned& nloc, unsigned& nx) {
    const unsigned G = gridDim.x * gridDim.y * gridDim.z;
    unsigned sum, cnt, mine, sp = 0u;
    for (;;) {
        sum = 0u; cnt = 0u; mine = 0u;
#pragma unroll
        for (unsigned j = 0; j < 16; ++j) { const unsigned c = xb_ld(&bar[XB_XCNT(j)]); sum += c; cnt += (c > 0u) ? 1u : 0u; mine = (j == x) ? c : mine; }
        if (sum == G) break;
        __builtin_amdgcn_s_sleep(1);
        if ((++sp & 255u) == 0u) { if (xb_ld(&bar[XB_TMO])) break; if (sp > XB_SPIN_CAP) { atomicAdd(&bar[XB_TMO], 1u); break; } }
    }
    nloc = mine > 0u ? mine : 1u; nx = cnt > 0u ? cnt : 1u;
}
__device__ __forceinline__ void xcd_barrier(const XcdBarrier& b) {
    asm volatile("s_waitcnt vmcnt(0)" ::: "memory");
    __syncthreads();
    if (threadIdx.x == 0) {
        unsigned* bar = b.bar;
        __builtin_amdgcn_s_waitcnt(0);
        unsigned nloc = b.st[0], nx = b.st[1];
        if (nloc == 0u) { xcd_barrier_complete(bar, b.x, nloc, nx); b.st[0] = nloc; b.st[1] = nx; }
        const unsigned old = xb_add(&bar[XB_XSUB(b.x)], 1u);
        const unsigned gen = old / nloc;
        if (old + 1u == (gen + 1u) * nloc) {
            __builtin_amdgcn_fence(__ATOMIC_RELEASE, "agent");
            asm volatile("s_waitcnt vmcnt(0)" ::: "memory");
            const unsigned og = xb_add(&bar[XB_TOP], 1u);
            const unsigned tg = og / nx;
            if (og + 1u == (tg + 1u) * nx) xb_add(&bar[XB_TOPGEN], 1u);
            else XB_SPIN(xb_ld(&bar[XB_TOPGEN]) == tg, bar);
            __builtin_amdgcn_fence(__ATOMIC_ACQUIRE, "agent");
            xb_add(&bar[XB_XGEN(b.x)], 1u);
            asm volatile("s_waitcnt vmcnt(0)" ::: "memory");
        } else {
            XB_SPIN(xb_ld(&bar[XB_XGEN(b.x)]) == gen, bar);
            __builtin_amdgcn_fence(__ATOMIC_ACQUIRE, "agent");
            asm volatile("s_waitcnt vmcnt(0)" ::: "memory");
        }
    }
    __syncthreads();
}

__device__ __forceinline__ float wave_sum(float v) {
#pragma unroll
    for (int o = 1; o < 64; o <<= 1) v += __shfl_xor(v, o);
    return v;
}
struct TrItem { const float* src; int ldw; bf16* dst; size_t opitch; };
__device__ __forceinline__ void tr_load(const TrItem& I, float (&v)[32], int lane) {
#pragma unroll
    for (int i = 0; i < 32; ++i) v[i] = I.src[(size_t)(2 * i + (lane >> 5)) * I.ldw + (lane & 31)];
}
__device__ __forceinline__ void tr_finish(const TrItem& I, const float (&v)[32], LAS float* scr, int lane) {
#pragma unroll
    for (int i = 0; i < 32; ++i) scr[(2 * i + (lane >> 5)) * 33 + (lane & 31)] = v[i];
    LDS_WAIT(); asm volatile("" ::: "memory");
    const int c = lane & 7;
#pragma unroll
    for (int j = 0; j < 4; ++j) { const int n = (lane >> 3) + 8 * j; const LAS float* sp = scr + (8 * c) * 33 + n;
        v4u o; o.x = pk2(sp[0 * 33], sp[1 * 33]); o.y = pk2(sp[2 * 33], sp[3 * 33]); o.z = pk2(sp[4 * 33], sp[5 * 33]); o.w = pk2(sp[6 * 33], sp[7 * 33]);
        *(GAS v4u*)(I.dst + (size_t)n * I.opitch + 8 * c) = o; }
    LDS_WAIT(); asm volatile("" ::: "memory");
}
template <int NR> __device__ __forceinline__ void rms_rows_to_bf16(const float* x, const float* g, bf16* o, int m0, int stride, int mend, int lane) {
    f32x4 v[NR][4];
#pragma unroll
    for (int k = 0; k < NR; ++k) { const int m = m0 + k * stride; const GAS f32x4* xr = (const GAS f32x4*)(x + (size_t)(m < mend ? m : m0) * DM) + lane;
#pragma unroll
        for (int j = 0; j < 4; ++j) v[k][j] = xr[64 * j]; }
    const GAS f32x4* gr = (const GAS f32x4*)g + lane; f32x4 gg[4];
#pragma unroll
    for (int j = 0; j < 4; ++j) gg[j] = gr[64 * j];
#pragma unroll
    for (int k = 0; k < NR; ++k) { const int m = m0 + k * stride; float s = 0.f;
#pragma unroll
        for (int j = 0; j < 4; ++j) s += (v[k][j].x * v[k][j].x + v[k][j].y * v[k][j].y) + (v[k][j].z * v[k][j].z + v[k][j].w * v[k][j].w);
        const float rstd = 1.0f / sqrtf(wave_sum(s) * (1.f / DM) + EPS);
        if (m < mend) { GAS v2u* o8 = (GAS v2u*)(o + (size_t)m * DM) + lane;
#pragma unroll
            for (int j = 0; j < 4; ++j) { v2u w; w.x = pk2(v[k][j].x * rstd * gg[j].x, v[k][j].y * rstd * gg[j].y); w.y = pk2(v[k][j].z * rstd * gg[j].z, v[k][j].w * rstd * gg[j].w); o8[64 * j] = w; } } }
}

__device__ __forceinline__ TrItem expert_item(int it, const float* wgate, const float* wup, const float* wdown, bf16* Wgu_t, bf16* Wd_t) {
    constexpr int I_G = 16 * 16, I_D = 8 * 32; TrItem I;
    const int e = it / (2 * I_G + I_D); int r = it - e * (2 * I_G + I_D);
    if (r < 2 * I_G) { const int up = r / I_G; r -= up * I_G; const int kb = r / 16, nb = r % 16, n0 = 32 * nb;
        I.src = (up ? wup : wgate) + (size_t)e * 1024 * 512 + (size_t)(64 * kb) * 512 + n0; I.ldw = 512;
        I.dst = Wgu_t + (size_t)e * 1024 * 1024 + (size_t)((n0 >> 7) * 256 + 128 * up + (n0 & 127)) * 1024 + 64 * kb; I.opitch = 1024; return I; }
    r -= 2 * I_G;
    const int kb = r / 32, nb = r % 32; I.src = wdown + (size_t)e * 512 * 1024 + (size_t)(64 * kb) * 1024 + 32 * nb; I.ldw = 1024; I.dst = Wd_t + (size_t)e * 1024 * 512 + (size_t)(32 * nb) * 512 + 64 * kb; I.opitch = 512; return I;
}
constexpr int N_EXPERT_ITEMS = 32 * 768, Q_BATCH = 64, N_Q_BATCHES = N_EXPERT_ITEMS / Q_BATCH;

struct Args { const float* in[20]; float* out; unsigned char* ws; int ph_lo, ph_hi; };

__global__ void __launch_bounds__(NWAVES * 64, 2) mk_fwd(Args args) {
    extern __shared__ __attribute__((aligned(16))) unsigned char lds[];
    LAS unsigned char* L = (LAS unsigned char*)lds;
    volatile LAS unsigned* MISC = (volatile LAS unsigned*)(L + MISC_OFF);
    const int tid = threadIdx.x, lane = tid & 63, wave = __builtin_amdgcn_readfirstlane(tid >> 6);
    const int G = gridDim.x; const int bx = blockIdx.x; const int vcu = (G % 8 == 0) ? (bx % 8) * (G / 8) + bx / 8 : bx;
    unsigned char* ws = args.ws;
    gu32* ctl = (gu32*)(ws + WS_CTL);
    const float* x = args.in[0]; const float* n1g = args.in[1]; const float* w_in = args.in[2];
    const float* lq1 = args.in[3]; const float* lk1 = args.in[4]; const float* lq2 = args.in[5]; const float* lk2 = args.in[6];
    const float* subg = args.in[7]; const float* wpool = args.in[8]; const float* pscale = args.in[9]; const float* w_out = args.in[10];
    const float* n2g = args.in[11]; const float* wgr = args.in[12]; const float* bgr = args.in[13]; const float* wer = args.in[14];
    const float* ber = args.in[15]; const float* wgate = args.in[16]; const float* wup = args.in[17]; const float* wdown = args.in[18]; const float* fing = args.in[19];
    float* out = args.out;
    bf16* Win_t = (bf16*)(ws + WS_WIN); bf16* Wout_t = (bf16*)(ws + WS_WOUT); bf16* Wgu_t = (bf16*)(ws + WS_WGU); bf16* Wd_t = (bf16*)(ws + WS_WD);
    bf16* QKVU = (bf16*)(ws + WS_QKVU); bf16* XN1 = (bf16*)(ws + WS_XN1); bf16* MIX = (bf16*)(ws + WS_MIX); bf16* AO = (bf16*)(ws + WS_AO);
    bf16* XN2 = (bf16*)(ws + WS_XN2); bf16* HDN = (bf16*)(ws + WS_HDN); bf16* Y = (bf16*)(ws + WS_Y);
    int* list = (int*)(ws + WS_LIST); float* glist = (float*)(ws + WS_GLIST); int* epos = (int*)(ws + WS_EPOS);
    for (int u = tid; u < 64; u += NWAVES * 64) ((LAS unsigned*)(L + MISC_OFF))[u] = 0u;
    __syncthreads();
    XcdBarrier bar = xcd_barrier_post((unsigned*)(ctl + CW_BAR), MISC + 8);
    const int lo = args.ph_lo, hi = args.ph_hi;
#define IN(k) (lo <= (k) && (k) < hi)
#define SEAM(k) do { if (IN(k) && IN((k) + 1)) xcd_barrier(bar); } while (0)
    const int gw = vcu * NWAVES + wave, NGW = G * NWAVES;

    if (IN(0)) {
        LAS float* scr = (LAS float*)(L + wave * 16384);
        constexpr int I_WIN = 16 * 64, I_WO = 8 * 32;
        constexpr int NITEMS = I_WIN + I_WO;
        auto decode = [&](int it) -> TrItem { TrItem I; int r = it;
            if (r < I_WIN) { const int kb = r / 64, nb = r % 64; I.src = w_in + (size_t)(64 * kb) * 2048 + 32 * nb; I.ldw = 2048; I.dst = Win_t + (size_t)(32 * nb) * 1024 + 64 * kb; I.opitch = 1024; return I; } r -= I_WIN;
            { const int kb = r / 32, nb = r % 32; I.src = w_out + (size_t)(64 * kb) * 1024 + 32 * nb; I.ldw = 1024; I.dst = Wout_t + (size_t)(32 * nb) * 1024 + 64 * kb; I.opitch = 1024; return I; } };
        { float va[32], vb[32]; int it = gw; TrItem Ia, Ib;
          if (it < NITEMS) { Ia = decode(it); tr_load(Ia, va, lane); }
          while (it < NITEMS) {
              const int itb = it + NGW; if (itb < NITEMS) { Ib = decode(itb); tr_load(Ib, vb, lane); }
              tr_finish(Ia, va, scr, lane);
              if (itb >= NITEMS) break;
              const int itc = itb + NGW; if (itc < NITEMS) { Ia = decode(itc); tr_load(Ia, va, lane); }
              tr_finish(Ib, vb, scr, lane);
              it = itc; } }
        for (int m = gw; m < T; m += 4 * NGW) rms_rows_to_bf16<4>(x, n1g, XN1, m, NGW, T, lane);
        __syncthreads();
        for (int id = bx; id < 256; id += G) {
            const int g = id >> 6, kb = (id >> 4) & 3, nb = id & 15;
            LAS float* WoS = (LAS float*)L; LAS float* wps = (LAS float*)(L + 32768);
            { f32x4 t4[4];
#pragma unroll
              for (int q = 0; q < 4; ++q) { const int f = tid + 512 * q, dd = f >> 4, c4 = (f & 15) * 4; t4[q] = *(const GAS f32x4*)(w_out + (size_t)(512 + g * 128 + dd) * 1024 + nb * 64 + c4); }
              float w8[8], p8[8];
#pragma unroll
              for (int q = 0; q < 8; ++q) { const int f = tid + 512 * q, kk = f >> 7, dd = f & 127; w8[q] = wpool[(size_t)(g * 128 + kb * 32 + kk) * 128 + dd]; p8[q] = pscale[g * 128 + dd]; }
#pragma unroll
              for (int q = 0; q < 4; ++q) { const int f = tid + 512 * q; *(LAS f32x4*)(WoS + (f >> 4) * 64 + (f & 15) * 4) = t4[q]; }
#pragma unroll
              for (int q = 0; q < 8; ++q) { const int f = tid + 512 * q; wps[(f >> 7) * 129 + (f & 127)] = w8[q] * p8[q]; } }
            __syncthreads();
            { const int kk = tid >> 4, c4 = (tid & 15) * 4; f32x4 acc = {0.f, 0.f, 0.f, 0.f};
#pragma unroll 8
              for (int dd = 0; dd < 128; ++dd) { const float w = wps[kk * 129 + dd]; const f32x4 wo = *(const LAS f32x4*)(WoS + dd * 64 + c4); acc = acc + wo * w; }
              bf16* dst = Wout_t + (size_t)(nb * 64 + c4) * 1024 + 512 + g * 128 + kb * 32 + kk;
              dst[0] = (bf16)f2bf(acc.x); dst[1024] = (bf16)f2bf(acc.y); dst[2048] = (bf16)f2bf(acc.z); dst[3072] = (bf16)f2bf(acc.w); }
            __syncthreads();
        }
    }
    SEAM(0);
    if (IN(1)) {
        pg8::Gemm g{XN1, Win_t, T, 2048, DM}; pg8::StaticOrder S; S.init(g, G, bx);
        pg8::EpiBf16 E{QKVU, 512, 512, (size_t)T * 512, C2, (unsigned*)(ctl + CW_KMAX)};
        pg8::gemm_phase<pg8::EpiBf16, pg8::StaticOrder, false>(L, DM, S, E);
    }
    SEAM(1);
    if (IN(2)) {
        const int xg = vcu >> 5, i5 = vcu & 31, b = xg >> 2, ty = (xg >> 1) & 1, qb = 16 * (xg & 1) + (i5 >> 1), c = i5 & 1;
        if (vcu < 256) {
#pragma unroll 1
            for (int u = 0; u < 2; ++u) { const int h = (u == 0) ? (ty ? 2 : 3) : (ty ? 1 : 0);
                const float slope = exp2f(-2.0f * (float)(h + 1)), sg2 = slope * LOG2E;
                attn::attn_unit<ATT_THR>(b, h, c, qb, sg2, QKVU, QKVU + (size_t)T * 512, QKVU + (size_t)2 * T * 512, AO + (size_t)c * T * 512, (const unsigned*)(ctl + CW_KMAX) + (size_t)b * 128 * 8, (char*)lds); }
        }
        { LAS float* scr = (LAS float*)(L + wave * 16384); volatile LAS unsigned* qslot = MISC + 16;
          for (;;) {
              __syncthreads();
              if (tid == 0) qslot[0] = atomicAdd((unsigned*)(ctl + CW_QUEUE), 1u);
              __syncthreads();
              const int batch = (int)qslot[0]; if (batch >= N_Q_BATCHES) break;
              const int it0 = batch * Q_BATCH + wave * 8; float va[32], vb[32]; TrItem Ia, Ib;
              Ia = expert_item(it0, wgate, wup, wdown, Wgu_t, Wd_t); tr_load(Ia, va, lane);
#pragma unroll 1
              for (int k = 0; k < 8; k += 2) {
                  Ib = expert_item(it0 + k + 1, wgate, wup, wdown, Wgu_t, Wd_t); tr_load(Ib, vb, lane);
                  tr_finish(Ia, va, scr, lane);
                  if (k + 2 < 8) { Ia = expert_item(it0 + k + 2, wgate, wup, wdown, Wgu_t, Wd_t); tr_load(Ia, va, lane); }
                  tr_finish(Ib, vb, scr, lane); } } }
    }
    SEAM(2);
    if (IN(3)) {
        float s1 = wave_sum(lq1[lane] * lk1[lane]), s2 = wave_sum(lq2[lane] * lk2[lane]);
        const float lam = expf(s1) - expf(s2) + LAM_INIT;
        const bf16* U = QKVU + (size_t)3 * T * 512;
        float sg[8];
#pragma unroll
        for (int j = 0; j < 8; ++j) sg[j] = subg[(8 * lane + j) & 127] * (1.0f - LAM_INIT);
        for (int t0 = gw * 8; t0 < T; t0 += NGW * 8) {
            v4u a1[8], a2[8], ur[23];
#pragma unroll
            for (int q = 0; q < 8; ++q) { a1[q] = *(const GAS v4u*)(AO + (size_t)(t0 + q) * 512 + 8 * lane); a2[q] = *(const GAS v4u*)(AO + (size_t)(T + t0 + q) * 512 + 8 * lane); }
            const int tt0 = t0 & (SEQ - 1), tb = t0 - tt0;
#pragma unroll
            for (int k = 0; k < 23; ++k) { int j = tt0 - 8 + k; j = j < 0 ? 0 : (j > SEQ - 1 ? SEQ - 1 : j); ur[k] = *(const GAS v4u*)(U + (size_t)(tb + j) * 512 + 8 * lane); }
#pragma unroll
            for (int q = 0; q < 8; ++q) {
                float a[8];
#pragma unroll
                for (int j = 0; j < 4; ++j) { a[2 * j] = bflo(a1[q][j]) - lam * bflo(a2[q][j]); a[2 * j + 1] = bfhi(a1[q][j]) - lam * bfhi(a2[q][j]); }
                float ss = 0.f;
#pragma unroll
                for (int j = 0; j < 8; ++j) ss += a[j] * a[j];
                ss += __shfl_xor(ss, 1); ss += __shfl_xor(ss, 2); ss += __shfl_xor(ss, 4); ss += __shfl_xor(ss, 8);
                const float r = 1.0f / sqrtf(ss * (1.0f / 128.0f) + EPS);
                v4u o; o.x = pk2(a[0] * r * sg[0], a[1] * r * sg[1]); o.y = pk2(a[2] * r * sg[2], a[3] * r * sg[3]); o.z = pk2(a[4] * r * sg[4], a[5] * r * sg[5]); o.w = pk2(a[6] * r * sg[6], a[7] * r * sg[7]);
                *(GAS v4u*)(MIX + (size_t)(t0 + q) * 1024 + 8 * lane) = o;
            }
            const int hw = 1 << (lane >> 4);
#pragma unroll
            for (int q = 0; q < 8; ++q) {
                const int tt = tt0 + q; int jlo = tt - hw, jhi = tt + hw; jlo = jlo < 0 ? 0 : jlo; jhi = jhi > SEQ ? SEQ : jhi;
                float sm[8] = {0.f, 0.f, 0.f, 0.f, 0.f, 0.f, 0.f, 0.f};
#pragma unroll
                for (int k = q; k < q + 16; ++k) { const int j = tt0 - 8 + k; const float wgt = (j >= jlo && j < jhi) ? 1.0f : 0.0f;
#pragma unroll
                    for (int p = 0; p < 4; ++p) { sm[2 * p] = __builtin_fmaf(wgt, bflo(ur[k][p]), sm[2 * p]); sm[2 * p + 1] = __builtin_fmaf(wgt, bfhi(ur[k][p]), sm[2 * p + 1]); } }
                const float ic = 1.0f / (float)(jhi - jlo); const v4u ut = ur[8 + q];
                v4u d; d.x = pk2(sm[0] * ic - bflo(ut[0]), sm[1] * ic - bfhi(ut[0])); d.y = pk2(sm[2] * ic - bflo(ut[1]), sm[3] * ic - bfhi(ut[1]));
                d.z = pk2(sm[4] * ic - bflo(ut[2]), sm[5] * ic - bfhi(ut[2])); d.w = pk2(sm[6] * ic - bflo(ut[3]), sm[7] * ic - bfhi(ut[3]));
                *(GAS v4u*)(MIX + (size_t)(t0 + q) * 1024 + 512 + 8 * lane) = d;
            }
        }
    }
    SEAM(3);
    if (IN(4)) {
        pg8::Gemm g{MIX, Wout_t, T, DM, DM}; pg8::StaticOrder S; S.init(g, G, bx);
        pg8::EpiResF32 E{x, out, DM};
        pg8::gemm_phase<pg8::EpiResF32, pg8::StaticOrder, false>(L, DM, S, E);
    }
    SEAM(4);
    if (IN(5)) {
        LAS float* WR = (LAS float*)(L + RT_WR); LAS float* SC = (LAS float*)(L + RT_SC); LAS float* SQ = (LAS float*)(L + RT_SQ); LAS float* SR = (LAS float*)(L + RT_SR);
        { float wv[8], gv[8];
#pragma unroll
          for (int q = 0; q < 8; ++q) { const int idx = tid + 512 * q; wv[q] = wgr[idx]; gv[q] = n2g[idx >> 2]; }
#pragma unroll
          for (int q = 0; q < 8; ++q) { const int idx = tid + 512 * q; WR[(idx & 3) * 1028 + (idx >> 2)] = wv[q] * gv[q]; }
          for (int base = 0; base < 1024 * 32; base += 512 * 16) { float w16[16], g16[16];
#pragma unroll
              for (int q = 0; q < 16; ++q) { const int idx = base + tid + 512 * q; w16[q] = wer[idx]; g16[q] = n2g[idx >> 5]; }
#pragma unroll
              for (int q = 0; q < 16; ++q) { const int idx = base + tid + 512 * q; WR[(4 + (idx & 31)) * 1028 + (idx >> 5)] = w16[q] * g16[q]; } } }
        LAS unsigned* HI = (LAS unsigned*)(L + RT_HI); LAS unsigned* HB = HI + 32;
        if (tid < 32) HI[tid] = 0u;
        __syncthreads();
        const int gq = wave & 3, kh = wave >> 2, tk = lane & 15, kq = lane >> 4;
        for (int tb = vcu * 64; tb < T; tb += G * 64) {
            const float* hrow = out + (size_t)(tb + 16 * gq + tk) * DM + 512 * kh + 4 * kq;
            f32x4 acc[3] = {{0.f, 0.f, 0.f, 0.f}, {0.f, 0.f, 0.f, 0.f}, {0.f, 0.f, 0.f, 0.f}}; float ssq = 0.f;
            int r_ea = 0, r_eb = 0, r_pa = 0, r_pb = 0; float r_g1 = 0.f, r_g2 = 0.f;
            int nn[3];
#pragma unroll
            for (int nb = 0; nb < 3; ++nb) { const int n = 16 * nb + tk; nn[nb] = (n < 36 ? n : 35) * 1028 + 512 * kh + 4 * kq; }
#pragma unroll 8
            for (int s = 0; s < 32; ++s) {
                const f32x4 hv = *(const GAS f32x4*)(hrow + 16 * s);
                ssq += (hv.x * hv.x + hv.y * hv.y) + (hv.z * hv.z + hv.w * hv.w);
#pragma unroll
                for (int nb = 0; nb < 3; ++nb) { const f32x4 bv = *(const LAS f32x4*)(WR + nn[nb] + 16 * s);
                    acc[nb] = __builtin_amdgcn_mfma_f32_16x16x4f32(hv.x, bv.x, acc[nb], 0, 0, 0); acc[nb] = __builtin_amdgcn_mfma_f32_16x16x4f32(hv.y, bv.y, acc[nb], 0, 0, 0);
                    acc[nb] = __builtin_amdgcn_mfma_f32_16x16x4f32(hv.z, bv.z, acc[nb], 0, 0, 0); acc[nb] = __builtin_amdgcn_mfma_f32_16x16x4f32(hv.w, bv.w, acc[nb], 0, 0, 0); }
            }
            ssq += __shfl_xor(ssq, 16); ssq += __shfl_xor(ssq, 32);
            if (kh == 1) {
#pragma unroll
                for (int nb = 0; nb < 3; ++nb)
#pragma unroll
                    for (int r = 0; r < 4; ++r) SC[gq * 768 + (nb * 4 + r) * 64 + lane] = acc[nb][r];
                if (kq == 0) SQ[gq * 16 + tk] = ssq;
            }
            __syncthreads();
            if (kh == 0) {
#pragma unroll
                for (int nb = 0; nb < 3; ++nb)
#pragma unroll
                    for (int r = 0; r < 4; ++r) acc[nb][r] += SC[gq * 768 + (nb * 4 + r) * 64 + lane];
                const float sq2 = ssq + SQ[gq * 16 + tk];
                LDS_WAIT(); asm volatile("" ::: "memory");
#pragma unroll
                for (int nb = 0; nb < 3; ++nb)
#pragma unroll
                    for (int r = 0; r < 4; ++r) SC[gq * 768 + (4 * kq + r) * 48 + 16 * nb + tk] = acc[nb][r];
                LDS_WAIT(); asm volatile("" ::: "memory");
                if (lane < 16) {
                    const int t = tb + 16 * gq + lane; const float rstd = 1.0f / sqrtf(sq2 * (1.0f / DM) + EPS);
                    SR[gq * 16 + lane] = rstd;
                    const LAS float* lg = SC + gq * 768 + lane * 48;
                    float gl[4];
#pragma unroll
                    for (int g = 0; g < 4; ++g) gl[g] = lg[g] * rstd + bgr[g];
                    int gs = 0; float gm = gl[0];
#pragma unroll
                    for (int g = 1; g < 4; ++g) if (gl[g] > gm) { gm = gl[g]; gs = g; }
                    float den = 0.f;
#pragma unroll
                    for (int g = 0; g < 4; ++g) den += expf(gl[g] - gm);
                    const float pg = 1.0f / den;
                    float e8[8];
#pragma unroll
                    for (int i = 0; i < 8; ++i) e8[i] = lg[4 + gs * 8 + i] * rstd + ber[gs * 8 + i];
                    float v1 = e8[0]; int i1 = 0;
#pragma unroll
                    for (int i = 1; i < 8; ++i) if (e8[i] > v1) { v1 = e8[i]; i1 = i; }
                    float v2 = -3.0e38f; int i2 = 0;
#pragma unroll
                    for (int i = 0; i < 8; ++i) if (i != i1 && e8[i] > v2) { v2 = e8[i]; i2 = i; }
                    const float p2 = expf(v2 - v1), g1 = pg / (1.0f + p2), g2 = pg * p2 / (1.0f + p2);
                    const int ea = gs * 8 + i1, eb = gs * 8 + i2;
                    r_ea = ea; r_eb = eb; r_g1 = g1; r_g2 = g2;
                    r_pa = (int)__hip_atomic_fetch_add((LAS unsigned*)HI + ea, 1u, __ATOMIC_RELAXED, __HIP_MEMORY_SCOPE_WORKGROUP);
                    r_pb = (int)__hip_atomic_fetch_add((LAS unsigned*)HI + eb, 1u, __ATOMIC_RELAXED, __HIP_MEMORY_SCOPE_WORKGROUP);
                }
            }
            __syncthreads();
            if (tid < 32) { const unsigned c = HI[tid]; HB[tid] = c ? atomicAdd((unsigned*)(ctl + CW_CNT + 64 * tid), c) : 0u; }
            __syncthreads();
            if (kh == 0 && lane < 16) { const int t = tb + 16 * gq + lane; const int pa = r_pa + (int)HB[r_ea], pb = r_pb + (int)HB[r_eb];
                list[(size_t)r_ea * 16384 + pa] = t; glist[(size_t)r_ea * 16384 + pa] = r_g1; list[(size_t)r_eb * 16384 + pb] = t; glist[(size_t)r_eb * 16384 + pb] = r_g2;
                epos[t * 2] = (r_ea << 16) | pa; epos[t * 2 + 1] = (r_eb << 16) | pb; }
            if (tid < 32) HI[tid] = 0u;
            { const GAS f32x4* gr = (const GAS f32x4*)n2g + lane; f32x4 gg[4];
#pragma unroll
              for (int j = 0; j < 4; ++j) gg[j] = gr[64 * j];
#pragma unroll
              for (int qb_ = 0; qb_ < 2; ++qb_) { f32x4 v[4][4];
#pragma unroll
                  for (int q = 0; q < 4; ++q) { const GAS f32x4* hr = (const GAS f32x4*)(out + (size_t)(tb + 8 * wave + 4 * qb_ + q) * DM) + lane;
#pragma unroll
                      for (int j = 0; j < 4; ++j) v[q][j] = hr[64 * j]; }
#pragma unroll
                  for (int q = 0; q < 4; ++q) { const int tl = 8 * wave + 4 * qb_ + q; const float rstd = SR[tl]; GAS v2u* o8 = (GAS v2u*)(XN2 + (size_t)(tb + tl) * DM) + lane;
#pragma unroll
                      for (int j = 0; j < 4; ++j) { v2u w; w.x = pk2(v[q][j].x * rstd * gg[j].x, v[q][j].y * rstd * gg[j].y); w.y = pk2(v[q][j].z * rstd * gg[j].z, v[q][j].w * rstd * gg[j].w); o8[64 * j] = w; } } } }
            __syncthreads();
        }
    }
    SEAM(5);
    LAS int* tstart = (LAS int*)(L + MOE_TAB_OFF); LAS int* ecnt = (LAS int*)(L + MOE_TAB_OFF + 256);
    if (IN(6) || IN(7) || IN(8)) {
        if (tid < 32) ecnt[tid] = (int)__hip_atomic_load(ctl + CW_CNT + 64 * tid, RLX_AGENT);
        __syncthreads();
        if (tid == 0) { int a = 0; for (int e = 0; e < 32; ++e) { tstart[e] = a; a += (ecnt[e] + 255) >> 8; } tstart[32] = a; }
        __syncthreads();
    }
    if (IN(6)) {
        pg8::MoeOrder<true> S; S.tstart = tstart; S.cnt = ecnt; S.ntiles = tstart[32]; S.G = G; S.c = vcu; S.A = XN2; S.Bt = Wgu_t; S.a_tstep = 0; S.b_estep = (size_t)1024 * 1024 * 2; S.b_tstep = (size_t)256 * 1024 * 2; S.list = list; S.Kb = 2048;
        pg8::EpiSwiGLU E{HDN};
        pg8::gemm_phase<pg8::EpiSwiGLU, pg8::MoeOrder<true>, true>(L, DM, S, E);
    }
    SEAM(6);
    if (IN(7)) {
        pg8::MoeOrder<false> S; S.tstart = tstart; S.cnt = ecnt; S.ntiles = tstart[32]; S.G = G; S.c = vcu; S.A = HDN; S.Bt = Wd_t; S.a_tstep = (size_t)256 * 512 * 2; S.b_estep = (size_t)1024 * 512 * 2; S.b_tstep = (size_t)256 * 512 * 2; S.list = list; S.Kb = 1024;
        pg8::EpiGateBf16 E{Y, glist};
        pg8::gemm_phase<pg8::EpiGateBf16, pg8::MoeOrder<false>, false>(L, DEXP, S, E);
    }
    SEAM(7);
    if (IN(8)) {
        const GAS f32x4* gr = (const GAS f32x4*)fing + lane; f32x4 gg[4];
#pragma unroll
        for (int j = 0; j < 4; ++j) gg[j] = gr[64 * j];
        for (int t0 = gw; t0 < T; t0 += 4 * NGW) {
            int pa[4], pb[4];
#pragma unroll
            for (int q = 0; q < 4; ++q) { const int t = t0 + q * NGW; pa[q] = epos[(t < T ? t : t0) * 2]; pb[q] = epos[(t < T ? t : t0) * 2 + 1]; }
            f32x4 v[4][4]; v2u ya[4][4], yb[4][4];
#pragma unroll
            for (int q = 0; q < 4; ++q) { const int t = (t0 + q * NGW < T) ? t0 + q * NGW : t0;
                const size_t ra = (size_t)tstart[pa[q] >> 16] * 256 + (pa[q] & 0xffff), rb = (size_t)tstart[pb[q] >> 16] * 256 + (pb[q] & 0xffff);
                const GAS f32x4* hr = (const GAS f32x4*)(out + (size_t)t * DM) + lane; const GAS v2u* pya = (const GAS v2u*)(Y + ra * 1024) + lane; const GAS v2u* pyb = (const GAS v2u*)(Y + rb * 1024) + lane;
#pragma unroll
                for (int j = 0; j < 4; ++j) { v[q][j] = hr[64 * j]; ya[q][j] = pya[64 * j]; yb[q][j] = pyb[64 * j]; } }
#pragma unroll
            for (int q = 0; q < 4; ++q) { const int t = t0 + q * NGW; float s = 0.f;
#pragma unroll
                for (int j = 0; j < 4; ++j) { const v2u a = ya[q][j], bq = yb[q][j];
                    v[q][j].x += bflo(a.x) + bflo(bq.x); v[q][j].y += bfhi(a.x) + bfhi(bq.x); v[q][j].z += bflo(a.y) + bflo(bq.y); v[q][j].w += bfhi(a.y) + bfhi(bq.y);
                    s += (v[q][j].x * v[q][j].x + v[q][j].y * v[q][j].y) + (v[q][j].z * v[q][j].z + v[q][j].w * v[q][j].w); }
                const float rstd = 1.0f / sqrtf(wave_sum(s) * (1.f / DM) + EPS);
                if (t < T) { GAS f32x4* orow = (GAS f32x4*)(out + (size_t)t * DM) + lane;
#pragma unroll
                    for (int j = 0; j < 4; ++j) orow[64 * j] = v[q][j] * rstd * gg[j]; } }
        }
    }
#undef IN
#undef SEAM
}

extern "C" void kernel_launch(void* const* d_in, const int* in_sizes, int n_in, void* d_out, int out_size, void* d_ws, size_t ws_size, hipStream_t stream) {
    static int grid = 0;
    if (grid == 0) {
        if (n_in != 20 || in_sizes[0] != T * DM || out_size != T * DM || ws_size < WS_END) { fprintf(stderr, "kernel_launch: unexpected shapes: n_in %d in0 %d out %d ws %zu; nothing launched\n", n_in, n_in > 0 ? in_sizes[0] : -1, out_size, ws_size); grid = -1; return; }
        int dev = 0, cus = 0;
        if (hipGetDevice(&dev) != hipSuccess || hipDeviceGetAttribute(&cus, hipDeviceAttributeMultiprocessorCount, dev) != hipSuccess) { grid = -1; return; }
        if (hipFuncSetAttribute((const void*)mk_fwd, hipFuncAttributeMaxDynamicSharedMemorySize, LDS_BYTES) != hipSuccess) { fprintf(stderr, "kernel_launch: hipFuncSetAttribute failed\n"); grid = -1; return; }
        (void)hipGetLastError();
        grid = cus;
    }
    if (grid < 0) return;
    (void)hipMemsetAsync((char*)d_ws + WS_CTL, 0, CTL_ZERO_BYTES, stream);
    Args a{};
    for (int i = 0; i < 20; ++i) a.in[i] = (const float*)d_in[i];
    a.out = (float*)d_out; a.ws = (unsigned char*)d_ws;
#ifndef MK_N_LAUNCHES
#define MK_N_LAUNCHES 1
#endif
    constexpr int NPH = 9;
    if (MK_N_LAUNCHES == 1) { a.ph_lo = 0; a.ph_hi = NPH; hipLaunchKernelGGL(mk_fwd, dim3(grid), dim3(NWAVES * 64), LDS_BYTES, stream, a); }
    else for (int p = 0; p < NPH; ++p) { a.ph_lo = p; a.ph_hi = p + 1; hipLaunchKernelGGL(mk_fwd, dim3(grid), dim3(NWAVES * 64), LDS_BYTES, stream, a); }
}
```

```cpp
#include <hip/hip_runtime.h>
#include <hip/hip_bf16.h>
#include <cstdio>
#include <cstdint>
#include <cmath>
namespace pg8 {
#define PG8_LAS __attribute__((address_space(3)))
typedef unsigned short bf16_t;
typedef short bf16x8 __attribute__((ext_vector_type(8)));
typedef float f32x4 __attribute__((ext_vector_type(4)));
typedef float f32x2 __attribute__((ext_vector_type(2)));
typedef unsigned u32x4 __attribute__((ext_vector_type(4)));
constexpr int BM = 256, BK = 64, HALF = 128, HTB = HALF * BK * 2  , STAGE_BYTES = 8 * HTB, NXCD = 8, WGM = 8;

__host__ __device__ __forceinline__ int lds_byte(int r, int c) { const int st = (r >> 4) * 2 + (c >> 5), rr = r & 15, cc = c & 31, ob = rr * 64 + cc * 2; return st * 1024 + (ob ^ (((ob >> 9) & 1) << 5)); }
__host__ __device__ __forceinline__ void stage_rc(int b, int& R, int& C) { const int st = b / 1024, sb = b % 1024, swz = sb ^ (((sb >> 9) & 1) << 5); R = (st >> 1) * 16 + swz / 64; C = (st & 1) * 32 + (swz % 64) / 2; }
__host__ __device__ __forceinline__ int perm32(int rho) { const int n = rho >> 4, i = rho & 15; return 8 * (i >> 2) + 4 * n + (i & 3); }

struct Unit { int pm, pn, e, lt, cnt; };
struct Gemm { const bf16_t* A; const bf16_t* Bt; int M, N, K; };

struct StaticOrder {
    int nM, nN, nwg, G, c; const bf16_t* A; const bf16_t* Bt; size_t tstep;
    __device__ void init(const Gemm& g, int G_, int c_) { nM = g.M / BM; nN = g.N / BM; nwg = nM * nN; G = G_; c = c_; A = g.A; Bt = g.Bt; tstep = (size_t)BM * g.K * 2; }
    __device__ bool next(int i, Unit& u) const {
        const long L = (long)i * G + c; if (L >= nwg) return false;
        int wgid = (int)L; { const int q = nwg / NXCD, r = nwg % NXCD, xcd = wgid % NXCD, off = wgid / NXCD; wgid = (xcd < r ? xcd * (q + 1) : r * (q + 1) + (xcd - r) * q) + off; }
        const int nig = WGM * nN, gid = wgid / nig, fm = gid * WGM, gsz = (nM - fm) < WGM ? (nM - fm) : WGM;
        u.pm = fm + ((wgid % nig) % gsz); u.pn = (wgid % nig) / gsz; u.e = 0; u.lt = 0; u.cnt = 0; return true;
    }
    __device__ __forceinline__ const char* a_base(const Unit& u) const { return (const char*)A + (size_t)u.pm * tstep; }
    __device__ __forceinline__ const char* b_base(const Unit& u) const { return (const char*)Bt + (size_t)u.pn * tstep; }
    __device__ __forceinline__ unsigned row_off(const Unit&, int) const { return 0u; }
};
template <bool GATHER> struct MoeOrder {
    const PG8_LAS int* tstart; const PG8_LAS int* cnt; int ntiles, G, c;
    const bf16_t* A; const bf16_t* Bt; size_t a_tstep, b_estep, b_tstep; const int* list; int Kb  ;
    __device__ bool next(int i, Unit& u) const {
        const long L = (long)i * G + c; if (L >= 4L * ntiles) return false;
        const int rt = (int)(L >> 2); u.pn = (int)(L & 3); u.pm = rt;
        int e = 0;
#pragma unroll
        for (int k = 1; k < 32; ++k) e += (rt >= tstart[k]) ? 1 : 0;
        e = __builtin_amdgcn_readfirstlane(e);
        u.e = e; u.lt = __builtin_amdgcn_readfirstlane(rt - tstart[e]); u.cnt = __builtin_amdgcn_readfirstlane(cnt[e]); return true;
    }
    __device__ __forceinline__ const char* a_base(const Unit& u) const { return GATHER ? (const char*)A : (const char*)A + (size_t)u.pm * a_tstep; }
    __device__ __forceinline__ const char* b_base(const Unit& u) const { return (const char*)Bt + (size_t)u.e * b_estep + (size_t)u.pn * b_tstep; }
    __device__ __forceinline__ unsigned row_off(const Unit& u, int R) const { const int pos = u.lt * BM + R; const int tok = (pos < u.cnt) ? list[(size_t)u.e * 16384 + pos] : 0; return (unsigned)tok * (unsigned)Kb; }
};

__device__ __forceinline__ unsigned cvt_pk_bf16(float lo, float hi) { unsigned r; asm volatile("v_cvt_pk_bf16_f32 %0, %1, %2" : "=v"(r) : "v"(lo), "v"(hi)); return r; }

struct EpiBf16 {
    static constexpr bool PERM = true;
    bf16_t* O; int ldc; int split_cols; size_t split_stride; float scale0; unsigned* kmax;
    __device__ __forceinline__ void operator()(const f32x4 (&acc)[2][2][4][2], const Unit& u, int wr, int wc, int fr, int fq) const {
        const int row0 = u.pm * BM + wr * 64 + fr; int colt = u.pn * BM; bf16_t* base = O;
        float sc = 1.f; int tsplit = 0; if (split_cols) { const int t = colt / split_cols; tsplit = t; base += (size_t)t * split_stride; colt -= t * split_cols; if (t == 0) sc = scale0; }
        const int col0 = colt + wc * 32 + 8 * fq;
        if (kmax && tsplit == 1) {
#pragma unroll
            for (int ai = 0; ai < 2; ++ai)
#pragma unroll
                for (int bj = 0; bj < 2; ++bj) { float mx = 0.f;
#pragma unroll
                    for (int m = 0; m < 4; ++m) { const f32x4 a = acc[ai][bj][m][0], b = acc[ai][bj][m][1];
                        float ss = (a[0] * a[0] + a[1] * a[1]) + (a[2] * a[2] + a[3] * a[3]) + (b[0] * b[0] + b[1] * b[1]) + (b[2] * b[2] + b[3] * b[3]);
                        ss += __shfl_xor(ss, 16); ss += __shfl_xor(ss, 32); mx = __builtin_fmaxf(mx, ss); }
                    mx = __builtin_fmaxf(mx, __shfl_xor(mx, 1)); mx = __builtin_fmaxf(mx, __shfl_xor(mx, 2)); mx = __builtin_fmaxf(mx, __shfl_xor(mx, 4)); mx = __builtin_fmaxf(mx, __shfl_xor(mx, 8));
                    if (fr == 0 && fq == 0) atomicMax(kmax + (size_t)(u.pm * 4 + ai * 2 + wr) * 8 + (colt >> 6) + 2 * bj + (wc >> 1), __float_as_uint(mx)); }
        }
#pragma unroll
        for (int ai = 0; ai < 2; ++ai)
#pragma unroll
            for (int m = 0; m < 4; ++m) { bf16_t* rowp = base + (size_t)(row0 + ai * HALF + m * 16) * ldc + col0;
#pragma unroll
                for (int bj = 0; bj < 2; ++bj) { f32x4 v0 = acc[ai][bj][m][0] * sc, v1 = acc[ai][bj][m][1] * sc;
                    u32x4 w; w.x = cvt_pk_bf16(v0[0], v0[1]); w.y = cvt_pk_bf16(v0[2], v0[3]); w.z = cvt_pk_bf16(v1[0], v1[1]); w.w = cvt_pk_bf16(v1[2], v1[3]);
                    *(u32x4*)(rowp + bj * HALF) = w; } }
    }
};
struct EpiResF32 {
    static constexpr bool PERM = false;
    const float* base; float* out; int ldc;
    __device__ __forceinline__ void operator()(const f32x4 (&acc)[2][2][4][2], const Unit& u, int wr, int wc, int fr, int fq) const {
        const int col0 = u.pn * BM + wc * 32 + 4 * fq;
#pragma unroll
        for (int ai = 0; ai < 2; ++ai)
#pragma unroll
            for (int m = 0; m < 4; ++m) { const size_t off = (size_t)(u.pm * BM + ai * HALF + wr * 64 + m * 16 + fr) * ldc + col0;
#pragma unroll
                for (int bj = 0; bj < 2; ++bj)
#pragma unroll
                    for (int n = 0; n < 2; ++n) { const f32x4 bs = *(const f32x4*)(base + off + bj * HALF + n * 16); *(f32x4*)(out + off + bj * HALF + n * 16) = bs + acc[ai][bj][m][n]; } }
    }
};
struct EpiSwiGLU {
    static constexpr bool PERM = true;
    bf16_t* O;
    __device__ __forceinline__ void operator()(const f32x4 (&acc)[2][2][4][2], const Unit& u, int wr, int wc, int fr, int fq) const {
        const int row0 = u.pm * BM + wr * 64 + fr, col0 = u.pn * HALF + wc * 32 + 8 * fq;
#pragma unroll
        for (int ai = 0; ai < 2; ++ai)
#pragma unroll
            for (int m = 0; m < 4; ++m) { float hv[8];
#pragma unroll
                for (int n = 0; n < 2; ++n)
#pragma unroll
                    for (int j = 0; j < 4; ++j) { const float g = acc[ai][0][m][n][j], up = acc[ai][1][m][n][j];
                        const float sg = __builtin_amdgcn_rcpf(1.0f + __builtin_amdgcn_exp2f(-1.4426950408889634f * g)); hv[n * 4 + j] = g * sg * up; }
                u32x4 w; w.x = cvt_pk_bf16(hv[0], hv[1]); w.y = cvt_pk_bf16(hv[2], hv[3]); w.z = cvt_pk_bf16(hv[4], hv[5]); w.w = cvt_pk_bf16(hv[6], hv[7]);
                *(u32x4*)(O + (size_t)(row0 + ai * HALF + m * 16) * 512 + col0) = w; }
    }
};
struct EpiGateBf16 {
    static constexpr bool PERM = true;
    bf16_t* O; const float* glist;
    __device__ __forceinline__ void operator()(const f32x4 (&acc)[2][2][4][2], const Unit& u, int wr, int wc, int fr, int fq) const {
        const int col0 = u.pn * BM + wc * 32 + 8 * fq;
#pragma unroll
        for (int ai = 0; ai < 2; ++ai)
#pragma unroll
            for (int m = 0; m < 4; ++m) { const int R = ai * HALF + wr * 64 + m * 16 + fr, pos = u.lt * BM + R; const float gt = (pos < u.cnt) ? glist[(size_t)u.e * 16384 + pos] : 0.f;
                bf16_t* rowp = O + (size_t)(u.pm * BM + R) * 1024 + col0;
#pragma unroll
                for (int bj = 0; bj < 2; ++bj) { f32x4 v0 = acc[ai][bj][m][0] * gt, v1 = acc[ai][bj][m][1] * gt;
                    u32x4 w; w.x = cvt_pk_bf16(v0[0], v0[1]); w.y = cvt_pk_bf16(v0[2], v0[3]); w.z = cvt_pk_bf16(v1[0], v1[1]); w.w = cvt_pk_bf16(v1[2], v1[3]);
                    *(u32x4*)(rowp + bj * HALF) = w; } }
    }
};

template <class Epi, class Sched, bool GATHER>
__device__ __forceinline__ void gemm_phase(PG8_LAS unsigned char* lds, const int K, const Sched& S, const Epi& E) {
    const int tid = threadIdx.x, wid = __builtin_amdgcn_readfirstlane(tid >> 6), lane = tid & 63, wr = wid >> 2, wc = wid & 3, fr = lane & 15, fq = lane >> 4;
    const int nt = K / BK;
    unsigned voffA[2], voffB[2]; int rowA[2];
#pragma unroll
    for (int i = 0; i < 2; ++i) { int R, C; stage_rc(tid * 16 + i * 8192, R, C); const int Rb = Epi::PERM ? ((R & ~31) + perm32(R & 31)) : R;
        rowA[i] = R; voffA[i] = GATHER ? (unsigned)C * 2u : (unsigned)(R * K + C) * 2u; voffB[i] = (unsigned)(Rb * K + C) * 2u; }
    const size_t kstep = (size_t)(BK * 2);
    const size_t hstep = (size_t)HALF * K * 2;
    const size_t hstepA = GATHER ? 0 : hstep;
    const unsigned ldsw = (unsigned)wid * 1024u;
    const int aoff = lds_byte(wr * 64 + fr, fq * 8), boff = lds_byte(wc * 32 + fr, fq * 8);
#define PG8_SA(b, h) (((b) * 2 + (h)) * HTB)
#define PG8_SB(b, h) ((4 + (b) * 2 + (h)) * HTB)
#define PG8_STAGE(bufoff, gbase, voff) do { _Pragma("unroll") for (int _i = 0; _i < 2; ++_i) \
        __builtin_amdgcn_global_load_lds((const unsigned*)((const char*)(gbase) + (voff)[_i]), (PG8_LAS unsigned*)(lds + (bufoff) + ldsw + _i * 8192), 16, 0, 0); } while (0)
#define PG8_STAGE_A(bufoff, gbase, h, VO) do { _Pragma("unroll") for (int _i = 0; _i < 2; ++_i) \
        __builtin_amdgcn_global_load_lds((const unsigned*)((const char*)(gbase) + (size_t)(h) * hstepA + (GATHER ? (VO)[2 * (h) + _i] : voffA[_i])), (PG8_LAS unsigned*)(lds + (bufoff) + ldsw + _i * 8192), 16, 0, 0); } while (0)
#define PG8_LDA(dst, b, h) do { _Pragma("unroll") for (int m = 0; m < 4; ++m) _Pragma("unroll") for (int k = 0; k < 2; ++k) dst[m][k] = *(const PG8_LAS bf16x8*)(lds + PG8_SA(b, h) + aoff + m * 2048 + k * 1024); } while (0)
#define PG8_LDB(dst, b, h) do { _Pragma("unroll") for (int n = 0; n < 2; ++n) _Pragma("unroll") for (int k = 0; k < 2; ++k) dst[n][k] = *(const PG8_LAS bf16x8*)(lds + PG8_SB(b, h) + boff + n * 2048 + k * 1024); } while (0)
#define PG8_MMA(ai, bj, At, Bt) do { __builtin_amdgcn_s_setprio(1); _Pragma("unroll") for (int m = 0; m < 4; ++m) _Pragma("unroll") for (int n = 0; n < 2; ++n) _Pragma("unroll") for (int k = 0; k < 2; ++k) \
        acc[ai][bj][m][n] = __builtin_amdgcn_mfma_f32_16x16x32_bf16(Bt[n][k], At[m][k], acc[ai][bj][m][n], 0, 0, 0); __builtin_amdgcn_s_setprio(0); } while (0)
#define PG8_WAIT_V(n) asm volatile("s_waitcnt vmcnt(" #n ")" ::: "memory")
#define PG8_WAIT_L(n) asm volatile("s_waitcnt lgkmcnt(" #n ")" ::: "memory")
#define PG8_BAR __builtin_amdgcn_s_barrier()
#define PG8_SCHED __builtin_amdgcn_sched_barrier(0)
    Unit cur, nxt; int ui = 0;
    if (!S.next(0, cur)) return;
    f32x4 acc[2][2][4][2];
#pragma unroll
    for (int a = 0; a < 2; ++a)
#pragma unroll
        for (int b = 0; b < 2; ++b)
#pragma unroll
            for (int m = 0; m < 4; ++m)
#pragma unroll
                for (int n = 0; n < 2; ++n) acc[a][b][m][n] = (f32x4){0.f, 0.f, 0.f, 0.f};
    bf16x8 At[4][2], B0[2][2], B1[2][2];
    const char* cA = S.a_base(cur); const char* cB = S.b_base(cur);
    unsigned vc[4] = {0u, 0u, 0u, 0u}, vn[4] = {0u, 0u, 0u, 0u};
    if constexpr (GATHER) {
#pragma unroll
        for (int h = 0; h < 2; ++h)
#pragma unroll
            for (int i = 0; i < 2; ++i) vc[2 * h + i] = S.row_off(cur, h * HALF + rowA[i]) + voffA[i];
    }
    PG8_STAGE(PG8_SB(0, 0), cB, voffB); PG8_STAGE(PG8_SB(0, 1), cB + hstep, voffB); PG8_STAGE_A(PG8_SA(0, 0), cA, 0, vc); PG8_STAGE_A(PG8_SA(0, 1), cA, 1, vc);
    if (wr == 1) PG8_BAR;
    PG8_WAIT_V(2); PG8_BAR;
    PG8_STAGE(PG8_SB(1, 0), cB + kstep, voffB); PG8_STAGE_A(PG8_SA(1, 0), cA + kstep, 0, vc); PG8_STAGE(PG8_SB(1, 1), cB + hstep + kstep, voffB);
    PG8_WAIT_V(6); PG8_BAR;
    for (;;) {
        const bool has_next = S.next(ui + 1, nxt);
        const char* nA = has_next ? S.a_base(nxt) : cA; const char* nB = has_next ? S.b_base(nxt) : cB;
        if constexpr (GATHER) {
#pragma unroll
            for (int h = 0; h < 2; ++h)
#pragma unroll
                for (int i = 0; i < 2; ++i) vn[2 * h + i] = has_next ? (S.row_off(nxt, h * HALF + rowA[i]) + voffA[i]) : vc[2 * h + i];
        }
        for (int t = 0; t < nt; t += 2) {
            const bool last = (t == nt - 2);
            const char* a1 = cA + (size_t)(t + 1) * kstep;
            const char* a2 = last ? nA : cA + (size_t)(t + 2) * kstep; const char* b2 = last ? nB : cB + (size_t)(t + 2) * kstep;
            const char* a3 = a2 + kstep; const char* b3 = b2 + kstep;
            unsigned v2[4];
#pragma unroll
            for (int q = 0; q < 4; ++q) v2[q] = last ? vn[q] : vc[q];
            PG8_LDB(B0, 0, 0); PG8_LDB(B1, 0, 1); PG8_SCHED; PG8_LDA(At, 0, 0); PG8_STAGE_A(PG8_SA(1, 1), a1, 1, vc);
            PG8_WAIT_V(8); PG8_WAIT_L(0); PG8_BAR; PG8_MMA(0, 0, At, B0); PG8_MMA(0, 1, At, B1); PG8_BAR; PG8_SCHED;
            PG8_LDA(At, 0, 1); PG8_STAGE(PG8_SB(0, 0), b2, voffB); PG8_STAGE(PG8_SB(0, 1), b2 + hstep, voffB); PG8_STAGE_A(PG8_SA(0, 0), a2, 0, v2);
            PG8_WAIT_V(8); PG8_WAIT_L(0); PG8_BAR; PG8_MMA(1, 0, At, B0); PG8_MMA(1, 1, At, B1); PG8_BAR; PG8_SCHED;
            PG8_LDB(B0, 1, 0); PG8_LDB(B1, 1, 1); PG8_SCHED; PG8_LDA(At, 1, 0); PG8_STAGE_A(PG8_SA(0, 1), a2, 1, v2);
            PG8_WAIT_V(8); PG8_WAIT_L(0); PG8_BAR; PG8_MMA(0, 0, At, B0); PG8_MMA(0, 1, At, B1); PG8_BAR; PG8_SCHED;
            PG8_LDA(At, 1, 1); PG8_STAGE(PG8_SB(1, 0), b3, voffB); PG8_STAGE(PG8_SB(1, 1), b3 + hstep, voffB); PG8_STAGE_A(PG8_SA(1, 0), a3, 0, v2);
            PG8_WAIT_V(8); PG8_WAIT_L(0); PG8_BAR; PG8_MMA(1, 0, At, B0); PG8_MMA(1, 1, At, B1); PG8_BAR; PG8_SCHED;
        }
        if (wr == 0) PG8_BAR;
        E(acc, cur, wr, wc, fr, fq);
        if (!has_next) break;
#pragma unroll
        for (int a = 0; a < 2; ++a)
#pragma unroll
            for (int b = 0; b < 2; ++b)
#pragma unroll
                for (int m = 0; m < 4; ++m)
#pragma unroll
                    for (int n = 0; n < 2; ++n) acc[a][b][m][n] = (f32x4){0.f, 0.f, 0.f, 0.f};
        cur = nxt; cA = nA; cB = nB; ++ui;
#pragma unroll
        for (int q = 0; q < 4; ++q) vc[q] = vn[q];
        if (wr == 1) PG8_BAR;
    }
    PG8_WAIT_V(0);
    PG8_BAR;
#undef PG8_SA
#undef PG8_SB
#undef PG8_STAGE
#undef PG8_STAGE_A
#undef PG8_LDA
#undef PG8_LDB
#undef PG8_MMA
#undef PG8_WAIT_V
#undef PG8_WAIT_L
#undef PG8_BAR
#undef PG8_SCHED
}
}
namespace attn {
using bf16x8 = __attribute__((ext_vector_type(8))) short;
using s16x4 = __attribute__((ext_vector_type(4))) short;
using f32x16 = __attribute__((ext_vector_type(16))) float;
using u32x4 = __attribute__((ext_vector_type(4))) unsigned;
typedef unsigned short bf16_t;
constexpr int SEQ = 8192, NW = 8, QBLK = 32, QB = QBLK * NW, KVBLK = 64, NTILE = SEQ / KVBLK, PITCH = 512;
constexpr int KSLOT = 8192, VSLOT = 16384;
constexpr int LDS_K = 0, LDS_V = 3 * KSLOT, LDS_WS = LDS_V + 3 * VSLOT, LDS_OST = LDS_WS + NW * 256, LDS_BYTES = LDS_OST + NW * 8192;
#define SBAR() __builtin_amdgcn_sched_barrier(0)
#define PIN(x) asm volatile("" : "+v"(x))
#define MFMA32(a, b, c) __builtin_amdgcn_mfma_f32_32x32x16_bf16(a, b, c, 0, 0, 0)
#define WAIT_BAR(N) asm volatile("s_waitcnt vmcnt(" #N ") lgkmcnt(0)\n\ts_barrier" ::: "memory")
__device__ __forceinline__ constexpr int crow0(int r) { return (r & 3) + 8 * (r >> 2); }
__device__ __forceinline__ void glds16(const void* g, unsigned lds_base) {
    unsigned sv; asm volatile("s_mov_b32 %0, m0\n\ts_mov_b32 m0, %2\n\ts_nop 0\n\tglobal_load_lds_dwordx4 %1, off\n\ts_mov_b32 m0, %0" : "=&s"(sv) : "v"(g), "s"(lds_base) : "memory"); }
typedef float f32x2_t __attribute__((ext_vector_type(2))); typedef __bf16 bf16x2_t __attribute__((ext_vector_type(2)));
__device__ __forceinline__ unsigned cvtpk(float lo, float hi) { f32x2_t v = {lo, hi}; bf16x2_t b = __builtin_convertvector(v, bf16x2_t); return __builtin_bit_cast(unsigned, b); }
typedef __attribute__((address_space(3))) const char* lds_cptr;
typedef short v4i16_t __attribute__((ext_vector_type(4)));
__device__ __forceinline__ bf16x8 kld(lds_cptr p) { return *(const __attribute__((address_space(3))) bf16x8*)p; }
__device__ __forceinline__ s16x4 vtr(lds_cptr p) { return __builtin_bit_cast(s16x4, __builtin_amdgcn_ds_read_tr16_b64_v4i16((__attribute__((address_space(3))) v4i16_t*)p)); }
#define MX3(a, b, c) __builtin_fmaxf(__builtin_fmaxf((a), (b)), (c))
__device__ __forceinline__ float rowmax(const f32x16& p0, const f32x16& p1) {
    float a = MX3(p0[0], p0[1], p1[0]), b = MX3(p0[2], p0[3], p1[1]); a = MX3(a, p1[2], p1[3]);
#pragma unroll
    for (int r = 4; r < 16; r += 4) { a = MX3(a, p0[r], p0[r + 1]); b = MX3(b, p0[r + 2], p0[r + 3]); a = MX3(a, p1[r], p1[r + 1]); b = MX3(b, p1[r + 2], p1[r + 3]); }
    float m = __builtin_fmaxf(a, b); auto rr = __builtin_amdgcn_permlane32_swap(__float_as_uint(m), __float_as_uint(m), false, false);
    return __builtin_fmaxf(__uint_as_float(rr[0]), __uint_as_float(rr[1])); }
__device__ __forceinline__ float bf2f(short s) { return __uint_as_float(((unsigned)(unsigned short)s) << 16); }
__device__ __forceinline__ void build_c(f32x16& C, int side, float dj, float sg2, float mhat) {
    if (side == 0) {
#pragma unroll
        for (int r = 0; r < 16; ++r) C[r] = __builtin_fmaf(-sg2, __builtin_fabsf(dj + (float)crow0(r)), -mhat);
    } else {
        const float ss = (side > 0) ? -sg2 : sg2, cl = __builtin_fmaf(ss, dj, -mhat);
#pragma unroll
        for (int r = 0; r < 16; ++r) C[r] = __builtin_fmaf(ss, (float)crow0(r), cl);
    }
}

constexpr float SKIP_T = 150.0f;
constexpr float NOMAX_SPAN = 100.0f;
template <int THRL, bool NOMAX>
__device__ __forceinline__ void attn_body(int b, int h, int c, int qb, int tlo, int thi, float sg2, float mhat, const bf16x8 (&qr)[4], const bf16_t* __restrict__ K, const bf16_t* __restrict__ V, bf16_t* AO, char* lds);

template <int THRL>
__device__ __forceinline__ void attn_unit(int b, int h, int c, int qb, float sg2, const bf16_t* Q, const bf16_t* __restrict__ K, const bf16_t* __restrict__ V, bf16_t* AO, const unsigned* kb2, char* lds) {
    const int tid = threadIdx.x, lane = tid & 63, r32 = lane & 31, hi = lane >> 5; const int wid = __builtin_amdgcn_readfirstlane(tid >> 6);
    const long rowbase = (long)b * SEQ; const int q0 = qb * QB, iw0 = q0 + wid * QBLK;
    const bf16_t* Qw = Q + (rowbase + iw0) * PITCH + h * 128 + c * 64;
    const bf16_t* Kh = K + rowbase * PITCH + h * 128 + c * 64; const bf16_t* Vh = V + rowbase * PITCH + h * 128;
    const unsigned lds0 = (unsigned)(uintptr_t)lds; float* wsf = (float*)(lds + LDS_WS) + wid * 64;
    bf16x8 qr[4];
#pragma unroll
    for (int d0 = 0; d0 < 4; ++d0) qr[d0] = *reinterpret_cast<const bf16x8*>(&Qw[(long)r32 * PITCH + d0 * 16 + hi * 8]);
    float mhat; int tlo, thi;
    { const bf16_t* Kd = Kh + (long)(iw0 + r32) * PITCH; float s = 0.f, na = 0.f, nb = 0.f;
#pragma unroll
      for (int d0 = 0; d0 < 4; ++d0) { const bf16x8 kk = *reinterpret_cast<const bf16x8*>(&Kd[d0 * 16 + hi * 8]);
#pragma unroll
          for (int j = 0; j < 8; ++j) { const float qv = bf2f(qr[d0][j]); s = __builtin_fmaf(qv, bf2f(kk[j]), s); if (d0 < 2) na = __builtin_fmaf(qv, qv, na); else nb = __builtin_fmaf(qv, qv, nb); } }
      auto rr = __builtin_amdgcn_permlane32_swap(__float_as_uint(s), __float_as_uint(s), false, false); mhat = __uint_as_float(rr[0]) + __uint_as_float(rr[1]);
      auto ra = __builtin_amdgcn_permlane32_swap(__float_as_uint(na), __float_as_uint(na), false, false); na = __uint_as_float(ra[0]) + __uint_as_float(ra[1]);
      auto rb = __builtin_amdgcn_permlane32_swap(__float_as_uint(nb), __float_as_uint(nb), false, false); nb = __uint_as_float(rb[0]) + __uint_as_float(rb[1]);
      float qn = (sqrtf(na) + sqrtf(nb)) * 1.001f, sm = mhat; const float qrow = qn;
#pragma unroll
      for (int o_ = 1; o_ < 32; o_ <<= 1) { qn = __builtin_fmaxf(qn, __shfl_xor(qn, o_)); sm = __builtin_fminf(sm, __shfl_xor(sm, o_)); }
      if (lane == 0) { wsf[48] = qn; wsf[49] = sm; }
      asm volatile("s_waitcnt lgkmcnt(0)\n\ts_barrier" ::: "memory");
      { const float* wsa = (const float*)(lds + LDS_WS);
#pragma unroll
        for (int w = 0; w < NW; ++w) { qn = __builtin_fmaxf(qn, wsa[w * 64 + 48]); sm = __builtin_fminf(sm, wsa[w * 64 + 49]); } }
      int lo_ = NTILE, hi_ = -1; float kmg = 0.f;
#pragma unroll
      for (int half = 0; half < 2; ++half) { const int J = lane + 64 * half; const float km = sqrtf(__uint_as_float(kb2[J * 8 + h * 2 + c])) * 1.01f;
          const int dl_ = q0 - (J * KVBLK + KVBLK - 1), dr_ = J * KVBLK - (q0 + QB - 1); const float dmin = (float)(dl_ > 0 ? dl_ : (dr_ > 0 ? dr_ : 0));
          const bool need = (qn * km - sg2 * dmin - sm >= -SKIP_T) || (dl_ <= 0 && dr_ <= 0);
          kmg = __builtin_fmaxf(kmg, km);
          if (need) { lo_ = lo_ < J ? lo_ : J; hi_ = hi_ > J ? hi_ : J; } }
#pragma unroll
      for (int o_ = 1; o_ < 64; o_ <<= 1) { const int l2 = __shfl_xor(lo_, o_), h2 = __shfl_xor(hi_, o_); lo_ = lo_ < l2 ? lo_ : l2; hi_ = hi_ > h2 ? hi_ : h2; kmg = __builtin_fmaxf(kmg, __shfl_xor(kmg, o_)); }
      tlo = __builtin_amdgcn_readfirstlane(lo_); thi = __builtin_amdgcn_readfirstlane(hi_);
      const bool fixedref = __builtin_amdgcn_readfirstlane((qn * kmg - sm <= NOMAX_SPAN) ? 1 : 0) != 0;
      if (fixedref) attn_body<THRL, true>(b, h, c, qb, tlo, thi, sg2, qrow * kmg, qr, K, V, AO, lds);
      else attn_body<THRL, false>(b, h, c, qb, tlo, thi, sg2, mhat, qr, K, V, AO, lds); }
}

template <int THRL, bool NOMAX>
__device__ __forceinline__ void attn_body(int b, int h, int c, int qb, int tlo, int thi, float sg2, float mhat, const bf16x8 (&qr)[4], const bf16_t* __restrict__ K, const bf16_t* __restrict__ V, bf16_t* AO, char* lds) {
    const int tid = threadIdx.x, lane = tid & 63, r32 = lane & 31, hi = lane >> 5; const int wid = __builtin_amdgcn_readfirstlane(tid >> 6);
    const long rowbase = (long)b * SEQ; const int q0 = qb * QB, iw0 = q0 + wid * QBLK;
    const bf16_t* Kh = K + rowbase * PITCH + h * 128 + c * 64; const bf16_t* Vh = V + rowbase * PITCH + h * 128;
    const unsigned lds0 = (unsigned)(uintptr_t)lds; float* wsf = (float*)(lds + LDS_WS) + wid * 64;
    const int n = thi - tlo + 1;
    const bf16_t* ksrc = Kh + (long)tlo * KVBLK * PITCH + (long)lane * PITCH + wid * 8;
    const bf16_t* vsrc = Vh + (long)tlo * KVBLK * PITCH + (long)(32 * (wid & 1) + (lane >> 2)) * PITCH + (wid >> 1) * 32 + (lane & 3) * 8;
    const unsigned kdst = lds0 + LDS_K + wid * 1024, vdst = lds0 + LDS_V + wid * 2048;
#define DMA_K(s, slot) glds16(ksrc + (long)(s) * KVBLK * PITCH, (unsigned)__builtin_amdgcn_readfirstlane(kdst + (slot) * KSLOT))
#define DMA_V(s, slot) do { glds16(vsrc + (long)(s) * KVBLK * PITCH, (unsigned)__builtin_amdgcn_readfirstlane(vdst + (slot) * VSLOT)); \
                            glds16(vsrc + (long)(s) * KVBLK * PITCH + 16 * PITCH, (unsigned)__builtin_amdgcn_readfirstlane(vdst + (slot) * VSLOT + 1024)); } while (0)
    const lds_cptr vp0 = (lds_cptr)lds + LDS_V + ((lane >> 4) & 1) * 32 + (lane & 3) * 8 + (4 * hi + ((lane & 15) >> 2)) * 64;
    const lds_cptr kp0 = (lds_cptr)lds + LDS_K + hi * 1024 + r32 * 16;
    DMA_K(0, 0); DMA_V(0, 0); DMA_K(1, 1); DMA_K(2, 2);
    float l_reg = 0.f; f32x16 o[4]; o[0] = f32x16{}; o[1] = f32x16{}; o[2] = f32x16{}; o[3] = f32x16{};
    const float fi = (float)(4 * hi - (iw0 + r32));
    bool resc = false;
    f32x16 C0, C1; bf16x8 kf[8]; u32x4 pw0, pw1, pw2, pw3;
    pw0 = u32x4{}; pw1 = u32x4{}; pw2 = u32x4{}; pw3 = u32x4{};
    int s_prev = 0, s_cur = 0, s_next = 1;
#define ROT() do { s_prev = s_cur; s_cur = s_next; s_next = (s_next == 2) ? 0 : s_next + 1; } while (0)
#define EX(v) __builtin_amdgcn_exp2f(v)
#define RESC() do { if constexpr (!NOMAX) if (resc) { asm volatile("s_waitcnt lgkmcnt(0)" ::: "memory"); _Pragma("unroll") for (int d_ = 0; d_ < 4; ++d_) _Pragma("unroll") for (int r = 0; r < 16; ++r) o[d_][r] *= wsf[crow0(r) + 4 * hi]; } } while (0)
    asm volatile("s_waitcnt vmcnt(0) lgkmcnt(0)\n\ts_barrier" ::: "memory");
#pragma unroll
    for (int f = 0; f < 8; ++f) kf[f] = kld(kp0 + (f >> 1) * 2048 + (f & 1) * 512);
    asm volatile("s_waitcnt lgkmcnt(0)\n\ts_barrier" ::: "memory");
#define PKW(P, i) cvtpk(P[i], P[i + 1])
#define PAF(k) __builtin_bit_cast(bf16x8, pw##k)
#define VFRG(lo, hi_) (bf16x8){lo[0], lo[1], lo[2], lo[3], hi_[0], hi_[1], hi_[2], hi_[3]}
#define VRD(f) do { vlo[f] = vtr(vp_ + (((f) & 3) * 4096 + ((f) >> 2) * 1024)); vhi[f] = vtr(vp_ + (((f) & 3) * 4096 + ((f) >> 2) * 1024 + 512)); } while (0)
#define STEP(s, FIRST, GK, GV, GL) do { SBAR(); \
    const int jt_ = (tlo + (s)) * KVBLK; const lds_cptr vp_ = vp0 + s_prev * VSLOT; s16x4 vlo[16], vhi[16]; \
    { const int d0_ = jt_ - iw0, d1_ = jt_ + 32 - iw0; \
      build_c(C0, (d0_ > 0) - (d0_ < 0), (float)jt_ + fi, sg2, mhat); build_c(C1, (d1_ > 0) - (d1_ < 0), (float)(jt_ + 32) + fi, sg2, mhat); } \
    if (!(FIRST)) { VRD(0); VRD(1); } SBAR(); \
    C0 = MFMA32(kf[0], qr[0], C0); C1 = MFMA32(kf[1], qr[0], C1); SBAR(); \
    if (!(FIRST)) { VRD(2); VRD(3); } SBAR(); \
    C0 = MFMA32(kf[2], qr[1], C0); C1 = MFMA32(kf[3], qr[1], C1); SBAR(); \
    C0 = MFMA32(kf[4], qr[2], C0); C1 = MFMA32(kf[5], qr[2], C1); SBAR(); \
    C0 = MFMA32(kf[6], qr[3], C0); C1 = MFMA32(kf[7], qr[3], C1); SBAR(); \
    if (GK) DMA_K((s) + 3, s_cur); if (GV) DMA_V((s) + 1, s_next); \
    if constexpr (!NOMAX) { const float rm = rowmax(C0, C1); resc = false; \
      if (__builtin_expect(__any(rm > (float)THRL), 0)) { const float dl = __builtin_fmaxf(rm, 0.f); mhat += dl; \
          _Pragma("unroll") for (int r = 0; r < 16; ++r) { C0[r] -= dl; C1[r] -= dl; } \
          const float f = EX(-dl); l_reg *= f; if (hi == 0) wsf[r32] = f; resc = true; } } \
    SBAR(); \
    float sacc = 0.f; u32x4 nw0, nw1, nw2, nw3; \
    _Pragma("unroll") for (int g = 0; g < 16; ++g) { \
        if (!(FIRST)) { const int ks_ = g >> 2, db_ = g & 3; \
            if (g + 4 < 16) { VRD(g + 4); } \
            const bf16x8 pa_ = (ks_ == 0) ? PAF(0) : (ks_ == 1) ? PAF(1) : (ks_ == 2) ? PAF(2) : PAF(3); \
            o[db_] = MFMA32(pa_, VFRG(vlo[g], vhi[g]), o[db_]); } \
        if (GL) { if (g >= 4 && g < 12) { kf[g - 4] = kld(kp0 + s_next * KSLOT + ((g - 4) >> 1) * 2048 + ((g - 4) & 1) * 512); } } \
        if (g < 8) { C0[2 * g] = EX(C0[2 * g]); C0[2 * g + 1] = EX(C0[2 * g + 1]); sacc += C0[2 * g]; sacc += C0[2 * g + 1]; } \
        else { C1[2 * g - 16] = EX(C1[2 * g - 16]); C1[2 * g - 15] = EX(C1[2 * g - 15]); sacc += C1[2 * g - 16]; sacc += C1[2 * g - 15]; } \
        if (g == 0) nw0[0] = PKW(C0, 0); if (g == 1) nw0[1] = PKW(C0, 2); if (g == 2) nw0[2] = PKW(C0, 4); if (g == 3) nw0[3] = PKW(C0, 6); \
        if (g == 4) nw1[0] = PKW(C0, 8); if (g == 5) nw1[1] = PKW(C0, 10); if (g == 6) nw1[2] = PKW(C0, 12); if (g == 7) nw1[3] = PKW(C0, 14); \
        if (g == 8) nw2[0] = PKW(C1, 0); if (g == 9) nw2[1] = PKW(C1, 2); if (g == 10) nw2[2] = PKW(C1, 4); if (g == 11) nw2[3] = PKW(C1, 6); \
        if (g == 12) nw3[0] = PKW(C1, 8); if (g == 13) nw3[1] = PKW(C1, 10); if (g == 14) nw3[2] = PKW(C1, 12); if (g == 15) nw3[3] = PKW(C1, 14); \
        PIN(sacc); SBAR(); } \
    l_reg += sacc; pw0 = nw0; pw1 = nw1; pw2 = nw2; pw3 = nw3; \
    } while (0)
    STEP(0, true, true, true, true); WAIT_BAR(3); RESC(); ROT();
    int s = 1;
    for (; s + 3 < n; ++s) { STEP(s, false, true, true, true); WAIT_BAR(3); RESC(); ROT(); }
    STEP(s, false, false, true, true); WAIT_BAR(2); RESC(); ROT(); ++s;
    STEP(s, false, false, true, true); WAIT_BAR(2); RESC(); ROT(); ++s;
    STEP(s, false, false, false, false); WAIT_BAR(0); RESC(); ROT();
    { const lds_cptr vp_ = vp0 + s_prev * VSLOT; s16x4 vlo[16], vhi[16];
#pragma unroll
      for (int g = 0; g < 16; ++g) VRD(g);
#pragma unroll
      for (int g = 0; g < 16; ++g) { const int ks_ = g >> 2, db_ = g & 3; const bf16x8 pa_ = (ks_ == 0) ? PAF(0) : (ks_ == 1) ? PAF(1) : (ks_ == 2) ? PAF(2) : PAF(3);
          o[db_] = MFMA32(pa_, VFRG(vlo[g], vhi[g]), o[db_]); } }
    { auto rr = __builtin_amdgcn_permlane32_swap(__float_as_uint(l_reg), __float_as_uint(l_reg), false, false); l_reg = __uint_as_float(rr[0]) + __uint_as_float(rr[1]); }
    if (hi == 0) wsf[32 + r32] = l_reg; asm volatile("s_waitcnt lgkmcnt(0)" ::: "memory");
    float rli[16];
#pragma unroll
    for (int r = 0; r < 16; ++r) rli[r] = __builtin_amdgcn_rcpf(wsf[32 + crow0(r) + 4 * hi]);
    bf16_t* Ow = AO + (rowbase + iw0) * PITCH + h * 128; __hip_bfloat16* stg = (__hip_bfloat16*)(lds + LDS_OST) + wid * 4096;
#pragma unroll
    for (int r = 0; r < 16; ++r) { const int orow = crow0(r) + 4 * hi;
#pragma unroll
        for (int db = 0; db < 4; ++db) stg[orow * 128 + db * 32 + r32] = __float2bfloat16(o[db][r] * rli[r]); }
    asm volatile("s_waitcnt lgkmcnt(0)" ::: "memory");
#pragma unroll
    for (int i = 0; i < 8; ++i) { const int row = i * 4 + (lane >> 4), ch = lane & 15; *(u32x4*)(Ow + (long)row * PITCH + ch * 8) = *(const u32x4*)(stg + row * 128 + ch * 8); }
    asm volatile("s_waitcnt lgkmcnt(0)\n\ts_barrier" ::: "memory");
#undef DMA_K
#undef DMA_V
#undef ROT
#undef EX
#undef RESC
#undef PKW
#undef PAF
#undef VFRG
#undef VRD
#undef STEP
}
#undef SBAR
#undef PIN
#undef MFMA32
#undef WAIT_BAR
#undef MX3
}
constexpr int NWAVES = 8;
constexpr int BATCH = 2, SEQ = 8192, DM = 1024, T = BATCH * SEQ, NEXP = 32, DEXP = 512;
constexpr float EPS = 1e-6f, LAM_INIT = 0.2f;
constexpr float C2 = 0.125f * 1.4426950408889634f;
constexpr float LOG2E = 1.4426950408889634f;
constexpr int ATT_THR = 8;

constexpr size_t MiB = 1u << 20;
constexpr size_t WS_CTL = 0, CTL_ZERO_BYTES = 65536;
constexpr size_t WS_LIST = 1 * MiB, WS_GLIST = 3 * MiB, WS_EPOS = 5 * MiB;
constexpr size_t WS_WIN = 6 * MiB, WS_WOUT = 10 * MiB, WS_WGU = 12 * MiB, WS_WD = 76 * MiB;
constexpr size_t WS_QKVU = 108 * MiB;
constexpr size_t WS_XN2 = 108 * MiB;
constexpr size_t WS_Y = 108 * MiB;
constexpr size_t WS_XN1 = 172 * MiB;
constexpr size_t WS_MIX = 172 * MiB;
constexpr size_t WS_AO = 204 * MiB;
constexpr size_t WS_HDN = 204 * MiB;
constexpr size_t WS_END = 244 * MiB;
constexpr int MAXROWS = 40960;
constexpr int CW_CNT = 64;
constexpr int CW_BAR = 4096;
constexpr int CW_QUEUE = 3968;
constexpr int CW_KMAX = 8192;
constexpr int LDS_BYTES = 163840;
constexpr int MISC_OFF = LDS_BYTES - 256;
constexpr int MOE_TAB_OFF = 131072;
constexpr int RT_WR = 0, RT_SC = 148032, RT_SQ = 160320, RT_SR = 160576, RT_HI = 160832;

#define GAS __attribute__((address_space(1)))
#define LAS __attribute__((address_space(3)))
typedef unsigned short bf16;
typedef unsigned v4u __attribute__((ext_vector_type(4)));
typedef unsigned v2u __attribute__((ext_vector_type(2)));
typedef float f32x4 __attribute__((ext_vector_type(4)));
typedef GAS unsigned gu32;
#define RLX_AGENT __ATOMIC_RELAXED, __HIP_MEMORY_SCOPE_AGENT
#define LDS_WAIT() asm volatile("s_waitcnt lgkmcnt(0)" ::: "memory")
#define VM_WAIT() asm volatile("s_waitcnt vmcnt(0)" ::: "memory")
__device__ __forceinline__ unsigned f2bf(float f) { unsigned u = __builtin_bit_cast(unsigned, f); return (u + 0x7fffu + ((u >> 16) & 1u)) >> 16; }
__device__ __forceinline__ unsigned pk2(float lo, float hi) { return f2bf(lo) | (f2bf(hi) << 16); }
__device__ __forceinline__ float bflo(unsigned w) { return __uint_as_float(w << 16); }
__device__ __forceinline__ float bfhi(unsigned w) { return __uint_as_float(w & 0xffff0000u); }

#define XB_TMO      128
#define XB_XCNT(j)  (256  + 64 * (j))
#define XB_XSUB(j)  (1280 + 64 * (j))
#define XB_XGEN(j)  (2304 + 64 * (j))
#define XB_TOP      3328
#define XB_TOPGEN   3392
#define XCD_BAR_WORDS 3456
#define XB_SPIN_CAP (1u << 18)
__device__ __forceinline__ unsigned xb_ld(unsigned* p)              { return __hip_atomic_load(p, __ATOMIC_RELAXED, __HIP_MEMORY_SCOPE_AGENT); }
__device__ __forceinline__ unsigned xb_add(unsigned* p, unsigned v) { return __hip_atomic_fetch_add(p, v, __ATOMIC_RELAXED, __HIP_MEMORY_SCOPE_AGENT); }
__device__ __forceinline__ unsigned xb_xcc_id() { return (unsigned)__builtin_amdgcn_s_getreg((3 << 11) | 20) & 0xFu; }
#define XB_SPIN(cond, bar) do { unsigned _sp = 0; while (cond) { __builtin_amdgcn_s_sleep(1); \
    if ((++_sp & 255u) == 0u) { if (xb_ld(&(bar)[XB_TMO])) break; if (_sp > XB_SPIN_CAP) { atomicAdd(&(bar)[XB_TMO], 1u); break; } } } } while (0)
struct XcdBarrier { unsigned* bar; unsigned x; volatile LAS unsigned* st; };
__device__ __forceinline__ XcdBarrier xcd_barrier_post(unsigned* bar, volatile LAS unsigned* st) {
    XcdBarrier b; b.bar = bar; b.x = xb_xcc_id(); b.st = st;
    if (threadIdx.x == 0) (void)xb_add(&bar[XB_XCNT(b.x)], 1u);
    return b;
}
__device__ __forceinline__ void xcd_barrier_complete(unsigned* bar, unsigned x, unsigned& nloc, unsigned& nx) {
    const unsigned G = gridDim.x * gridDim.y * gridDim.z;
    unsigned sum, cnt, mine, sp = 0u;
    for (;;) {
        sum = 0u; cnt = 0u; mine = 0u;
#pragma unroll
        for (unsigned j = 0; j < 16; ++j) { const unsigned c = xb_ld(&bar[XB_XCNT(j)]); sum += c; cnt += (c > 0u) ? 1u : 0u; mine = (j == x) ? c : mine; }
        if (sum == G) break;
        __builtin_amdgcn_s_sleep(1);
        if ((++sp & 255u) == 0u) { if (xb_ld(&bar[XB_TMO])) break; if (sp > XB_SPIN_CAP) { atomicAdd(&bar[XB_TMO], 1u); break; } }
    }
    nloc = mine > 0u ? mine : 1u; nx = cnt > 0u ? cnt : 1u;
}
__device__ __forceinline__ void xcd_barrier(const XcdBarrier& b) {
    asm volatile("s_waitcnt vmcnt(0)" ::: "memory");
    __syncthreads();
    if (threadIdx.x == 0) {
        unsigned* bar = b.bar;
        __builtin_amdgcn_s_waitcnt(0);
        unsigned nloc = b.st[0], nx = b.st[1];
        if (nloc == 0u) { xcd_barrier_complete(bar, b.x, nloc, nx); b.st[0] = nloc; b.st[1] = nx; }
        const unsigned old = xb_add(&bar[XB_XSUB(b.x)], 1u);
        const unsigned gen = old / nloc;
        if (old + 1u == (gen + 1u) * nloc) {
            __builtin_amdgcn_fence(__ATOMIC_RELEASE, "agent");
            asm volatile("s_waitcnt vmcnt(0)" ::: "memory");
            const unsigned og = xb_add(&bar[XB_TOP], 1u);
            const unsigned tg = og / nx;
            if (og + 1u == (tg + 1u) * nx) xb_add(&bar[XB_TOPGEN], 1u);
            else XB_SPIN(xb_ld(&bar[XB_TOPGEN]) == tg, bar);
            __builtin_amdgcn_fence(__ATOMIC_ACQUIRE, "agent");
            xb_add(&bar[XB_XGEN(b.x)], 1u);
            asm volatile("s_waitcnt vmcnt(0)" ::: "memory");
        } else {
            XB_SPIN(xb_ld(&bar[XB_XGEN(b.x)]) == gen, bar);
            __builtin_amdgcn_fence(__ATOMIC_ACQUIRE, "agent");
            asm volatile("s_waitcnt vmcnt(0)" ::: "memory");
        }
    }
    __syncthreads();
}

__device__ __forceinline__ float wave_sum(float v) {
#pragma unroll
    for (int o = 1; o < 64; o <<= 1) v += __shfl_xor(v, o);
    return v;
}
struct TrItem { const float* src; int ldw; bf16* dst; size_t opitch; };
__device__ __forceinline__ void tr_load(const TrItem& I, float (&v)[32], int lane) {
#pragma unroll
    for (int i = 0; i < 32; ++i) v[i] = I.src[(size_t)(2 * i + (lane >> 5)) * I.ldw + (lane & 31)];
}
__device__ __forceinline__ void tr_finish(const TrItem& I, const float (&v)[32], LAS float* scr, int lane) {
#pragma unroll
    for (int i = 0; i < 32; ++i) scr[(2 * i + (lane >> 5)) * 33 + (lane & 31)] = v[i];
    LDS_WAIT(); asm volatile("" ::: "memory");
    const int c = lane & 7;
#pragma unroll
    for (int j = 0; j < 4; ++j) { const int n = (lane >> 3) + 8 * j; const LAS float* sp = scr + (8 * c) * 33 + n;
        v4u o; o.x = pk2(sp[0 * 33], sp[1 * 33]); o.y = pk2(sp[2 * 33], sp[3 * 33]); o.z = pk2(sp[4 * 33], sp[5 * 33]); o.w = pk2(sp[6 * 33], sp[7 * 33]);
        *(GAS v4u*)(I.dst + (size_t)n * I.opitch + 8 * c) = o; }
    LDS_WAIT(); asm volatile("" ::: "memory");
}
template <int NR> __device__ __forceinline__ void rms_rows_to_bf16(const float* x, const float* g, bf16* o, int m0, int stride, int mend, int lane) {
    f32x4 v[NR][4];
#pragma unroll
    for (int k = 0; k < NR; ++k) { const int m = m0 + k * stride; const GAS f32x4* xr = (const GAS f32x4*)(x + (size_t)(m < mend ? m : m0) * DM) + lane;
#pragma unroll
        for (int j = 0; j < 4; ++j) v[k][j] = xr[64 * j]; }
    const GAS f32x4* gr = (const GAS f32x4*)g + lane; f32x4 gg[4];
#pragma unroll
    for (int j = 0; j < 4; ++j) gg[j] = gr[64 * j];
#pragma unroll
    for (int k = 0; k < NR; ++k) { const int m = m0 + k * stride; float s = 0.f;
#pragma unroll
        for (int j = 0; j < 4; ++j) s += (v[k][j].x * v[k][j].x + v[k][j].y * v[k][j].y) + (v[k][j].z * v[k][j].z + v[k][j].w * v[k][j].w);
        const float rstd = 1.0f / sqrtf(wave_sum(s) * (1.f / DM) + EPS);
        if (m < mend) { GAS v2u* o8 = (GAS v2u*)(o + (size_t)m * DM) + lane;
#pragma unroll
            for (int j = 0; j < 4; ++j) { v2u w; w.x = pk2(v[k][j].x * rstd * gg[j].x, v[k][j].y * rstd * gg[j].y); w.y = pk2(v[k][j].z * rstd * gg[j].z, v[k][j].w * rstd * gg[j].w); o8[64 * j] = w; } } }
}

__device__ __forceinline__ TrItem expert_item(int it, const float* wgate, const float* wup, const float* wdown, bf16* Wgu_t, bf16* Wd_t) {
    constexpr int I_G = 16 * 16, I_D = 8 * 32; TrItem I;
    const int e = it / (2 * I_G + I_D); int r = it - e * (2 * I_G + I_D);
    if (r < 2 * I_G) { const int up = r / I_G; r -= up * I_G; const int kb = r / 16, nb = r % 16, n0 = 32 * nb;
        I.src = (up ? wup : wgate) + (size_t)e * 1024 * 512 + (size_t)(64 * kb) * 512 + n0; I.ldw = 512;
        I.dst = Wgu_t + (size_t)e * 1024 * 1024 + (size_t)((n0 >> 7) * 256 + 128 * up + (n0 & 127)) * 1024 + 64 * kb; I.opitch = 1024; return I; }
    r -= 2 * I_G;
    const int kb = r / 32, nb = r % 32; I.src = wdown + (size_t)e * 512 * 1024 + (size_t)(64 * kb) * 1024 + 32 * nb; I.ldw = 1024; I.dst = Wd_t + (size_t)e * 1024 * 512 + (size_t)(32 * nb) * 512 + 64 * kb; I.opitch = 512; return I;
}
constexpr int N_EXPERT_ITEMS = 32 * 768, Q_BATCH = 64, N_Q_BATCHES = N_EXPERT_ITEMS / Q_BATCH;

struct Args { const float* in[20]; float* out; unsigned char* ws; int ph_lo, ph_hi; };

__global__ void __launch_bounds__(NWAVES * 64, 2) mk_fwd(Args args) {
    extern __shared__ __attribute__((aligned(16))) unsigned char lds[];
    LAS unsigned char* L = (LAS unsigned char*)lds;
    volatile LAS unsigned* MISC = (volatile LAS unsigned*)(L + MISC_OFF);
    const int tid = threadIdx.x, lane = tid & 63, wave = __builtin_amdgcn_readfirstlane(tid >> 6);
    const int G = gridDim.x; const int bx = blockIdx.x; const int vcu = (G % 8 == 0) ? (bx % 8) * (G / 8) + bx / 8 : bx;
    unsigned char* ws = args.ws;
    gu32* ctl = (gu32*)(ws + WS_CTL);
    const float* x = args.in[0]; const float* n1g = args.in[1]; const float* w_in = args.in[2];
    const float* lq1 = args.in[3]; const float* lk1 = args.in[4]; const float* lq2 = args.in[5]; const float* lk2 = args.in[6];
    const float* subg = args.in[7]; const float* wpool = args.in[8]; const float* pscale = args.in[9]; const float* w_out = args.in[10];
    const float* n2g = args.in[11]; const float* wgr = args.in[12]; const float* bgr = args.in[13]; const float* wer = args.in[14];
    const float* ber = args.in[15]; const float* wgate = args.in[16]; const float* wup = args.in[17]; const float* wdown = args.in[18]; const float* fing = args.in[19];
    float* out = args.out;
    bf16* Win_t = (bf16*)(ws + WS_WIN); bf16* Wout_t = (bf16*)(ws + WS_WOUT); bf16* Wgu_t = (bf16*)(ws + WS_WGU); bf16* Wd_t = (bf16*)(ws + WS_WD);
    bf16* QKVU = (bf16*)(ws + WS_QKVU); bf16* XN1 = (bf16*)(ws + WS_XN1); bf16* MIX = (bf16*)(ws + WS_MIX); bf16* AO = (bf16*)(ws + WS_AO);
    bf16* XN2 = (bf16*)(ws + WS_XN2); bf16* HDN = (bf16*)(ws + WS_HDN); bf16* Y = (bf16*)(ws + WS_Y);
    int* list = (int*)(ws + WS_LIST); float* glist = (float*)(ws + WS_GLIST); int* epos = (int*)(ws + WS_EPOS);
    for (int u = tid; u < 64; u += NWAVES * 64) ((LAS unsigned*)(L + MISC_OFF))[u] = 0u;
    __syncthreads();
    XcdBarrier bar = xcd_barrier_post((unsigned*)(ctl + CW_BAR), MISC + 8);
    const int lo = args.ph_lo, hi = args.ph_hi;
#define IN(k) (lo <= (k) && (k) < hi)
#define SEAM(k) do { if (IN(k) && IN((k) + 1)) xcd_barrier(bar); } while (0)
    const int gw = vcu * NWAVES + wave, NGW = G * NWAVES;

    if (IN(0)) {
        LAS float* scr = (LAS float*)(L + wave * 16384);
        constexpr int I_WIN = 16 * 64, I_WO = 8 * 32;
        constexpr int NITEMS = I_WIN + I_WO;
        auto decode = [&](int it) -> TrItem { TrItem I; int r = it;
            if (r < I_WIN) { const int kb = r / 64, nb = r % 64; I.src = w_in + (size_t)(64 * kb) * 2048 + 32 * nb; I.ldw = 2048; I.dst = Win_t + (size_t)(32 * nb) * 1024 + 64 * kb; I.opitch = 1024; return I; } r -= I_WIN;
            { const int kb = r / 32, nb = r % 32; I.src = w_out + (size_t)(64 * kb) * 1024 + 32 * nb; I.ldw = 1024; I.dst = Wout_t + (size_t)(32 * nb) * 1024 + 64 * kb; I.opitch = 1024; return I; } };
        { float va[32], vb[32]; int it = gw; TrItem Ia, Ib;
          if (it < NITEMS) { Ia = decode(it); tr_load(Ia, va, lane); }
          while (it < NITEMS) {
              const int itb = it + NGW; if (itb < NITEMS) { Ib = decode(itb); tr_load(Ib, vb, lane); }
              tr_finish(Ia, va, scr, lane);
              if (itb >= NITEMS) break;
              const int itc = itb + NGW; if (itc < NITEMS) { Ia = decode(itc); tr_load(Ia, va, lane); }
              tr_finish(Ib, vb, scr, lane);
              it = itc; } }
        for (int m = gw; m < T; m += 4 * NGW) rms_rows_to_bf16<4>(x, n1g, XN1, m, NGW, T, lane);
        __syncthreads();
        for (int id = bx; id < 256; id += G) {
            const int g = id >> 6, kb = (id >> 4) & 3, nb = id & 15;
            LAS float* WoS = (LAS float*)L; LAS float* wps = (LAS float*)(L + 32768);
            { f32x4 t4[4];
#pragma unroll
              for (int q = 0; q < 4; ++q) { const int f = tid + 512 * q, dd = f >> 4, c4 = (f & 15) * 4; t4[q] = *(const GAS f32x4*)(w_out + (size_t)(512 + g * 128 + dd) * 1024 + nb * 64 + c4); }
              float w8[8], p8[8];
#pragma unroll
              for (int q = 0; q < 8; ++q) { const int f = tid + 512 * q, kk = f >> 7, dd = f & 127; w8[q] = wpool[(size_t)(g * 128 + kb * 32 + kk) * 128 + dd]; p8[q] = pscale[g * 128 + dd]; }
#pragma unroll
              for (int q = 0; q < 4; ++q) { const int f = tid + 512 * q; *(LAS f32x4*)(WoS + (f >> 4) * 64 + (f & 15) * 4) = t4[q]; }
#pragma unroll
              for (int q = 0; q < 8; ++q) { const int f = tid + 512 * q; wps[(f >> 7) * 129 + (f & 127)] = w8[q] * p8[q]; } }
            __syncthreads();
            { const int kk = tid >> 4, c4 = (tid & 15) * 4; f32x4 acc = {0.f, 0.f, 0.f, 0.f};
#pragma unroll 8
              for (int dd = 0; dd < 128; ++dd) { const float w = wps[kk * 129 + dd]; const f32x4 wo = *(const LAS f32x4*)(WoS + dd * 64 + c4); acc = acc + wo * w; }
              bf16* dst = Wout_t + (size_t)(nb * 64 + c4) * 1024 + 512 + g * 128 + kb * 32 + kk;
              dst[0] = (bf16)f2bf(acc.x); dst[1024] = (bf16)f2bf(acc.y); dst[2048] = (bf16)f2bf(acc.z); dst[3072] = (bf16)f2bf(acc.w); }
            __syncthreads();
        }
    }
    SEAM(0);
    if (IN(1)) {
        pg8::Gemm g{XN1, Win_t, T, 2048, DM}; pg8::StaticOrder S; S.init(g, G, bx);
        pg8::EpiBf16 E{QKVU, 512, 512, (size_t)T * 512, C2, (unsigned*)(ctl + CW_KMAX)};
        pg8::gemm_phase<pg8::EpiBf16, pg8::StaticOrder, false>(L, DM, S, E);
    }
    SEAM(1);
    if (IN(2)) {
        const int xg = vcu >> 5, i5 = vcu & 31, b = xg >> 2, ty = (xg >> 1) & 1, qb = 16 * (xg & 1) + (i5 >> 1), c = i5 & 1;
        if (vcu < 256) {
#pragma unroll 1
            for (int u = 0; u < 2; ++u) { const int h = (u == 0) ? (ty ? 2 : 3) : (ty ? 1 : 0);
                const float slope = exp2f(-2.0f * (float)(h + 1)), sg2 = slope * LOG2E;
                attn::attn_unit<ATT_THR>(b, h, c, qb, sg2, QKVU, QKVU + (size_t)T * 512, QKVU + (size_t)2 * T * 512, AO + (size_t)c * T * 512, (const unsigned*)(ctl + CW_KMAX) + (size_t)b * 128 * 8, (char*)lds); }
        }
        { LAS float* scr = (LAS float*)(L + wave * 16384); volatile LAS unsigned* qslot = MISC + 16;
          for (;;) {
              __syncthreads();
              if (tid == 0) qslot[0] = atomicAdd((unsigned*)(ctl + CW_QUEUE), 1u);
              __syncthreads();
              const int batch = (int)qslot[0]; if (batch >= N_Q_BATCHES) break;
              const int it0 = batch * Q_BATCH + wave * 8; float va[32], vb[32]; TrItem Ia, Ib;
              Ia = expert_item(it0, wgate, wup, wdown, Wgu_t, Wd_t); tr_load(Ia, va, lane);
#pragma unroll 1
              for (int k = 0; k < 8; k += 2) {
                  Ib = expert_item(it0 + k + 1, wgate, wup, wdown, Wgu_t, Wd_t); tr_load(Ib, vb, lane);
                  tr_finish(Ia, va, scr, lane);
                  if (k + 2 < 8) { Ia = expert_item(it0 + k + 2, wgate, wup, wdown, Wgu_t, Wd_t); tr_load(Ia, va, lane); }
                  tr_finish(Ib, vb, scr, lane); } } }
    }
    SEAM(2);
    if (IN(3)) {
        float s1 = wave_sum(lq1[lane] * lk1[lane]), s2 = wave_sum(lq2[lane] * lk2[lane]);
        const float lam = expf(s1) - expf(s2) + LAM_INIT;
        const bf16* U = QKVU + (size_t)3 * T * 512;
        float sg[8];
#pragma unroll
        for (int j = 0; j < 8; ++j) sg[j] = subg[(8 * lane + j) & 127] * (1.0f - LAM_INIT);
        for (int t0 = gw * 8; t0 < T; t0 += NGW * 8) {
            v4u a1[8], a2[8], ur[23];
#pragma unroll
            for (int q = 0; q < 8; ++q) { a1[q] = *(const GAS v4u*)(AO + (size_t)(t0 + q) * 512 + 8 * lane); a2[q] = *(const GAS v4u*)(AO + (size_t)(T + t0 + q) * 512 + 8 * lane); }
            const int tt0 = t0 & (SEQ - 1), tb = t0 - tt0;
#pragma unroll
            for (int k = 0; k < 23; ++k) { int j = tt0 - 8 + k; j = j < 0 ? 0 : (j > SEQ - 1 ? SEQ - 1 : j); ur[k] = *(const GAS v4u*)(U + (size_t)(tb + j) * 512 + 8 * lane); }
#pragma unroll
            for (int q = 0; q < 8; ++q) {
                float a[8];
#pragma unroll
                for (int j = 0; j < 4; ++j) { a[2 * j] = bflo(a1[q][j]) - lam * bflo(a2[q][j]); a[2 * j + 1] = bfhi(a1[q][j]) - lam * bfhi(a2[q][j]); }
                float ss = 0.f;
#pragma unroll
                for (int j = 0; j < 8; ++j) ss += a[j] * a[j];
                ss += __shfl_xor(ss, 1); ss += __shfl_xor(ss, 2); ss += __shfl_xor(ss, 4); ss += __shfl_xor(ss, 8);
                const float r = 1.0f / sqrtf(ss * (1.0f / 128.0f) + EPS);
                v4u o; o.x = pk2(a[0] * r * sg[0], a[1] * r * sg[1]); o.y = pk2(a[2] * r * sg[2], a[3] * r * sg[3]); o.z = pk2(a[4] * r * sg[4], a[5] * r * sg[5]); o.w = pk2(a[6] * r * sg[6], a[7] * r * sg[7]);
                *(GAS v4u*)(MIX + (size_t)(t0 + q) * 1024 + 8 * lane) = o;
            }
            const int hw = 1 << (lane >> 4);
#pragma unroll
            for (int q = 0; q < 8; ++q) {
                const int tt = tt0 + q; int jlo = tt - hw, jhi = tt + hw; jlo = jlo < 0 ? 0 : jlo; jhi = jhi > SEQ ? SEQ : jhi;
                float sm[8] = {0.f, 0.f, 0.f, 0.f, 0.f, 0.f, 0.f, 0.f};
#pragma unroll
                for (int k = q; k < q + 16; ++k) { const int j = tt0 - 8 + k; const float wgt = (j >= jlo && j < jhi) ? 1.0f : 0.0f;
#pragma unroll
                    for (int p = 0; p < 4; ++p) { sm[2 * p] = __builtin_fmaf(wgt, bflo(ur[k][p]), sm[2 * p]); sm[2 * p + 1] = __builtin_fmaf(wgt, bfhi(ur[k][p]), sm[2 * p + 1]); } }
                const float ic = 1.0f / (float)(jhi - jlo); const v4u ut = ur[8 + q];
                v4u d; d.x = pk2(sm[0] * ic - bflo(ut[0]), sm[1] * ic - bfhi(ut[0])); d.y = pk2(sm[2] * ic - bflo(ut[1]), sm[3] * ic - bfhi(ut[1]));
                d.z = pk2(sm[4] * ic - bflo(ut[2]), sm[5] * ic - bfhi(ut[2])); d.w = pk2(sm[6] * ic - bflo(ut[3]), sm[7] * ic - bfhi(ut[3]));
                *(GAS v4u*)(MIX + (size_t)(t0 + q) * 1024 + 512 + 8 * lane) = d;
            }
        }
    }
    SEAM(3);
    if (IN(4)) {
        pg8::Gemm g{MIX, Wout_t, T, DM, DM}; pg8::StaticOrder S; S.init(g, G, bx);
        pg8::EpiResF32 E{x, out, DM};
        pg8::gemm_phase<pg8::EpiResF32, pg8::StaticOrder, false>(L, DM, S, E);
    }
    SEAM(4);
    if (IN(5)) {
        LAS float* WR = (LAS float*)(L + RT_WR); LAS float* SC = (LAS float*)(L + RT_SC); LAS float* SQ = (LAS float*)(L + RT_SQ); LAS float* SR = (LAS float*)(L + RT_SR);
        { float wv[8], gv[8];
#pragma unroll
          for (int q = 0; q < 8; ++q) { const int idx = tid + 512 * q; wv[q] = wgr[idx]; gv[q] = n2g[idx >> 2]; }
#pragma unroll
          for (int q = 0; q < 8; ++q) { const int idx = tid + 512 * q; WR[(idx & 3) * 1028 + (idx >> 2)] = wv[q] * gv[q]; }
          for (int base = 0; base < 1024 * 32; base += 512 * 16) { float w16[16], g16[16];
#pragma unroll
              for (int q = 0; q < 16; ++q) { const int idx = base + tid + 512 * q; w16[q] = wer[idx]; g16[q] = n2g[idx >> 5]; }
#pragma unroll
              for (int q = 0; q < 16; ++q) { const int idx = base + tid + 512 * q; WR[(4 + (idx & 31)) * 1028 + (idx >> 5)] = w16[q] * g16[q]; } } }
        LAS unsigned* HI = (LAS unsigned*)(L + RT_HI); LAS unsigned* HB = HI + 32;
        if (tid < 32) HI[tid] = 0u;
        __syncthreads();
        const int gq = wave & 3, kh = wave >> 2, tk = lane & 15, kq = lane >> 4;
        for (int tb = vcu * 64; tb < T; tb += G * 64) {
            const float* hrow = out + (size_t)(tb + 16 * gq + tk) * DM + 512 * kh + 4 * kq;
            f32x4 acc[3] = {{0.f, 0.f, 0.f, 0.f}, {0.f, 0.f, 0.f, 0.f}, {0.f, 0.f, 0.f, 0.f}}; float ssq = 0.f;
            int r_ea = 0, r_eb = 0, r_pa = 0, r_pb = 0; float r_g1 = 0.f, r_g2 = 0.f;
            int nn[3];
#pragma unroll
            for (int nb = 0; nb < 3; ++nb) { const int n = 16 * nb + tk; nn[nb] = (n < 36 ? n : 35) * 1028 + 512 * kh + 4 * kq; }
#pragma unroll 8
            for (int s = 0; s < 32; ++s) {
                const f32x4 hv = *(const GAS f32x4*)(hrow + 16 * s);
                ssq += (hv.x * hv.x + hv.y * hv.y) + (hv.z * hv.z + hv.w * hv.w);
#pragma unroll
                for (int nb = 0; nb < 3; ++nb) { const f32x4 bv = *(const LAS f32x4*)(WR + nn[nb] + 16 * s);
                    acc[nb] = __builtin_amdgcn_mfma_f32_16x16x4f32(hv.x, bv.x, acc[nb], 0, 0, 0); acc[nb] = __builtin_amdgcn_mfma_f32_16x16x4f32(hv.y, bv.y, acc[nb], 0, 0, 0);
                    acc[nb] = __builtin_amdgcn_mfma_f32_16x16x4f32(hv.z, bv.z, acc[nb], 0, 0, 0); acc[nb] = __builtin_amdgcn_mfma_f32_16x16x4f32(hv.w, bv.w, acc[nb], 0, 0, 0); }
            }
            ssq += __shfl_xor(ssq, 16); ssq += __shfl_xor(ssq, 32);
            if (kh == 1) {
#pragma unroll
                for (int nb = 0; nb < 3; ++nb)
#pragma unroll
                    for (int r = 0; r < 4; ++r) SC[gq * 768 + (nb * 4 + r) * 64 + lane] = acc[nb][r];
                if (kq == 0) SQ[gq * 16 + tk] = ssq;
            }
            __syncthreads();
            if (kh == 0) {
#pragma unroll
                for (int nb = 0; nb < 3; ++nb)
#pragma unroll
                    for (int r = 0; r < 4; ++r) acc[nb][r] += SC[gq * 768 + (nb * 4 + r) * 64 + lane];
                const float sq2 = ssq + SQ[gq * 16 + tk];
                LDS_WAIT(); asm volatile("" ::: "memory");
#pragma unroll
                for (int nb = 0; nb < 3; ++nb)
#pragma unroll
                    for (int r = 0; r < 4; ++r) SC[gq * 768 + (4 * kq + r) * 48 + 16 * nb + tk] = acc[nb][r];
                LDS_WAIT(); asm volatile("" ::: "memory");
                if (lane < 16) {
                    const int t = tb + 16 * gq + lane; const float rstd = 1.0f / sqrtf(sq2 * (1.0f / DM) + EPS);
                    SR[gq * 16 + lane] = rstd;
                    const LAS float* lg = SC + gq * 768 + lane * 48;
                    float gl[4];
#pragma unroll
                    for (int g = 0; g < 4; ++g) gl[g] = lg[g] * rstd + bgr[g];
                    int gs = 0; float gm = gl[0];
#pragma unroll
                    for (int g = 1; g < 4; ++g) if (gl[g] > gm) { gm = gl[g]; gs = g; }
                    float den = 0.f;
#pragma unroll
                    for (int g = 0; g < 4; ++g) den += expf(gl[g] - gm);
                    const float pg = 1.0f / den;
                    float e8[8];
#pragma unroll
                    for (int i = 0; i < 8; ++i) e8[i] = lg[4 + gs * 8 + i] * rstd + ber[gs * 8 + i];
                    float v1 = e8[0]; int i1 = 0;
#pragma unroll
                    for (int i = 1; i < 8; ++i) if (e8[i] > v1) { v1 = e8[i]; i1 = i; }
                    float v2 = -3.0e38f; int i2 = 0;
#pragma unroll
                    for (int i = 0; i < 8; ++i) if (i != i1 && e8[i] > v2) { v2 = e8[i]; i2 = i; }
                    const float p2 = expf(v2 - v1), g1 = pg / (1.0f + p2), g2 = pg * p2 / (1.0f + p2);
                    const int ea = gs * 8 + i1, eb = gs * 8 + i2;
                    r_ea = ea; r_eb = eb; r_g1 = g1; r_g2 = g2;
                    r_pa = (int)__hip_atomic_fetch_add((LAS unsigned*)HI + ea, 1u, __ATOMIC_RELAXED, __HIP_MEMORY_SCOPE_WORKGROUP);
                    r_pb = (int)__hip_atomic_fetch_add((LAS unsigned*)HI + eb, 1u, __ATOMIC_RELAXED, __HIP_MEMORY_SCOPE_WORKGROUP);
                }
            }
            __syncthreads();
            if (tid < 32) { const unsigned c = HI[tid]; HB[tid] = c ? atomicAdd((unsigned*)(ctl + CW_CNT + 64 * tid), c) : 0u; }
            __syncthreads();
            if (kh == 0 && lane < 16) { const int t = tb + 16 * gq + lane; const int pa = r_pa + (int)HB[r_ea], pb = r_pb + (int)HB[r_eb];
                list[(size_t)r_ea * 16384 + pa] = t; glist[(size_t)r_ea * 16384 + pa] = r_g1; list[(size_t)r_eb * 16384 + pb] = t; glist[(size_t)r_eb * 16384 + pb] = r_g2;
                epos[t * 2] = (r_ea << 16) | pa; epos[t * 2 + 1] = (r_eb << 16) | pb; }
            if (tid < 32) HI[tid] = 0u;
            { const GAS f32x4* gr = (const GAS f32x4*)n2g + lane; f32x4 gg[4];
#pragma unroll
              for (int j = 0; j < 4; ++j) gg[j] = gr[64 * j];
#pragma unroll
              for (int qb_ = 0; qb_ < 2; ++qb_) { f32x4 v[4][4];
#pragma unroll
                  for (int q = 0; q < 4; ++q) { const GAS f32x4* hr = (const GAS f32x4*)(out + (size_t)(tb + 8 * wave + 4 * qb_ + q) * DM) + lane;
#pragma unroll
                      for (int j = 0; j < 4; ++j) v[q][j] = hr[64 * j]; }
#pragma unroll
                  for (int q = 0; q < 4; ++q) { const int tl = 8 * wave + 4 * qb_ + q; const float rstd = SR[tl]; GAS v2u* o8 = (GAS v2u*)(XN2 + (size_t)(tb + tl) * DM) + lane;
#pragma unroll
                      for (int j = 0; j < 4; ++j) { v2u w; w.x = pk2(v[q][j].x * rstd * gg[j].x, v[q][j].y * rstd * gg[j].y); w.y = pk2(v[q][j].z * rstd * gg[j].z, v[q][j].w * rstd * gg[j].w); o8[64 * j] = w; } } } }
            __syncthreads();
        }
    }
    SEAM(5);
    LAS int* tstart = (LAS int*)(L + MOE_TAB_OFF); LAS int* ecnt = (LAS int*)(L + MOE_TAB_OFF + 256);
    if (IN(6) || IN(7) || IN(8)) {
        if (tid < 32) ecnt[tid] = (int)__hip_atomic_load(ctl + CW_CNT + 64 * tid, RLX_AGENT);
        __syncthreads();
        if (tid == 0) { int a = 0; for (int e = 0; e < 32; ++e) { tstart[e] = a; a += (ecnt[e] + 255) >> 8; } tstart[32] = a; }
        __syncthreads();
    }
    if (IN(6)) {
        pg8::MoeOrder<true> S; S.tstart = tstart; S.cnt = ecnt; S.ntiles = tstart[32]; S.G = G; S.c = vcu; S.A = XN2; S.Bt = Wgu_t; S.a_tstep = 0; S.b_estep = (size_t)1024 * 1024 * 2; S.b_tstep = (size_t)256 * 1024 * 2; S.list = list; S.Kb = 2048;
        pg8::EpiSwiGLU E{HDN};
        pg8::gemm_phase<pg8::EpiSwiGLU, pg8::MoeOrder<true>, true>(L, DM, S, E);
    }
    SEAM(6);
    if (IN(7)) {
        pg8::MoeOrder<false> S; S.tstart = tstart; S.cnt = ecnt; S.ntiles = tstart[32]; S.G = G; S.c = vcu; S.A = HDN; S.Bt = Wd_t; S.a_tstep = (size_t)256 * 512 * 2; S.b_estep = (size_t)1024 * 512 * 2; S.b_tstep = (size_t)256 * 512 * 2; S.list = list; S.Kb = 1024;
        pg8::EpiGateBf16 E{Y, glist};
        pg8::gemm_phase<pg8::EpiGateBf16, pg8::MoeOrder<false>, false>(L, DEXP, S, E);
    }
    SEAM(7);
    if (IN(8)) {
        const GAS f32x4* gr = (const GAS f32x4*)fing + lane; f32x4 gg[4];
#pragma unroll
        for (int j = 0; j < 4; ++j) gg[j] = gr[64 * j];
        for (int t0 = gw; t0 < T; t0 += 4 * NGW) {
            int pa[4], pb[4];
#pragma unroll
            for (int q = 0; q < 4; ++q) { const int t = t0 + q * NGW; pa[q] = epos[(t < T ? t : t0) * 2]; pb[q] = epos[(t < T ? t : t0) * 2 + 1]; }
            f32x4 v[4][4]; v2u ya[4][4], yb[4][4];
#pragma unroll
            for (int q = 0; q < 4; ++q) { const int t = (t0 + q * NGW < T) ? t0 + q * NGW : t0;
                const size_t ra = (size_t)tstart[pa[q] >> 16] * 256 + (pa[q] & 0xffff), rb = (size_t)tstart[pb[q] >> 16] * 256 + (pb[q] & 0xffff);
                const GAS f32x4* hr = (const GAS f32x4*)(out + (size_t)t * DM) + lane; const GAS v2u* pya = (const GAS v2u*)(Y + ra * 1024) + lane; const GAS v2u* pyb = (const GAS v2u*)(Y + rb * 1024) + lane;
#pragma unroll
                for (int j = 0; j < 4; ++j) { v[q][j] = hr[64 * j]; ya[q][j] = pya[64 * j]; yb[q][j] = pyb[64 * j]; } }
#pragma unroll
            for (int q = 0; q < 4; ++q) { const int t = t0 + q * NGW; float s = 0.f;
#pragma unroll
                for (int j = 0; j < 4; ++j) { const v2u a = ya[q][j], bq = yb[q][j];
                    v[q][j].x += bflo(a.x) + bflo(bq.x); v[q][j].y += bfhi(a.x) + bfhi(bq.x); v[q][j].z += bflo(a.y) + bflo(bq.y); v[q][j].w += bfhi(a.y) + bfhi(bq.y);
                    s += (v[q][j].x * v[q][j].x + v[q][j].y * v[q][j].y) + (v[q][j].z * v[q][j].z + v[q][j].w * v[q][j].w); }
                const float rstd = 1.0f / sqrtf(wave_sum(s) * (1.f / DM) + EPS);
                if (t < T) { GAS f32x4* orow = (GAS f32x4*)(out + (size_t)t * DM) + lane;
#pragma unroll
                    for (int j = 0; j < 4; ++j) orow[64 * j] = v[q][j] * rstd * gg[j]; } }
        }
    }
#undef IN
#undef SEAM
}

extern "C" void kernel_launch(void* const* d_in, const int* in_sizes, int n_in, void* d_out, int out_size, void* d_ws, size_t ws_size, hipStream_t stream) {
    static int grid = 0;
    if (grid == 0) {
        if (n_in != 20 || in_sizes[0] != T * DM || out_size != T * DM || ws_size < WS_END) { fprintf(stderr, "kernel_launch: unexpected shapes: n_in %d in0 %d out %d ws %zu; nothing launched\n", n_in, n_in > 0 ? in_sizes[0] : -1, out_size, ws_size); grid = -1; return; }
        int dev = 0, cus = 0;
        if (hipGetDevice(&dev) != hipSuccess || hipDeviceGetAttribute(&cus, hipDeviceAttributeMultiprocessorCount, dev) != hipSuccess) { grid = -1; return; }
        if (hipFuncSetAttribute((const void*)mk_fwd, hipFuncAttributeMaxDynamicSharedMemorySize, LDS_BYTES) != hipSuccess) { fprintf(stderr, "kernel_launch: hipFuncSetAttribute failed\n"); grid = -1; return; }
        (void)hipGetLastError();
        grid = cus;
    }
    if (grid < 0) return;
    (void)hipMemsetAsync((char*)d_ws + WS_CTL, 0, CTL_ZERO_BYTES, stream);
    Args a{};
    for (int i = 0; i < 20; ++i) a.in[i] = (const float*)d_in[i];
    a.out = (float*)d_out; a.ws = (unsigned char*)d_ws;
#ifndef MK_N_LAUNCHES
#define MK_N_LAUNCHES 1
#endif
    constexpr int NPH = 9;
    if (MK_N_LAUNCHES == 1) { a.ph_lo = 0; a.ph_hi = NPH; hipLaunchKernelGGL(mk_fwd, dim3(grid), dim3(NWAVES * 64), LDS_BYTES, stream, a); }
    else for (int p = 0; p < NPH; ++p) { a.ph_lo = p; a.ph_hi = p + 1; hipLaunchKernelGGL(mk_fwd, dim3(grid), dim3(NWAVES * 64), LDS_BYTES, stream, a); }
}
```

```cpp
#include <hip/hip_runtime.h>
#include <hip/hip_bf16.h>
#include <cstdio>
#include <cstdint>
#include <cmath>
namespace pg8 {
#define PG8_LAS __attribute__((address_space(3)))
typedef unsigned short bf16_t;
typedef short bf16x8 __attribute__((ext_vector_type(8)));
typedef float f32x4 __attribute__((ext_vector_type(4)));
typedef float f32x2 __attribute__((ext_vector_type(2)));
typedef unsigned u32x4 __attribute__((ext_vector_type(4)));
constexpr int BM = 256, BK = 64, HALF = 128, HTB = HALF * BK * 2  , STAGE_BYTES = 8 * HTB, NXCD = 8, WGM = 8;

__host__ __device__ __forceinline__ int lds_byte(int r, int c) { const int st = (r >> 4) * 2 + (c >> 5), rr = r & 15, cc = c & 31, ob = rr * 64 + cc * 2; return st * 1024 + (ob ^ (((ob >> 9) & 1) << 5)); }
__host__ __device__ __forceinline__ void stage_rc(int b, int& R, int& C) { const int st = b / 1024, sb = b % 1024, swz = sb ^ (((sb >> 9) & 1) << 5); R = (st >> 1) * 16 + swz / 64; C = (st & 1) * 32 + (swz % 64) / 2; }
__host__ __device__ __forceinline__ int perm32(int rho) { const int n = rho >> 4, i = rho & 15; return 8 * (i >> 2) + 4 * n + (i & 3); }

struct Unit { int pm, pn, e, lt, cnt; };
struct Gemm { const bf16_t* A; const bf16_t* Bt; int M, N, K; };

struct StaticOrder {
    int nM, nN, nwg, G, c; const bf16_t* A; const bf16_t* Bt; size_t tstep;
    __device__ void init(const Gemm& g, int G_, int c_) { nM = g.M / BM; nN = g.N / BM; nwg = nM * nN; G = G_; c = c_; A = g.A; Bt = g.Bt; tstep = (size_t)BM * g.K * 2; }
    __device__ bool next(int i, Unit& u) const {
        const long L = (long)i * G + c; if (L >= nwg) return false;
        int wgid = (int)L; { const int q = nwg / NXCD, r = nwg % NXCD, xcd = wgid % NXCD, off = wgid / NXCD; wgid = (xcd < r ? xcd * (q + 1) : r * (q + 1) + (xcd - r) * q) + off; }
        const int nig = WGM * nN, gid = wgid / nig, fm = gid * WGM, gsz = (nM - fm) < WGM ? (nM - fm) : WGM;
        u.pm = fm + ((wgid % nig) % gsz); u.pn = (wgid % nig) / gsz; u.e = 0; u.lt = 0; u.cnt = 0; return true;
    }
    __device__ __forceinline__ const char* a_base(const Unit& u) const { return (const char*)A + (size_t)u.pm * tstep; }
    __device__ __forceinline__ const char* b_base(const Unit& u) const { return (const char*)Bt + (size_t)u.pn * tstep; }
    __device__ __forceinline__ unsigned row_off(const Unit&, int) const { return 0u; }
    __device__ __forceinline__ int rows_valid(const Unit&) const { return BM; }
};
template <bool GATHER> struct MoeOrder {
    const PG8_LAS int* tstart; const PG8_LAS int* cnt; int ntiles, G, c;
    const bf16_t* A; const bf16_t* Bt; size_t a_tstep, b_estep, b_tstep; const int* list; int Kb  ;
    __device__ bool next(int i, Unit& u) const {
        const long L = (long)i * G + c; if (L >= 4L * ntiles) return false;
        const int rt = (int)(L >> 2); u.pn = (int)(L & 3); u.pm = rt;
        int e = 0;
#pragma unroll
        for (int k = 1; k < 32; ++k) e += (rt >= tstart[k]) ? 1 : 0;
        e = __builtin_amdgcn_readfirstlane(e);
        u.e = e; u.lt = __builtin_amdgcn_readfirstlane(rt - tstart[e]); u.cnt = __builtin_amdgcn_readfirstlane(cnt[e]); return true;
    }
    __device__ __forceinline__ const char* a_base(const Unit& u) const { return GATHER ? (const char*)A : (const char*)A + (size_t)u.pm * a_tstep; }
    __device__ __forceinline__ const char* b_base(const Unit& u) const { return (const char*)Bt + (size_t)u.e * b_estep + (size_t)u.pn * b_tstep; }
    __device__ __forceinline__ unsigned row_off(const Unit& u, int R) const { const int pos = u.lt * BM + R; const int tok = (pos < u.cnt) ? list[(size_t)u.e * 16384 + pos] : 0; return (unsigned)tok * (unsigned)Kb; }
    __device__ __forceinline__ int rows_valid(const Unit& u) const { return u.cnt - u.lt * BM; }
};

__device__ __forceinline__ unsigned cvt_pk_bf16(float lo, float hi) { unsigned r; asm volatile("v_cvt_pk_bf16_f32 %0, %1, %2" : "=v"(r) : "v"(lo), "v"(hi)); return r; }

struct EpiBf16 {
    static constexpr bool PERM = true;
    bf16_t* O; int ldc; int split_cols; size_t split_stride; float scale0; unsigned* kmax;
    __device__ __forceinline__ void operator()(const f32x4 (&acc)[2][2][4][2], const Unit& u, int wr, int wc, int fr, int fq) const {
        const int row0 = u.pm * BM + wr * 64 + fr; int colt = u.pn * BM; bf16_t* base = O;
        float sc = 1.f; int tsplit = 0; if (split_cols) { const int t = colt / split_cols; tsplit = t; base += (size_t)t * split_stride; colt -= t * split_cols; if (t == 0) sc = scale0; }
        const int col0 = colt + wc * 32 + 8 * fq;
        if (kmax && tsplit == 1) {
#pragma unroll
            for (int ai = 0; ai < 2; ++ai)
#pragma unroll
                for (int bj = 0; bj < 2; ++bj) { float mx = 0.f;
#pragma unroll
                    for (int m = 0; m < 4; ++m) { const f32x4 a = acc[ai][bj][m][0], b = acc[ai][bj][m][1];
                        float ss = (a[0] * a[0] + a[1] * a[1]) + (a[2] * a[2] + a[3] * a[3]) + (b[0] * b[0] + b[1] * b[1]) + (b[2] * b[2] + b[3] * b[3]);
                        ss += __shfl_xor(ss, 16); ss += __shfl_xor(ss, 32); mx = __builtin_fmaxf(mx, ss); }
                    mx = __builtin_fmaxf(mx, __shfl_xor(mx, 1)); mx = __builtin_fmaxf(mx, __shfl_xor(mx, 2)); mx = __builtin_fmaxf(mx, __shfl_xor(mx, 4)); mx = __builtin_fmaxf(mx, __shfl_xor(mx, 8));
                    if (fr == 0 && fq == 0) atomicMax(kmax + (size_t)(u.pm * 4 + ai * 2 + wr) * 8 + (colt >> 6) + 2 * bj + (wc >> 1), __float_as_uint(mx)); }
        }
#pragma unroll
        for (int ai = 0; ai < 2; ++ai)
#pragma unroll
            for (int m = 0; m < 4; ++m) { bf16_t* rowp = base + (size_t)(row0 + ai * HALF + m * 16) * ldc + col0;
#pragma unroll
                for (int bj = 0; bj < 2; ++bj) { f32x4 v0 = acc[ai][bj][m][0] * sc, v1 = acc[ai][bj][m][1] * sc;
                    u32x4 w; w.x = cvt_pk_bf16(v0[0], v0[1]); w.y = cvt_pk_bf16(v0[2], v0[3]); w.z = cvt_pk_bf16(v1[0], v1[1]); w.w = cvt_pk_bf16(v1[2], v1[3]);
                    *(u32x4*)(rowp + bj * HALF) = w; } }
    }
};
struct EpiResF32 {
    static constexpr bool PERM = false;
    const float* base; float* out; int ldc;
    __device__ __forceinline__ void operator()(const f32x4 (&acc)[2][2][4][2], const Unit& u, int wr, int wc, int fr, int fq) const {
        const int col0 = u.pn * BM + wc * 32 + 4 * fq;
#pragma unroll
        for (int ai = 0; ai < 2; ++ai)
#pragma unroll
            for (int m = 0; m < 4; ++m) { const size_t off = (size_t)(u.pm * BM + ai * HALF + wr * 64 + m * 16 + fr) * ldc + col0;
#pragma unroll
                for (int bj = 0; bj < 2; ++bj)
#pragma unroll
                    for (int n = 0; n < 2; ++n) { const f32x4 bs = *(const f32x4*)(base + off + bj * HALF + n * 16); *(f32x4*)(out + off + bj * HALF + n * 16) = bs + acc[ai][bj][m][n]; } }
    }
};
struct EpiSwiGLU {
    static constexpr bool PERM = true;
    bf16_t* O;
    __device__ __forceinline__ void operator()(const f32x4 (&acc)[2][2][4][2], const Unit& u, int wr, int wc, int fr, int fq) const {
        const int row0 = u.pm * BM + wr * 64 + fr, col0 = u.pn * HALF + wc * 32 + 8 * fq;
#pragma unroll
        for (int ai = 0; ai < 2; ++ai)
#pragma unroll
            for (int m = 0; m < 4; ++m) { float hv[8];
#pragma unroll
                for (int n = 0; n < 2; ++n)
#pragma unroll
                    for (int j = 0; j < 4; ++j) { const float g = acc[ai][0][m][n][j], up = acc[ai][1][m][n][j];
                        const float sg = __builtin_amdgcn_rcpf(1.0f + __builtin_amdgcn_exp2f(-1.4426950408889634f * g)); hv[n * 4 + j] = g * sg * up; }
                u32x4 w; w.x = cvt_pk_bf16(hv[0], hv[1]); w.y = cvt_pk_bf16(hv[2], hv[3]); w.z = cvt_pk_bf16(hv[4], hv[5]); w.w = cvt_pk_bf16(hv[6], hv[7]);
                *(u32x4*)(O + (size_t)(row0 + ai * HALF + m * 16) * 512 + col0) = w; }
    }
};
struct EpiGateBf16 {
    static constexpr bool PERM = true;
    bf16_t* O; const float* glist;
    __device__ __forceinline__ void operator()(const f32x4 (&acc)[2][2][4][2], const Unit& u, int wr, int wc, int fr, int fq) const {
        const int col0 = u.pn * BM + wc * 32 + 8 * fq;
#pragma unroll
        for (int ai = 0; ai < 2; ++ai)
#pragma unroll
            for (int m = 0; m < 4; ++m) { const int R = ai * HALF + wr * 64 + m * 16 + fr, pos = u.lt * BM + R; const float gt = (pos < u.cnt) ? glist[(size_t)u.e * 16384 + pos] : 0.f;
                bf16_t* rowp = O + (size_t)(u.pm * BM + R) * 1024 + col0;
#pragma unroll
                for (int bj = 0; bj < 2; ++bj) { f32x4 v0 = acc[ai][bj][m][0] * gt, v1 = acc[ai][bj][m][1] * gt;
                    u32x4 w; w.x = cvt_pk_bf16(v0[0], v0[1]); w.y = cvt_pk_bf16(v0[2], v0[3]); w.z = cvt_pk_bf16(v1[0], v1[1]); w.w = cvt_pk_bf16(v1[2], v1[3]);
                    *(u32x4*)(rowp + bj * HALF) = w; } }
    }
};

template <class Epi, class Sched, bool GATHER>
__device__ __forceinline__ void gemm_phase(PG8_LAS unsigned char* lds, const int K, const Sched& S, const Epi& E) {
    const int tid = threadIdx.x, wid = __builtin_amdgcn_readfirstlane(tid >> 6), lane = tid & 63, wr = wid >> 2, wc = wid & 3, fr = lane & 15, fq = lane >> 4;
    const int nt = K / BK;
    unsigned voffA[2], voffB[2]; int rowA[2];
#pragma unroll
    for (int i = 0; i < 2; ++i) { int R, C; stage_rc(tid * 16 + i * 8192, R, C); const int Rb = Epi::PERM ? ((R & ~31) + perm32(R & 31)) : R;
        rowA[i] = R; voffA[i] = GATHER ? (unsigned)C * 2u : (unsigned)(R * K + C) * 2u; voffB[i] = (unsigned)(Rb * K + C) * 2u; }
    const size_t kstep = (size_t)(BK * 2);
    const size_t hstep = (size_t)HALF * K * 2;
    const size_t hstepA = GATHER ? 0 : hstep;
    const unsigned ldsw = (unsigned)wid * 1024u;
    const int aoff = lds_byte(wr * 64 + fr, fq * 8), boff = lds_byte(wc * 32 + fr, fq * 8);
#define PG8_SA(b, h) (((b) * 2 + (h)) * HTB)
#define PG8_SB(b, h) ((4 + (b) * 2 + (h)) * HTB)
#define PG8_STAGE(bufoff, gbase, voff) do { _Pragma("unroll") for (int _i = 0; _i < 2; ++_i) \
        __builtin_amdgcn_global_load_lds((const unsigned*)((const char*)(gbase) + (voff)[_i]), (PG8_LAS unsigned*)(lds + (bufoff) + ldsw + _i * 8192), 16, 0, 0); } while (0)
#define PG8_STAGE_A(bufoff, gbase, h, VO) do { _Pragma("unroll") for (int _i = 0; _i < 2; ++_i) \
        __builtin_amdgcn_global_load_lds((const unsigned*)((const char*)(gbase) + (size_t)(h) * hstepA + (GATHER ? (VO)[2 * (h) + _i] : voffA[_i])), (PG8_LAS unsigned*)(lds + (bufoff) + ldsw + _i * 8192), 16, 0, 0); } while (0)
#define PG8_LDA(dst, b, h) do { _Pragma("unroll") for (int m = 0; m < 4; ++m) _Pragma("unroll") for (int k = 0; k < 2; ++k) dst[m][k] = *(const PG8_LAS bf16x8*)(lds + PG8_SA(b, h) + aoff + m * 2048 + k * 1024); } while (0)
#define PG8_LDB(dst, b, h) do { _Pragma("unroll") for (int n = 0; n < 2; ++n) _Pragma("unroll") for (int k = 0; k < 2; ++k) dst[n][k] = *(const PG8_LAS bf16x8*)(lds + PG8_SB(b, h) + boff + n * 2048 + k * 1024); } while (0)
#define PG8_MMA(ai, bj, At, Bt) do { __builtin_amdgcn_s_setprio(1); _Pragma("unroll") for (int m = 0; m < 4; ++m) _Pragma("unroll") for (int n = 0; n < 2; ++n) _Pragma("unroll") for (int k = 0; k < 2; ++k) \
        acc[ai][bj][m][n] = __builtin_amdgcn_mfma_f32_16x16x32_bf16(Bt[n][k], At[m][k], acc[ai][bj][m][n], 0, 0, 0); __builtin_amdgcn_s_setprio(0); } while (0)
#define PG8_WAIT_V(n) asm volatile("s_waitcnt vmcnt(" #n ")" ::: "memory")
#define PG8_WAIT_L(n) asm volatile("s_waitcnt lgkmcnt(" #n ")" ::: "memory")
#define PG8_BAR __builtin_amdgcn_s_barrier()
#define PG8_SCHED __builtin_amdgcn_sched_barrier(0)
    Unit cur, nxt; int ui = 0;
    if (!S.next(0, cur)) return;
    f32x4 acc[2][2][4][2];
#pragma unroll
    for (int a = 0; a < 2; ++a)
#pragma unroll
        for (int b = 0; b < 2; ++b)
#pragma unroll
            for (int m = 0; m < 4; ++m)
#pragma unroll
                for (int n = 0; n < 2; ++n) acc[a][b][m][n] = (f32x4){0.f, 0.f, 0.f, 0.f};
    bf16x8 At[4][2], B0[2][2], B1[2][2];
    const char* cA = S.a_base(cur); const char* cB = S.b_base(cur);
    unsigned vc[4] = {0u, 0u, 0u, 0u}, vn[4] = {0u, 0u, 0u, 0u};
    if constexpr (GATHER) {
#pragma unroll
        for (int h = 0; h < 2; ++h)
#pragma unroll
            for (int i = 0; i < 2; ++i) vc[2 * h + i] = S.row_off(cur, h * HALF + rowA[i]) + voffA[i];
    }
    PG8_STAGE(PG8_SB(0, 0), cB, voffB); PG8_STAGE(PG8_SB(0, 1), cB + hstep, voffB); PG8_STAGE_A(PG8_SA(0, 0), cA, 0, vc); PG8_STAGE_A(PG8_SA(0, 1), cA, 1, vc);
    if (wr == 1) PG8_BAR;
    PG8_WAIT_V(2); PG8_BAR;
    PG8_STAGE(PG8_SB(1, 0), cB + kstep, voffB); PG8_STAGE_A(PG8_SA(1, 0), cA + kstep, 0, vc); PG8_STAGE(PG8_SB(1, 1), cB + hstep + kstep, voffB);
    PG8_WAIT_V(6); PG8_BAR;
    for (;;) {
        const bool has_next = S.next(ui + 1, nxt);
        const char* nA = has_next ? S.a_base(nxt) : cA; const char* nB = has_next ? S.b_base(nxt) : cB;
        if constexpr (GATHER) {
#pragma unroll
            for (int h = 0; h < 2; ++h)
#pragma unroll
                for (int i = 0; i < 2; ++i) vn[2 * h + i] = has_next ? (S.row_off(nxt, h * HALF + rowA[i]) + voffA[i]) : vc[2 * h + i];
        }
        const bool full = S.rows_valid(cur) > HALF;
        for (int t = 0; t < nt; t += 2) {
            const bool last = (t == nt - 2);
            const char* a1 = cA + (size_t)(t + 1) * kstep;
            const char* a2 = last ? nA : cA + (size_t)(t + 2) * kstep; const char* b2 = last ? nB : cB + (size_t)(t + 2) * kstep;
            const char* a3 = a2 + kstep; const char* b3 = b2 + kstep;
            unsigned v2[4];
#pragma unroll
            for (int q = 0; q < 4; ++q) v2[q] = last ? vn[q] : vc[q];
            PG8_LDB(B0, 0, 0); PG8_LDB(B1, 0, 1); PG8_SCHED; PG8_LDA(At, 0, 0); PG8_STAGE_A(PG8_SA(1, 1), a1, 1, vc);
            PG8_WAIT_V(8); PG8_WAIT_L(0); PG8_BAR; PG8_MMA(0, 0, At, B0); PG8_MMA(0, 1, At, B1); PG8_BAR; PG8_SCHED;
            PG8_LDA(At, 0, 1); PG8_STAGE(PG8_SB(0, 0), b2, voffB); PG8_STAGE(PG8_SB(0, 1), b2 + hstep, voffB); PG8_STAGE_A(PG8_SA(0, 0), a2, 0, v2);
            PG8_WAIT_V(8); PG8_WAIT_L(0); PG8_BAR; if (full) { PG8_MMA(1, 0, At, B0); PG8_MMA(1, 1, At, B1); } PG8_BAR; PG8_SCHED;
            PG8_LDB(B0, 1, 0); PG8_LDB(B1, 1, 1); PG8_SCHED; PG8_LDA(At, 1, 0); PG8_STAGE_A(PG8_SA(0, 1), a2, 1, v2);
            PG8_WAIT_V(8); PG8_WAIT_L(0); PG8_BAR; PG8_MMA(0, 0, At, B0); PG8_MMA(0, 1, At, B1); PG8_BAR; PG8_SCHED;
            PG8_LDA(At, 1, 1); PG8_STAGE(PG8_SB(1, 0), b3, voffB); PG8_STAGE(PG8_SB(1, 1), b3 + hstep, voffB); PG8_STAGE_A(PG8_SA(1, 0), a3, 0, v2);
            PG8_WAIT_V(8); PG8_WAIT_L(0); PG8_BAR; if (full) { PG8_MMA(1, 0, At, B0); PG8_MMA(1, 1, At, B1); } PG8_BAR; PG8_SCHED;
        }
        if (wr == 0) PG8_BAR;
        E(acc, cur, wr, wc, fr, fq);
        if (!has_next) break;
#pragma unroll
        for (int a = 0; a < 2; ++a)
#pragma unroll
            for (int b = 0; b < 2; ++b)
#pragma unroll
                for (int m = 0; m < 4; ++m)
#pragma unroll
                    for (int n = 0; n < 2; ++n) acc[a][b][m][n] = (f32x4){0.f, 0.f, 0.f, 0.f};
        cur = nxt; cA = nA; cB = nB; ++ui;
#pragma unroll
        for (int q = 0; q < 4; ++q) vc[q] = vn[q];
        if (wr == 1) PG8_BAR;
    }
    PG8_WAIT_V(0);
    PG8_BAR;
#undef PG8_SA
#undef PG8_SB
#undef PG8_STAGE
#undef PG8_STAGE_A
#undef PG8_LDA
#undef PG8_LDB
#undef PG8_MMA
#undef PG8_WAIT_V
#undef PG8_WAIT_L
#undef PG8_BAR
#undef PG8_SCHED
}
}
namespace attn {
using bf16x8 = __attribute__((ext_vector_type(8))) short;
using s16x4 = __attribute__((ext_vector_type(4))) short;
using f32x16 = __attribute__((ext_vector_type(16))) float;
using u32x4 = __attribute__((ext_vector_type(4))) unsigned;
typedef unsigned short bf16_t;
constexpr int SEQ = 8192, NW = 8, QBLK = 32, QB = QBLK * NW, KVBLK = 64, NTILE = SEQ / KVBLK, PITCH = 512;
constexpr int KSLOT = 8192, VSLOT = 16384;
constexpr int LDS_K = 0, LDS_V = 3 * KSLOT, LDS_WS = LDS_V + 3 * VSLOT, LDS_OST = LDS_WS + NW * 256, LDS_BYTES = LDS_OST + NW * 8192;
#define SBAR() __builtin_amdgcn_sched_barrier(0)
#define PIN(x) asm volatile("" : "+v"(x))
#define MFMA32(a, b, c) __builtin_amdgcn_mfma_f32_32x32x16_bf16(a, b, c, 0, 0, 0)
#define WAIT_BAR(N) asm volatile("s_waitcnt vmcnt(" #N ") lgkmcnt(0)\n\ts_barrier" ::: "memory")
__device__ __forceinline__ constexpr int crow0(int r) { return (r & 3) + 8 * (r >> 2); }
__device__ __forceinline__ void glds16(const void* g, unsigned lds_base) {
    unsigned sv; asm volatile("s_mov_b32 %0, m0\n\ts_mov_b32 m0, %2\n\ts_nop 0\n\tglobal_load_lds_dwordx4 %1, off\n\ts_mov_b32 m0, %0" : "=&s"(sv) : "v"(g), "s"(lds_base) : "memory"); }
typedef float f32x2_t __attribute__((ext_vector_type(2))); typedef __bf16 bf16x2_t __attribute__((ext_vector_type(2)));
__device__ __forceinline__ unsigned cvtpk(float lo, float hi) { f32x2_t v = {lo, hi}; bf16x2_t b = __builtin_convertvector(v, bf16x2_t); return __builtin_bit_cast(unsigned, b); }
typedef __attribute__((address_space(3))) const char* lds_cptr;
typedef short v4i16_t __attribute__((ext_vector_type(4)));
__device__ __forceinline__ bf16x8 kld(lds_cptr p) { return *(const __attribute__((address_space(3))) bf16x8*)p; }
__device__ __forceinline__ s16x4 vtr(lds_cptr p) { return __builtin_bit_cast(s16x4, __builtin_amdgcn_ds_read_tr16_b64_v4i16((__attribute__((address_space(3))) v4i16_t*)p)); }
#define MX3(a, b, c) __builtin_fmaxf(__builtin_fmaxf((a), (b)), (c))
__device__ __forceinline__ float rowmax(const f32x16& p0, const f32x16& p1) {
    float a = MX3(p0[0], p0[1], p1[0]), b = MX3(p0[2], p0[3], p1[1]); a = MX3(a, p1[2], p1[3]);
#pragma unroll
    for (int r = 4; r < 16; r += 4) { a = MX3(a, p0[r], p0[r + 1]); b = MX3(b, p0[r + 2], p0[r + 3]); a = MX3(a, p1[r], p1[r + 1]); b = MX3(b, p1[r + 2], p1[r + 3]); }
    float m = __builtin_fmaxf(a, b); auto rr = __builtin_amdgcn_permlane32_swap(__float_as_uint(m), __float_as_uint(m), false, false);
    return __builtin_fmaxf(__uint_as_float(rr[0]), __uint_as_float(rr[1])); }
__device__ __forceinline__ float bf2f(short s) { return __uint_as_float(((unsigned)(unsigned short)s) << 16); }
__device__ __forceinline__ void build_c(f32x16& C, int side, float dj, float sg2, float mhat) {
    if (side == 0) {
#pragma unroll
        for (int r = 0; r < 16; ++r) C[r] = __builtin_fmaf(-sg2, __builtin_fabsf(dj + (float)crow0(r)), -mhat);
    } else {
        const float ss = (side > 0) ? -sg2 : sg2, cl = __builtin_fmaf(ss, dj, -mhat);
#pragma unroll
        for (int r = 0; r < 16; ++r) C[r] = __builtin_fmaf(ss, (float)crow0(r), cl);
    }
}

constexpr float SKIP_T = 150.0f;
constexpr float NOMAX_SPAN = 100.0f;
template <int THRL, bool NOMAX>
__device__ __forceinline__ void attn_body(int b, int h, int c, int qb, int tlo, int thi, float sg2, float mhat, const bf16x8 (&qr)[4], const bf16_t* __restrict__ K, const bf16_t* __restrict__ V, bf16_t* AO, char* lds);

template <int THRL>
__device__ __forceinline__ void attn_unit(int b, int h, int c, int qb, float sg2, const bf16_t* Q, const bf16_t* __restrict__ K, const bf16_t* __restrict__ V, bf16_t* AO, const unsigned* kb2, char* lds) {
    const int tid = threadIdx.x, lane = tid & 63, r32 = lane & 31, hi = lane >> 5; const int wid = __builtin_amdgcn_readfirstlane(tid >> 6);
    const long rowbase = (long)b * SEQ; const int q0 = qb * QB, iw0 = q0 + wid * QBLK;
    const bf16_t* Qw = Q + (rowbase + iw0) * PITCH + h * 128 + c * 64;
    const bf16_t* Kh = K + rowbase * PITCH + h * 128 + c * 64; const bf16_t* Vh = V + rowbase * PITCH + h * 128;
    const unsigned lds0 = (unsigned)(uintptr_t)lds; float* wsf = (float*)(lds + LDS_WS) + wid * 64;
    bf16x8 qr[4];
#pragma unroll
    for (int d0 = 0; d0 < 4; ++d0) qr[d0] = *reinterpret_cast<const bf16x8*>(&Qw[(long)r32 * PITCH + d0 * 16 + hi * 8]);
    float mhat; int tlo, thi;
    { const bf16_t* Kd = Kh + (long)(iw0 + r32) * PITCH; float s = 0.f, na = 0.f, nb = 0.f;
#pragma unroll
      for (int d0 = 0; d0 < 4; ++d0) { const bf16x8 kk = *reinterpret_cast<const bf16x8*>(&Kd[d0 * 16 + hi * 8]);
#pragma unroll
          for (int j = 0; j < 8; ++j) { const float qv = bf2f(qr[d0][j]); s = __builtin_fmaf(qv, bf2f(kk[j]), s); if (d0 < 2) na = __builtin_fmaf(qv, qv, na); else nb = __builtin_fmaf(qv, qv, nb); } }
      auto rr = __builtin_amdgcn_permlane32_swap(__float_as_uint(s), __float_as_uint(s), false, false); mhat = __uint_as_float(rr[0]) + __uint_as_float(rr[1]);
      auto ra = __builtin_amdgcn_permlane32_swap(__float_as_uint(na), __float_as_uint(na), false, false); na = __uint_as_float(ra[0]) + __uint_as_float(ra[1]);
      auto rb = __builtin_amdgcn_permlane32_swap(__float_as_uint(nb), __float_as_uint(nb), false, false); nb = __uint_as_float(rb[0]) + __uint_as_float(rb[1]);
      float qn = (sqrtf(na) + sqrtf(nb)) * 1.001f, sm = mhat; const float qrow = qn;
#pragma unroll
      for (int o_ = 1; o_ < 32; o_ <<= 1) { qn = __builtin_fmaxf(qn, __shfl_xor(qn, o_)); sm = __builtin_fminf(sm, __shfl_xor(sm, o_)); }
      if (lane == 0) { wsf[48] = qn; wsf[49] = sm; }
      asm volatile("s_waitcnt lgkmcnt(0)\n\ts_barrier" ::: "memory");
      { const float* wsa = (const float*)(lds + LDS_WS);
#pragma unroll
        for (int w = 0; w < NW; ++w) { qn = __builtin_fmaxf(qn, wsa[w * 64 + 48]); sm = __builtin_fminf(sm, wsa[w * 64 + 49]); } }
      int lo_ = NTILE, hi_ = -1; float kmg = 0.f;
#pragma unroll
      for (int half = 0; half < 2; ++half) { const int J = lane + 64 * half; const float km = sqrtf(__uint_as_float(kb2[J * 8 + h * 2 + c])) * 1.01f;
          const int dl_ = q0 - (J * KVBLK + KVBLK - 1), dr_ = J * KVBLK - (q0 + QB - 1); const float dmin = (float)(dl_ > 0 ? dl_ : (dr_ > 0 ? dr_ : 0));
          const bool need = (qn * km - sg2 * dmin - sm >= -SKIP_T) || (dl_ <= 0 && dr_ <= 0);
          kmg = __builtin_fmaxf(kmg, km);
          if (need) { lo_ = lo_ < J ? lo_ : J; hi_ = hi_ > J ? hi_ : J; } }
#pragma unroll
      for (int o_ = 1; o_ < 64; o_ <<= 1) { const int l2 = __shfl_xor(lo_, o_), h2 = __shfl_xor(hi_, o_); lo_ = lo_ < l2 ? lo_ : l2; hi_ = hi_ > h2 ? hi_ : h2; kmg = __builtin_fmaxf(kmg, __shfl_xor(kmg, o_)); }
      tlo = __builtin_amdgcn_readfirstlane(lo_); thi = __builtin_amdgcn_readfirstlane(hi_);
      const bool fixedref = __builtin_amdgcn_readfirstlane((qn * kmg - sm <= NOMAX_SPAN) ? 1 : 0) != 0;
      if (fixedref) attn_body<THRL, true>(b, h, c, qb, tlo, thi, sg2, qrow * kmg, qr, K, V, AO, lds);
      else attn_body<THRL, false>(b, h, c, qb, tlo, thi, sg2, mhat, qr, K, V, AO, lds); }
}

template <int THRL, bool NOMAX>
__device__ __forceinline__ void attn_body(int b, int h, int c, int qb, int tlo, int thi, float sg2, float mhat, const bf16x8 (&qr)[4], const bf16_t* __restrict__ K, const bf16_t* __restrict__ V, bf16_t* AO, char* lds) {
    const int tid = threadIdx.x, lane = tid & 63, r32 = lane & 31, hi = lane >> 5; const int wid = __builtin_amdgcn_readfirstlane(tid >> 6);
    const long rowbase = (long)b * SEQ; const int q0 = qb * QB, iw0 = q0 + wid * QBLK;
    const bf16_t* Kh = K + rowbase * PITCH + h * 128 + c * 64; const bf16_t* Vh = V + rowbase * PITCH + h * 128;
    const unsigned lds0 = (unsigned)(uintptr_t)lds; float* wsf = (float*)(lds + LDS_WS) + wid * 64;
    const int n = thi - tlo + 1;
    const bf16_t* ksrc = Kh + (long)tlo * KVBLK * PITCH + (long)lane * PITCH + wid * 8;
    const bf16_t* vsrc = Vh + (long)tlo * KVBLK * PITCH + (long)(32 * (wid & 1) + (lane >> 2)) * PITCH + (wid >> 1) * 32 + (lane & 3) * 8;
    const unsigned kdst = lds0 + LDS_K + wid * 1024, vdst = lds0 + LDS_V + wid * 2048;
#define DMA_K(s, slot) glds16(ksrc + (long)(s) * KVBLK * PITCH, (unsigned)__builtin_amdgcn_readfirstlane(kdst + (slot) * KSLOT))
#define DMA_V(s, slot) do { glds16(vsrc + (long)(s) * KVBLK * PITCH, (unsigned)__builtin_amdgcn_readfirstlane(vdst + (slot) * VSLOT)); \
                            glds16(vsrc + (long)(s) * KVBLK * PITCH + 16 * PITCH, (unsigned)__builtin_amdgcn_readfirstlane(vdst + (slot) * VSLOT + 1024)); } while (0)
    const lds_cptr vp0 = (lds_cptr)lds + LDS_V + ((lane >> 4) & 1) * 32 + (lane & 3) * 8 + (4 * hi + ((lane & 15) >> 2)) * 64;
    const lds_cptr kp0 = (lds_cptr)lds + LDS_K + hi * 1024 + r32 * 16;
    DMA_K(0, 0); DMA_V(0, 0); DMA_K(1, 1); DMA_K(2, 2);
    float l_reg = 0.f; f32x16 o[4]; o[0] = f32x16{}; o[1] = f32x16{}; o[2] = f32x16{}; o[3] = f32x16{};
    const float fi = (float)(4 * hi - (iw0 + r32));
    bool resc = false;
    f32x16 C0, C1; bf16x8 kf[8]; u32x4 pw0, pw1, pw2, pw3;
    pw0 = u32x4{}; pw1 = u32x4{}; pw2 = u32x4{}; pw3 = u32x4{};
    int s_prev = 0, s_cur = 0, s_next = 1;
#define ROT() do { s_prev = s_cur; s_cur = s_next; s_next = (s_next == 2) ? 0 : s_next + 1; } while (0)
#define EX(v) __builtin_amdgcn_exp2f(v)
#define RESC() do { if constexpr (!NOMAX) if (resc) { asm volatile("s_waitcnt lgkmcnt(0)" ::: "memory"); _Pragma("unroll") for (int d_ = 0; d_ < 4; ++d_) _Pragma("unroll") for (int r = 0; r < 16; ++r) o[d_][r] *= wsf[crow0(r) + 4 * hi]; } } while (0)
    asm volatile("s_waitcnt vmcnt(0) lgkmcnt(0)\n\ts_barrier" ::: "memory");
#pragma unroll
    for (int f = 0; f < 8; ++f) kf[f] = kld(kp0 + (f >> 1) * 2048 + (f & 1) * 512);
    asm volatile("s_waitcnt lgkmcnt(0)\n\ts_barrier" ::: "memory");
#define PKW(P, i) cvtpk(P[i], P[i + 1])
#define PAF(k) __builtin_bit_cast(bf16x8, pw##k)
#define VFRG(lo, hi_) (bf16x8){lo[0], lo[1], lo[2], lo[3], hi_[0], hi_[1], hi_[2], hi_[3]}
#define VRD(f) do { vlo[f] = vtr(vp_ + (((f) & 3) * 4096 + ((f) >> 2) * 1024)); vhi[f] = vtr(vp_ + (((f) & 3) * 4096 + ((f) >> 2) * 1024 + 512)); } while (0)
#define STEP(s, FIRST, GK, GV, GL) do { SBAR(); \
    const int jt_ = (tlo + (s)) * KVBLK; const lds_cptr vp_ = vp0 + s_prev * VSLOT; s16x4 vlo[16], vhi[16]; \
    { const int d0_ = jt_ - iw0, d1_ = jt_ + 32 - iw0; \
      build_c(C0, (d0_ > 0) - (d0_ < 0), (float)jt_ + fi, sg2, mhat); build_c(C1, (d1_ > 0) - (d1_ < 0), (float)(jt_ + 32) + fi, sg2, mhat); } \
    if (!(FIRST)) { VRD(0); VRD(1); } SBAR(); \
    C0 = MFMA32(kf[0], qr[0], C0); C1 = MFMA32(kf[1], qr[0], C1); SBAR(); \
    if (!(FIRST)) { VRD(2); VRD(3); } SBAR(); \
    C0 = MFMA32(kf[2], qr[1], C0); C1 = MFMA32(kf[3], qr[1], C1); SBAR(); \
    C0 = MFMA32(kf[4], qr[2], C0); C1 = MFMA32(kf[5], qr[2], C1); SBAR(); \
    C0 = MFMA32(kf[6], qr[3], C0); C1 = MFMA32(kf[7], qr[3], C1); SBAR(); \
    if (GK) DMA_K((s) + 3, s_cur); if (GV) DMA_V((s) + 1, s_next); \
    if constexpr (!NOMAX) { const float rm = rowmax(C0, C1); resc = false; \
      if (__builtin_expect(__any(rm > (float)THRL), 0)) { const float dl = __builtin_fmaxf(rm, 0.f); mhat += dl; \
          _Pragma("unroll") for (int r = 0; r < 16; ++r) { C0[r] -= dl; C1[r] -= dl; } \
          const float f = EX(-dl); l_reg *= f; if (hi == 0) wsf[r32] = f; resc = true; } } \
    SBAR(); \
    float sacc = 0.f; u32x4 nw0, nw1, nw2, nw3; \
    _Pragma("unroll") for (int g = 0; g < 16; ++g) { \
        if (!(FIRST)) { const int ks_ = g >> 2, db_ = g & 3; \
            if (g + 4 < 16) { VRD(g + 4); } \
            const bf16x8 pa_ = (ks_ == 0) ? PAF(0) : (ks_ == 1) ? PAF(1) : (ks_ == 2) ? PAF(2) : PAF(3); \
            o[db_] = MFMA32(pa_, VFRG(vlo[g], vhi[g]), o[db_]); } \
        if (GL) { if (g >= 4 && g < 12) { kf[g - 4] = kld(kp0 + s_next * KSLOT + ((g - 4) >> 1) * 2048 + ((g - 4) & 1) * 512); } } \
        if (g < 8) { C0[2 * g] = EX(C0[2 * g]); C0[2 * g + 1] = EX(C0[2 * g + 1]); sacc += C0[2 * g]; sacc += C0[2 * g + 1]; } \
        else { C1[2 * g - 16] = EX(C1[2 * g - 16]); C1[2 * g - 15] = EX(C1[2 * g - 15]); sacc += C1[2 * g - 16]; sacc += C1[2 * g - 15]; } \
        if (g == 0) nw0[0] = PKW(C0, 0); if (g == 1) nw0[1] = PKW(C0, 2); if (g == 2) nw0[2] = PKW(C0, 4); if (g == 3) nw0[3] = PKW(C0, 6); \
        if (g == 4) nw1[0] = PKW(C0, 8); if (g == 5) nw1[1] = PKW(C0, 10); if (g == 6) nw1[2] = PKW(C0, 12); if (g == 7) nw1[3] = PKW(C0, 14); \
        if (g == 8) nw2[0] = PKW(C1, 0); if (g == 9) nw2[1] = PKW(C1, 2); if (g == 10) nw2[2] = PKW(C1, 4); if (g == 11) nw2[3] = PKW(C1, 6); \
        if (g == 12) nw3[0] = PKW(C1, 8); if (g == 13) nw3[1] = PKW(C1, 10); if (g == 14) nw3[2] = PKW(C1, 12); if (g == 15) nw3[3] = PKW(C1, 14); \
        PIN(sacc); SBAR(); } \
    l_reg += sacc; pw0 = nw0; pw1 = nw1; pw2 = nw2; pw3 = nw3; \
    } while (0)
    STEP(0, true, true, true, true); WAIT_BAR(3); RESC(); ROT();
    int s = 1;
    for (; s + 3 < n; ++s) { STEP(s, false, true, true, true); WAIT_BAR(3); RESC(); ROT(); }
    STEP(s, false, false, true, true); WAIT_BAR(2); RESC(); ROT(); ++s;
    STEP(s, false, false, true, true); WAIT_BAR(2); RESC(); ROT(); ++s;
    STEP(s, false, false, false, false); WAIT_BAR(0); RESC(); ROT();
    { const lds_cptr vp_ = vp0 + s_prev * VSLOT; s16x4 vlo[16], vhi[16];
#pragma unroll
      for (int g = 0; g < 16; ++g) VRD(g);
#pragma unroll
      for (int g = 0; g < 16; ++g) { const int ks_ = g >> 2, db_ = g & 3; const bf16x8 pa_ = (ks_ == 0) ? PAF(0) : (ks_ == 1) ? PAF(1) : (ks_ == 2) ? PAF(2) : PAF(3);
          o[db_] = MFMA32(pa_, VFRG(vlo[g], vhi[g]), o[db_]); } }
    { auto rr = __builtin_amdgcn_permlane32_swap(__float_as_uint(l_reg), __float_as_uint(l_reg), false, false); l_reg = __uint_as_float(rr[0]) + __uint_as_float(rr[1]); }
    if (hi == 0) wsf[32 + r32] = l_reg; asm volatile("s_waitcnt lgkmcnt(0)" ::: "memory");
    float rli[16];
#pragma unroll
    for (int r = 0; r < 16; ++r) rli[r] = __builtin_amdgcn_rcpf(wsf[32 + crow0(r) + 4 * hi]);
    bf16_t* Ow = AO + (rowbase + iw0) * PITCH + h * 128; __hip_bfloat16* stg = (__hip_bfloat16*)(lds + LDS_OST) + wid * 4096;
#pragma unroll
    for (int r = 0; r < 16; ++r) { const int orow = crow0(r) + 4 * hi;
#pragma unroll
        for (int db = 0; db < 4; ++db) stg[orow * 128 + db * 32 + r32] = __float2bfloat16(o[db][r] * rli[r]); }
    asm volatile("s_waitcnt lgkmcnt(0)" ::: "memory");
#pragma unroll
    for (int i = 0; i < 8; ++i) { const int row = i * 4 + (lane >> 4), ch = lane & 15; *(u32x4*)(Ow + (long)row * PITCH + ch * 8) = *(const u32x4*)(stg + row * 128 + ch * 8); }
    asm volatile("s_waitcnt lgkmcnt(0)\n\ts_barrier" ::: "memory");
#undef DMA_K
#undef DMA_V
#undef ROT
#undef EX
#undef RESC
#undef PKW
#undef PAF
#undef VFRG
#undef VRD
#undef STEP
}
#undef SBAR
#undef PIN
#undef MFMA32
#undef WAIT_BAR
#undef MX3
}
constexpr int NWAVES = 8;
constexpr int BATCH = 2, SEQ = 8192, DM = 1024, T = BATCH * SEQ, NEXP = 32, DEXP = 512;
constexpr float EPS = 1e-6f, LAM_INIT = 0.2f;
constexpr float C2 = 0.125f * 1.4426950408889634f;
constexpr float LOG2E = 1.4426950408889634f;
constexpr int ATT_THR = 8;

constexpr size_t MiB = 1u << 20;
constexpr size_t WS_CTL = 0, CTL_ZERO_BYTES = 65536;
constexpr size_t WS_LIST = 1 * MiB, WS_GLIST = 3 * MiB, WS_EPOS = 5 * MiB;
constexpr size_t WS_WIN = 6 * MiB, WS_WOUT = 10 * MiB, WS_WGU = 12 * MiB, WS_WD = 76 * MiB;
constexpr size_t WS_QKVU = 108 * MiB;
constexpr size_t WS_XN2 = 108 * MiB;
constexpr size_t WS_Y = 108 * MiB;
constexpr size_t WS_XN1 = 172 * MiB;
constexpr size_t WS_MIX = 172 * MiB;
constexpr size_t WS_AO = 204 * MiB;
constexpr size_t WS_HDN = 204 * MiB;
constexpr size_t WS_END = 244 * MiB;
constexpr int MAXROWS = 40960;
constexpr int CW_CNT = 64;
constexpr int CW_BAR = 4096;
constexpr int CW_QUEUE = 3968;
constexpr int CW_KMAX = 8192;
constexpr int LDS_BYTES = 163840;
constexpr int MISC_OFF = LDS_BYTES - 256;
constexpr int MOE_TAB_OFF = 131072;
constexpr int RT_WR = 0, RT_SC = 148032, RT_SQ = 160320, RT_SR = 160576, RT_HI = 160832;

#define GAS __attribute__((address_space(1)))
#define LAS __attribute__((address_space(3)))
typedef unsigned short bf16;
typedef unsigned v4u __attribute__((ext_vector_type(4)));
typedef unsigned v2u __attribute__((ext_vector_type(2)));
typedef float f32x4 __attribute__((ext_vector_type(4)));
typedef GAS unsigned gu32;
#define RLX_AGENT __ATOMIC_RELAXED, __HIP_MEMORY_SCOPE_AGENT
#define LDS_WAIT() asm volatile("s_waitcnt lgkmcnt(0)" ::: "memory")
#define VM_WAIT() asm volatile("s_waitcnt vmcnt(0)" ::: "memory")
__device__ __forceinline__ unsigned f2bf(float f) { unsigned u = __builtin_bit_cast(unsigned, f); return (u + 0x7fffu + ((u >> 16) & 1u)) >> 16; }
__device__ __forceinline__ unsigned pk2(float lo, float hi) { return f2bf(lo) | (f2bf(hi) << 16); }
__device__ __forceinline__ float bflo(unsigned w) { return __uint_as_float(w << 16); }
__device__ __forceinline__ float bfhi(unsigned w) { return __uint_as_float(w & 0xffff0000u); }

#define XB_TMO      128
#define XB_XCNT(j)  (256  + 64 * (j))
#define XB_XSUB(j)  (1280 + 64 * (j))
#define XB_XGEN(j)  (2304 + 64 * (j))
#define XB_TOP      3328
#define XB_TOPGEN   3392
#define XCD_BAR_WORDS 3456
#define XB_SPIN_CAP (1u << 18)
__device__ __forceinline__ unsigned xb_ld(unsigned* p)              { return __hip_atomic_load(p, __ATOMIC_RELAXED, __HIP_MEMORY_SCOPE_AGENT); }
__device__ __forceinline__ unsigned xb_add(unsigned* p, unsigned v) { return __hip_atomic_fetch_add(p, v, __ATOMIC_RELAXED, __HIP_MEMORY_SCOPE_AGENT); }
__device__ __forceinline__ unsigned xb_xcc_id() { return (unsigned)__builtin_amdgcn_s_getreg((3 << 11) | 20) & 0xFu; }
#define XB_SPIN(cond, bar) do { unsigned _sp = 0; while (cond) { __builtin_amdgcn_s_sleep(1); \
    if ((++_sp & 255u) == 0u) { if (xb_ld(&(bar)[XB_TMO])) break; if (_sp > XB_SPIN_CAP) { atomicAdd(&(bar)[XB_TMO], 1u); break; } } } } while (0)
struct XcdBarrier { unsigned* bar; unsigned x; volatile LAS unsigned* st; };
__device__ __forceinline__ XcdBarrier xcd_barrier_post(unsigned* bar, volatile LAS unsigned* st) {
    XcdBarrier b; b.bar = bar; b.x = xb_xcc_id(); b.st = st;
    if (threadIdx.x == 0) (void)xb_add(&bar[XB_XCNT(b.x)], 1u);
    return b;
}
__device__ __forceinline__ void xcd_barrier_complete(unsigned* bar, unsigned x, unsigned& nloc, unsigned& nx) {
    const unsigned G = gridDim.x * gridDim.y * gridDim.z;
    unsigned sum, cnt, mine, sp = 0u;
    for (;;) {
        sum = 0u; cnt = 0u; mine = 0u;
#pragma unroll
        for (unsigned j = 0; j < 16; ++j) { const unsigned c = xb_ld(&bar[XB_XCNT(j)]); sum += c; cnt += (c > 0u) ? 1u : 0u; mine = (j == x) ? c : mine; }
        if (sum == G) break;
        __builtin_amdgcn_s_sleep(1);
        if ((++sp & 255u) == 0u) { if (xb_ld(&bar[XB_TMO])) break; if (sp > XB_SPIN_CAP) { atomicAdd(&bar[XB_TMO], 1u); break; } }
    }
    nloc = mine > 0u ? mine : 1u; nx = cnt > 0u ? cnt : 1u;
}
__device__ __forceinline__ void xcd_barrier(const XcdBarrier& b) {
    asm volatile("s_waitcnt vmcnt(0)" ::: "memory");
    __syncthreads();
    if (threadIdx.x == 0) {
        unsigned* bar = b.bar;
        __builtin_amdgcn_s_waitcnt(0);
        unsigned nloc = b.st[0], nx = b.st[1];
        if (nloc == 0u) { xcd_barrier_complete(bar, b.x, nloc, nx); b.st[0] = nloc; b.st[1] = nx; }
        const unsigned old = xb_add(&bar[XB_XSUB(b.x)], 1u);
        const unsigned gen = old / nloc;
        if (old + 1u == (gen + 1u) * nloc) {
            __builtin_amdgcn_fence(__ATOMIC_RELEASE, "agent");
            asm volatile("s_waitcnt vmcnt(0)" ::: "memory");
            const unsigned og = xb_add(&bar[XB_TOP], 1u);
            const unsigned tg = og / nx;
            if (og + 1u == (tg + 1u) * nx) xb_add(&bar[XB_TOPGEN], 1u);
            else XB_SPIN(xb_ld(&bar[XB_TOPGEN]) == tg, bar);
            __builtin_amdgcn_fence(__ATOMIC_ACQUIRE, "agent");
            xb_add(&bar[XB_XGEN(b.x)], 1u);
            asm volatile("s_waitcnt vmcnt(0)" ::: "memory");
        } else {
            XB_SPIN(xb_ld(&bar[XB_XGEN(b.x)]) == gen, bar);
            __builtin_amdgcn_fence(__ATOMIC_ACQUIRE, "agent");
            asm volatile("s_waitcnt vmcnt(0)" ::: "memory");
        }
    }
    __syncthreads();
}

__device__ __forceinline__ float wave_sum(float v) {
#pragma unroll
    for (int o = 1; o < 64; o <<= 1) v += __shfl_xor(v, o);
    return v;
}
struct TrItem { const float* src; int ldw; bf16* dst; size_t opitch; };
__device__ __forceinline__ void tr_load(const TrItem& I, float (&v)[32], int lane) {
#pragma unroll
    for (int i = 0; i < 32; ++i) v[i] = I.src[(size_t)(2 * i + (lane >> 5)) * I.ldw + (lane & 31)];
}
__device__ __forceinline__ void tr_finish(const TrItem& I, const float (&v)[32], LAS float* scr, int lane) {
#pragma unroll
    for (int i = 0; i < 32; ++i) scr[(2 * i + (lane >> 5)) * 33 + (lane & 31)] = v[i];
    LDS_WAIT(); asm volatile("" ::: "memory");
    const int c = lane & 7;
#pragma unroll
    for (int j = 0; j < 4; ++j) { const int n = (lane >> 3) + 8 * j; const LAS float* sp = scr + (8 * c) * 33 + n;
        v4u o; o.x = pk2(sp[0 * 33], sp[1 * 33]); o.y = pk2(sp[2 * 33], sp[3 * 33]); o.z = pk2(sp[4 * 33], sp[5 * 33]); o.w = pk2(sp[6 * 33], sp[7 * 33]);
        *(GAS v4u*)(I.dst + (size_t)n * I.opitch + 8 * c) = o; }
    LDS_WAIT(); asm volatile("" ::: "memory");
}
template <int NR> __device__ __forceinline__ void rms_rows_to_bf16(const float* x, const float* g, bf16* o, int m0, int stride, int mend, int lane) {
    f32x4 v[NR][4];
#pragma unroll
    for (int k = 0; k < NR; ++k) { const int m = m0 + k * stride; const GAS f32x4* xr = (const GAS f32x4*)(x + (size_t)(m < mend ? m : m0) * DM) + lane;
#pragma unroll
        for (int j = 0; j < 4; ++j) v[k][j] = xr[64 * j]; }
    const GAS f32x4* gr = (const GAS f32x4*)g + lane; f32x4 gg[4];
#pragma unroll
    for (int j = 0; j < 4; ++j) gg[j] = gr[64 * j];
#pragma unroll
    for (int k = 0; k < NR; ++k) { const int m = m0 + k * stride; float s = 0.f;
#pragma unroll
        for (int j = 0; j < 4; ++j) s += (v[k][j].x * v[k][j].x + v[k][j].y * v[k][j].y) + (v[k][j].z * v[k][j].z + v[k][j].w * v[k][j].w);
        const float rstd = 1.0f / sqrtf(wave_sum(s) * (1.f / DM) + EPS);
        if (m < mend) { GAS v2u* o8 = (GAS v2u*)(o + (size_t)m * DM) + lane;
#pragma unroll
            for (int j = 0; j < 4; ++j) { v2u w; w.x = pk2(v[k][j].x * rstd * gg[j].x, v[k][j].y * rstd * gg[j].y); w.y = pk2(v[k][j].z * rstd * gg[j].z, v[k][j].w * rstd * gg[j].w); o8[64 * j] = w; } } }
}

__device__ __forceinline__ TrItem expert_item(int it, const float* wgate, const float* wup, const float* wdown, bf16* Wgu_t, bf16* Wd_t) {
    constexpr int I_G = 16 * 16, I_D = 8 * 32; TrItem I;
    const int e = it / (2 * I_G + I_D); int r = it - e * (2 * I_G + I_D);
    if (r < 2 * I_G) { const int up = r / I_G; r -= up * I_G; const int kb = r / 16, nb = r % 16, n0 = 32 * nb;
        I.src = (up ? wup : wgate) + (size_t)e * 1024 * 512 + (size_t)(64 * kb) * 512 + n0; I.ldw = 512;
        I.dst = Wgu_t + (size_t)e * 1024 * 1024 + (size_t)((n0 >> 7) * 256 + 128 * up + (n0 & 127)) * 1024 + 64 * kb; I.opitch = 1024; return I; }
    r -= 2 * I_G;
    const int kb = r / 32, nb = r % 32; I.src = wdown + (size_t)e * 512 * 1024 + (size_t)(64 * kb) * 1024 + 32 * nb; I.ldw = 1024; I.dst = Wd_t + (size_t)e * 1024 * 512 + (size_t)(32 * nb) * 512 + 64 * kb; I.opitch = 512; return I;
}
constexpr int N_EXPERT_ITEMS = 32 * 768, Q_BATCH = 64, N_Q_BATCHES = N_EXPERT_ITEMS / Q_BATCH, N_POOL_BATCHES = 16384 / 64;

struct Args { const float* in[20]; float* out; unsigned char* ws; int ph_lo, ph_hi; };

__global__ void __launch_bounds__(NWAVES * 64, 2) mk_fwd(Args args) {
    extern __shared__ __attribute__((aligned(16))) unsigned char lds[];
    LAS unsigned char* L = (LAS unsigned char*)lds;
    volatile LAS unsigned* MISC = (volatile LAS unsigned*)(L + MISC_OFF);
    const int tid = threadIdx.x, lane = tid & 63, wave = __builtin_amdgcn_readfirstlane(tid >> 6);
    const int G = gridDim.x; const int bx = blockIdx.x; const int vcu = (G % 8 == 0) ? (bx % 8) * (G / 8) + bx / 8 : bx;
    unsigned char* ws = args.ws;
    gu32* ctl = (gu32*)(ws + WS_CTL);
    const float* x = args.in[0]; const float* n1g = args.in[1]; const float* w_in = args.in[2];
    const float* lq1 = args.in[3]; const float* lk1 = args.in[4]; const float* lq2 = args.in[5]; const float* lk2 = args.in[6];
    const float* subg = args.in[7]; const float* wpool = args.in[8]; const float* pscale = args.in[9]; const float* w_out = args.in[10];
    const float* n2g = args.in[11]; const float* wgr = args.in[12]; const float* bgr = args.in[13]; const float* wer = args.in[14];
    const float* ber = args.in[15]; const float* wgate = args.in[16]; const float* wup = args.in[17]; const float* wdown = args.in[18]; const float* fing = args.in[19];
    float* out = args.out;
    bf16* Win_t = (bf16*)(ws + WS_WIN); bf16* Wout_t = (bf16*)(ws + WS_WOUT); bf16* Wgu_t = (bf16*)(ws + WS_WGU); bf16* Wd_t = (bf16*)(ws + WS_WD);
    bf16* QKVU = (bf16*)(ws + WS_QKVU); bf16* XN1 = (bf16*)(ws + WS_XN1); bf16* MIX = (bf16*)(ws + WS_MIX); bf16* AO = (bf16*)(ws + WS_AO);
    bf16* XN2 = (bf16*)(ws + WS_XN2); bf16* HDN = (bf16*)(ws + WS_HDN); bf16* Y = (bf16*)(ws + WS_Y);
    int* list = (int*)(ws + WS_LIST); float* glist = (float*)(ws + WS_GLIST); int* epos = (int*)(ws + WS_EPOS);
    for (int u = tid; u < 64; u += NWAVES * 64) ((LAS unsigned*)(L + MISC_OFF))[u] = 0u;
    __syncthreads();
    XcdBarrier bar = xcd_barrier_post((unsigned*)(ctl + CW_BAR), MISC + 8);
    const int lo = args.ph_lo, hi = args.ph_hi;
#define IN(k) (lo <= (k) && (k) < hi)
#define SEAM(k) do { if (IN(k) && IN((k) + 1)) xcd_barrier(bar); } while (0)
    const int gw = vcu * NWAVES + wave, NGW = G * NWAVES;

    if (IN(0)) {
        LAS float* scr = (LAS float*)(L + wave * 16384);
        constexpr int I_WIN = 16 * 64, I_WO = 8 * 32;
        constexpr int NITEMS = I_WIN + I_WO;
        auto decode = [&](int it) -> TrItem { TrItem I; int r = it;
            if (r < I_WIN) { const int kb = r / 64, nb = r % 64; I.src = w_in + (size_t)(64 * kb) * 2048 + 32 * nb; I.ldw = 2048; I.dst = Win_t + (size_t)(32 * nb) * 1024 + 64 * kb; I.opitch = 1024; return I; } r -= I_WIN;
            { const int kb = r / 32, nb = r % 32; I.src = w_out + (size_t)(64 * kb) * 1024 + 32 * nb; I.ldw = 1024; I.dst = Wout_t + (size_t)(32 * nb) * 1024 + 64 * kb; I.opitch = 1024; return I; } };
        { float va[32], vb[32]; int it = gw; TrItem Ia, Ib;
          if (it < NITEMS) { Ia = decode(it); tr_load(Ia, va, lane); }
          while (it < NITEMS) {
              const int itb = it + NGW; if (itb < NITEMS) { Ib = decode(itb); tr_load(Ib, vb, lane); }
              tr_finish(Ia, va, scr, lane);
              if (itb >= NITEMS) break;
              const int itc = itb + NGW; if (itc < NITEMS) { Ia = decode(itc); tr_load(Ia, va, lane); }
              tr_finish(Ib, vb, scr, lane);
              it = itc; } }
        for (int m = gw; m < T; m += 4 * NGW) rms_rows_to_bf16<4>(x, n1g, XN1, m, NGW, T, lane);
        __syncthreads();
        for (int id = bx; id < 256; id += G) {
            const int g = id >> 6, kb = (id >> 4) & 3, nb = id & 15;
            LAS float* WoS = (LAS float*)L; LAS float* wps = (LAS float*)(L + 32768);
            { f32x4 t4[4];
#pragma unroll
              for (int q = 0; q < 4; ++q) { const int f = tid + 512 * q, dd = f >> 4, c4 = (f & 15) * 4; t4[q] = *(const GAS f32x4*)(w_out + (size_t)(512 + g * 128 + dd) * 1024 + nb * 64 + c4); }
              float w8[8], p8[8];
#pragma unroll
              for (int q = 0; q < 8; ++q) { const int f = tid + 512 * q, kk = f >> 7, dd = f & 127; w8[q] = wpool[(size_t)(g * 128 + kb * 32 + kk) * 128 + dd]; p8[q] = pscale[g * 128 + dd]; }
#pragma unroll
              for (int q = 0; q < 4; ++q) { const int f = tid + 512 * q; *(LAS f32x4*)(WoS + (f >> 4) * 64 + (f & 15) * 4) = t4[q]; }
#pragma unroll
              for (int q = 0; q < 8; ++q) { const int f = tid + 512 * q; wps[(f >> 7) * 129 + (f & 127)] = w8[q] * p8[q]; } }
            __syncthreads();
            { const int kk = tid >> 4, c4 = (tid & 15) * 4; f32x4 acc = {0.f, 0.f, 0.f, 0.f};
#pragma unroll 8
              for (int dd = 0; dd < 128; ++dd) { const float w = wps[kk * 129 + dd]; const f32x4 wo = *(const LAS f32x4*)(WoS + dd * 64 + c4); acc = acc + wo * w; }
              bf16* dst = Wout_t + (size_t)(nb * 64 + c4) * 1024 + 512 + g * 128 + kb * 32 + kk;
              dst[0] = (bf16)f2bf(acc.x); dst[1024] = (bf16)f2bf(acc.y); dst[2048] = (bf16)f2bf(acc.z); dst[3072] = (bf16)f2bf(acc.w); }
            __syncthreads();
        }
    }
    SEAM(0);
    if (IN(1)) {
        pg8::Gemm g{XN1, Win_t, T, 2048, DM}; pg8::StaticOrder S; S.init(g, G, bx);
        pg8::EpiBf16 E{QKVU, 512, 512, (size_t)T * 512, C2, (unsigned*)(ctl + CW_KMAX)};
        pg8::gemm_phase<pg8::EpiBf16, pg8::StaticOrder, false>(L, DM, S, E);
    }
    SEAM(1);
    if (IN(2)) {
        const int xg = vcu >> 5, i5 = vcu & 31, b = xg >> 2, ty = (xg >> 1) & 1, qb = 16 * (xg & 1) + (i5 >> 1), c = i5 & 1;
        if (vcu < 256) {
#pragma unroll 1
            for (int u = 0; u < 2; ++u) { const int h = (u == 0) ? (ty ? 2 : 3) : (ty ? 1 : 0);
                const float slope = exp2f(-2.0f * (float)(h + 1)), sg2 = slope * LOG2E;
                attn::attn_unit<ATT_THR>(b, h, c, qb, sg2, QKVU, QKVU + (size_t)T * 512, QKVU + (size_t)2 * T * 512, AO + (size_t)c * T * 512, (const unsigned*)(ctl + CW_KMAX) + (size_t)b * 128 * 8, (char*)lds); }
        }
        { LAS float* scr = (LAS float*)(L + wave * 16384); volatile LAS unsigned* qslot = MISC + 16;
          for (;;) {
              __syncthreads();
              if (tid == 0) qslot[0] = atomicAdd((unsigned*)(ctl + CW_QUEUE), 1u);
              __syncthreads();
              const int batch = (int)qslot[0]; if (batch >= N_Q_BATCHES + N_POOL_BATCHES) break;
              if (batch >= N_Q_BATCHES) {
                  const bf16* U = QKVU + (size_t)3 * T * 512; const int t0 = (batch - N_Q_BATCHES) * 64 + wave * 8, tt0 = t0 & (SEQ - 1), tb = t0 - tt0; v4u ur[23];
#pragma unroll
                  for (int k = 0; k < 23; ++k) { int j = tt0 - 8 + k; j = j < 0 ? 0 : (j > SEQ - 1 ? SEQ - 1 : j); ur[k] = *(const GAS v4u*)(U + (size_t)(tb + j) * 512 + 8 * lane); }
                  const int hw = 1 << (lane >> 4);
#pragma unroll
                  for (int q = 0; q < 8; ++q) {
                      const int tt = tt0 + q; int jlo = tt - hw, jhi = tt + hw; jlo = jlo < 0 ? 0 : jlo; jhi = jhi > SEQ ? SEQ : jhi;
                      float sm[8] = {0.f, 0.f, 0.f, 0.f, 0.f, 0.f, 0.f, 0.f};
#pragma unroll
                      for (int k = q; k < q + 16; ++k) { const int j = tt0 - 8 + k; const float wgt = (j >= jlo && j < jhi) ? 1.0f : 0.0f;
#pragma unroll
                          for (int p = 0; p < 4; ++p) { sm[2 * p] = __builtin_fmaf(wgt, bflo(ur[k][p]), sm[2 * p]); sm[2 * p + 1] = __builtin_fmaf(wgt, bfhi(ur[k][p]), sm[2 * p + 1]); } }
                      const float ic = 1.0f / (float)(jhi - jlo); const v4u ut = ur[8 + q];
                      v4u d; d.x = pk2(sm[0] * ic - bflo(ut[0]), sm[1] * ic - bfhi(ut[0])); d.y = pk2(sm[2] * ic - bflo(ut[1]), sm[3] * ic - bfhi(ut[1]));
                      d.z = pk2(sm[4] * ic - bflo(ut[2]), sm[5] * ic - bfhi(ut[2])); d.w = pk2(sm[6] * ic - bflo(ut[3]), sm[7] * ic - bfhi(ut[3]));
                      *(GAS v4u*)(MIX + (size_t)(t0 + q) * 1024 + 512 + 8 * lane) = d; }
                  continue; }
              const int it0 = batch * Q_BATCH + wave * 8; float va[32], vb[32]; TrItem Ia, Ib;
              Ia = expert_item(it0, wgate, wup, wdown, Wgu_t, Wd_t); tr_load(Ia, va, lane);
#pragma unroll 1
              for (int k = 0; k < 8; k += 2) {
                  Ib = expert_item(it0 + k + 1, wgate, wup, wdown, Wgu_t, Wd_t); tr_load(Ib, vb, lane);
                  tr_finish(Ia, va, scr, lane);
                  if (k + 2 < 8) { Ia = expert_item(it0 + k + 2, wgate, wup, wdown, Wgu_t, Wd_t); tr_load(Ia, va, lane); }
                  tr_finish(Ib, vb, scr, lane); } } }
    }
    SEAM(2);
    if (IN(3)) {
        float s1 = wave_sum(lq1[lane] * lk1[lane]), s2 = wave_sum(lq2[lane] * lk2[lane]);
        const float lam = expf(s1) - expf(s2) + LAM_INIT;
        float sg[8];
#pragma unroll
        for (int j = 0; j < 8; ++j) sg[j] = subg[(8 * lane + j) & 127] * (1.0f - LAM_INIT);
        for (int t0 = gw * 8; t0 < T; t0 += NGW * 8) {
            v4u a1[8], a2[8];
#pragma unroll
            for (int q = 0; q < 8; ++q) { a1[q] = *(const GAS v4u*)(AO + (size_t)(t0 + q) * 512 + 8 * lane); a2[q] = *(const GAS v4u*)(AO + (size_t)(T + t0 + q) * 512 + 8 * lane); }
#pragma unroll
            for (int q = 0; q < 8; ++q) {
                float a[8];
#pragma unroll
                for (int j = 0; j < 4; ++j) { a[2 * j] = bflo(a1[q][j]) - lam * bflo(a2[q][j]); a[2 * j + 1] = bfhi(a1[q][j]) - lam * bfhi(a2[q][j]); }
                float ss = 0.f;
#pragma unroll
                for (int j = 0; j < 8; ++j) ss += a[j] * a[j];
                ss += __shfl_xor(ss, 1); ss += __shfl_xor(ss, 2); ss += __shfl_xor(ss, 4); ss += __shfl_xor(ss, 8);
                const float r = 1.0f / sqrtf(ss * (1.0f / 128.0f) + EPS);
                v4u o; o.x = pk2(a[0] * r * sg[0], a[1] * r * sg[1]); o.y = pk2(a[2] * r * sg[2], a[3] * r * sg[3]); o.z = pk2(a[4] * r * sg[4], a[5] * r * sg[5]); o.w = pk2(a[6] * r * sg[6], a[7] * r * sg[7]);
                *(GAS v4u*)(MIX + (size_t)(t0 + q) * 1024 + 8 * lane) = o;
            }
        }
    }
    SEAM(3);
    if (IN(4)) {
        pg8::Gemm g{MIX, Wout_t, T, DM, DM}; pg8::StaticOrder S; S.init(g, G, bx);
        pg8::EpiResF32 E{x, out, DM};
        pg8::gemm_phase<pg8::EpiResF32, pg8::StaticOrder, false>(L, DM, S, E);
    }
    SEAM(4);
    if (IN(5)) {
        LAS float* WR = (LAS float*)(L + RT_WR); LAS float* SC = (LAS float*)(L + RT_SC); LAS float* SQ = (LAS float*)(L + RT_SQ); LAS float* SR = (LAS float*)(L + RT_SR);
        { float wv[8], gv[8];
#pragma unroll
          for (int q = 0; q < 8; ++q) { const int idx = tid + 512 * q; wv[q] = wgr[idx]; gv[q] = n2g[idx >> 2]; }
#pragma unroll
          for (int q = 0; q < 8; ++q) { const int idx = tid + 512 * q; WR[(idx & 3) * 1028 + (idx >> 2)] = wv[q] * gv[q]; }
          for (int base = 0; base < 1024 * 32; base += 512 * 16) { float w16[16], g16[16];
#pragma unroll
              for (int q = 0; q < 16; ++q) { const int idx = base + tid + 512 * q; w16[q] = wer[idx]; g16[q] = n2g[idx >> 5]; }
#pragma unroll
              for (int q = 0; q < 16; ++q) { const int idx = base + tid + 512 * q; WR[(4 + (idx & 31)) * 1028 + (idx >> 5)] = w16[q] * g16[q]; } } }
        LAS unsigned* HI = (LAS unsigned*)(L + RT_HI); LAS unsigned* HB = HI + 32;
        if (tid < 32) HI[tid] = 0u;
        __syncthreads();
        const int gq = wave & 3, kh = wave >> 2, tk = lane & 15, kq = lane >> 4;
        for (int tb = vcu * 64; tb < T; tb += G * 64) {
            const float* hrow = out + (size_t)(tb + 16 * gq + tk) * DM + 512 * kh + 4 * kq;
            f32x4 acc[3] = {{0.f, 0.f, 0.f, 0.f}, {0.f, 0.f, 0.f, 0.f}, {0.f, 0.f, 0.f, 0.f}}; float ssq = 0.f;
            int r_ea = 0, r_eb = 0, r_pa = 0, r_pb = 0; float r_g1 = 0.f, r_g2 = 0.f;
            int nn[3];
#pragma unroll
            for (int nb = 0; nb < 3; ++nb) { const int n = 16 * nb + tk; nn[nb] = (n < 36 ? n : 35) * 1028 + 512 * kh + 4 * kq; }
#pragma unroll 8
            for (int s = 0; s < 32; ++s) {
                const f32x4 hv = *(const GAS f32x4*)(hrow + 16 * s);
                ssq += (hv.x * hv.x + hv.y * hv.y) + (hv.z * hv.z + hv.w * hv.w);
#pragma unroll
                for (int nb = 0; nb < 3; ++nb) { const f32x4 bv = *(const LAS f32x4*)(WR + nn[nb] + 16 * s);
                    acc[nb] = __builtin_amdgcn_mfma_f32_16x16x4f32(hv.x, bv.x, acc[nb], 0, 0, 0); acc[nb] = __builtin_amdgcn_mfma_f32_16x16x4f32(hv.y, bv.y, acc[nb], 0, 0, 0);
                    acc[nb] = __builtin_amdgcn_mfma_f32_16x16x4f32(hv.z, bv.z, acc[nb], 0, 0, 0); acc[nb] = __builtin_amdgcn_mfma_f32_16x16x4f32(hv.w, bv.w, acc[nb], 0, 0, 0); }
            }
            ssq += __shfl_xor(ssq, 16); ssq += __shfl_xor(ssq, 32);
            if (kh == 1) {
#pragma unroll
                for (int nb = 0; nb < 3; ++nb)
#pragma unroll
                    for (int r = 0; r < 4; ++r) SC[gq * 768 + (nb * 4 + r) * 64 + lane] = acc[nb][r];
                if (kq == 0) SQ[gq * 16 + tk] = ssq;
            }
            __syncthreads();
            if (kh == 0) {
#pragma unroll
                for (int nb = 0; nb < 3; ++nb)
#pragma unroll
                    for (int r = 0; r < 4; ++r) acc[nb][r] += SC[gq * 768 + (nb * 4 + r) * 64 + lane];
                const float sq2 = ssq + SQ[gq * 16 + tk];
                LDS_WAIT(); asm volatile("" ::: "memory");
#pragma unroll
                for (int nb = 0; nb < 3; ++nb)
#pragma unroll
                    for (int r = 0; r < 4; ++r) SC[gq * 768 + (4 * kq + r) * 48 + 16 * nb + tk] = acc[nb][r];
                LDS_WAIT(); asm volatile("" ::: "memory");
                if (lane < 16) {
                    const int t = tb + 16 * gq + lane; const float rstd = 1.0f / sqrtf(sq2 * (1.0f / DM) + EPS);
                    SR[gq * 16 + lane] = rstd;
                    const LAS float* lg = SC + gq * 768 + lane * 48;
                    float gl[4];
#pragma unroll
                    for (int g = 0; g < 4; ++g) gl[g] = lg[g] * rstd + bgr[g];
                    int gs = 0; float gm = gl[0];
#pragma unroll
                    for (int g = 1; g < 4; ++g) if (gl[g] > gm) { gm = gl[g]; gs = g; }
                    float den = 0.f;
#pragma unroll
                    for (int g = 0; g < 4; ++g) den += expf(gl[g] - gm);
                    const float pg = 1.0f / den;
                    float e8[8];
#pragma unroll
                    for (int i = 0; i < 8; ++i) e8[i] = lg[4 + gs * 8 + i] * rstd + ber[gs * 8 + i];
                    float v1 = e8[0]; int i1 = 0;
#pragma unroll
                    for (int i = 1; i < 8; ++i) if (e8[i] > v1) { v1 = e8[i]; i1 = i; }
                    float v2 = -3.0e38f; int i2 = 0;
#pragma unroll
                    for (int i = 0; i < 8; ++i) if (i != i1 && e8[i] > v2) { v2 = e8[i]; i2 = i; }
                    const float p2 = expf(v2 - v1), g1 = pg / (1.0f + p2), g2 = pg * p2 / (1.0f + p2);
                    const int ea = gs * 8 + i1, eb = gs * 8 + i2;
                    r_ea = ea; r_eb = eb; r_g1 = g1; r_g2 = g2;
                    r_pa = (int)__hip_atomic_fetch_add((LAS unsigned*)HI + ea, 1u, __ATOMIC_RELAXED, __HIP_MEMORY_SCOPE_WORKGROUP);
                    r_pb = (int)__hip_atomic_fetch_add((LAS unsigned*)HI + eb, 1u, __ATOMIC_RELAXED, __HIP_MEMORY_SCOPE_WORKGROUP);
                }
            }
            __syncthreads();
            if (tid < 32) { const unsigned c = HI[tid]; HB[tid] = c ? atomicAdd((unsigned*)(ctl + CW_CNT + 64 * tid), c) : 0u; }
            __syncthreads();
            if (kh == 0 && lane < 16) { const int t = tb + 16 * gq + lane; const int pa = r_pa + (int)HB[r_ea], pb = r_pb + (int)HB[r_eb];
                list[(size_t)r_ea * 16384 + pa] = t; glist[(size_t)r_ea * 16384 + pa] = r_g1; list[(size_t)r_eb * 16384 + pb] = t; glist[(size_t)r_eb * 16384 + pb] = r_g2;
                epos[t * 2] = (r_ea << 16) | pa; epos[t * 2 + 1] = (r_eb << 16) | pb; }
            if (tid < 32) HI[tid] = 0u;
            { const GAS f32x4* gr = (const GAS f32x4*)n2g + lane; f32x4 gg[4];
#pragma unroll
              for (int j = 0; j < 4; ++j) gg[j] = gr[64 * j];
#pragma unroll
              for (int qb_ = 0; qb_ < 2; ++qb_) { f32x4 v[4][4];
#pragma unroll
                  for (int q = 0; q < 4; ++q) { const GAS f32x4* hr = (const GAS f32x4*)(out + (size_t)(tb + 8 * wave + 4 * qb_ + q) * DM) + lane;
#pragma unroll
                      for (int j = 0; j < 4; ++j) v[q][j] = hr[64 * j]; }
#pragma unroll
                  for (int q = 0; q < 4; ++q) { const int tl = 8 * wave + 4 * qb_ + q; const float rstd = SR[tl]; GAS v2u* o8 = (GAS v2u*)(XN2 + (size_t)(tb + tl) * DM) + lane;
#pragma unroll
                      for (int j = 0; j < 4; ++j) { v2u w; w.x = pk2(v[q][j].x * rstd * gg[j].x, v[q][j].y * rstd * gg[j].y); w.y = pk2(v[q][j].z * rstd * gg[j].z, v[q][j].w * rstd * gg[j].w); o8[64 * j] = w; } } } }
            __syncthreads();
        }
    }
    SEAM(5);
    LAS int* tstart = (LAS int*)(L + MOE_TAB_OFF); LAS int* ecnt = (LAS int*)(L + MOE_TAB_OFF + 256);
    if (IN(6) || IN(7) || IN(8)) {
        if (tid < 32) ecnt[tid] = (int)__hip_atomic_load(ctl + CW_CNT + 64 * tid, RLX_AGENT);
        __syncthreads();
        if (tid == 0) { int a = 0; for (int e = 0; e < 32; ++e) { tstart[e] = a; a += (ecnt[e] + 255) >> 8; } tstart[32] = a; }
        __syncthreads();
    }
    if (IN(6)) {
        pg8::MoeOrder<true> S; S.tstart = tstart; S.cnt = ecnt; S.ntiles = tstart[32]; S.G = G; S.c = vcu; S.A = XN2; S.Bt = Wgu_t; S.a_tstep = 0; S.b_estep = (size_t)1024 * 1024 * 2; S.b_tstep = (size_t)256 * 1024 * 2; S.list = list; S.Kb = 2048;
        pg8::EpiSwiGLU E{HDN};
        pg8::gemm_phase<pg8::EpiSwiGLU, pg8::MoeOrder<true>, true>(L, DM, S, E);
    }
    SEAM(6);
    if (IN(7)) {
        pg8::MoeOrder<false> S; S.tstart = tstart; S.cnt = ecnt; S.ntiles = tstart[32]; S.G = G; S.c = vcu; S.A = HDN; S.Bt = Wd_t; S.a_tstep = (size_t)256 * 512 * 2; S.b_estep = (size_t)1024 * 512 * 2; S.b_tstep = (size_t)256 * 512 * 2; S.list = list; S.Kb = 1024;
        pg8::EpiGateBf16 E{Y, glist};
        pg8::gemm_phase<pg8::EpiGateBf16, pg8::MoeOrder<false>, false>(L, DEXP, S, E);
    }
    SEAM(7);
    if (IN(8)) {
        const GAS f32x4* gr = (const GAS f32x4*)fing + lane; f32x4 gg[4];
#pragma unroll
        for (int j = 0; j < 4; ++j) gg[j] = gr[64 * j];
        for (int t0 = gw; t0 < T; t0 += 4 * NGW) {
            int pa[4], pb[4];
#pragma unroll
            for (int q = 0; q < 4; ++q) { const int t = t0 + q * NGW; pa[q] = epos[(t < T ? t : t0) * 2]; pb[q] = epos[(t < T ? t : t0) * 2 + 1]; }
            f32x4 v[4][4]; v2u ya[4][4], yb[4][4];
#pragma unroll
            for (int q = 0; q < 4; ++q) { const int t = (t0 + q * NGW < T) ? t0 + q * NGW : t0;
                const size_t ra = (size_t)tstart[pa[q] >> 16] * 256 + (pa[q] & 0xffff), rb = (size_t)tstart[pb[q] >> 16] * 256 + (pb[q] & 0xffff);
                const GAS f32x4* hr = (const GAS f32x4*)(out + (size_t)t * DM) + lane; const GAS v2u* pya = (const GAS v2u*)(Y + ra * 1024) + lane; const GAS v2u* pyb = (const GAS v2u*)(Y + rb * 1024) + lane;
#pragma unroll
                for (int j = 0; j < 4; ++j) { v[q][j] = hr[64 * j]; ya[q][j] = pya[64 * j]; yb[q][j] = pyb[64 * j]; } }
#pragma unroll
            for (int q = 0; q < 4; ++q) { const int t = t0 + q * NGW; float s = 0.f;
#pragma unroll
                for (int j = 0; j < 4; ++j) { const v2u a = ya[q][j], bq = yb[q][j];
                    v[q][j].x += bflo(a.x) + bflo(bq.x); v[q][j].y += bfhi(a.x) + bfhi(bq.x); v[q][j].z += bflo(a.y) + bflo(bq.y); v[q][j].w += bfhi(a.y) + bfhi(bq.y);
                    s += (v[q][j].x * v[q][j].x + v[q][j].y * v[q][j].y) + (v[q][j].z * v[q][j].z + v[q][j].w * v[q][j].w); }
                const float rstd = 1.0f / sqrtf(wave_sum(s) * (1.f / DM) + EPS);
                if (t < T) { GAS f32x4* orow = (GAS f32x4*)(out + (size_t)t * DM) + lane;
#pragma unroll
                    for (int j = 0; j < 4; ++j) orow[64 * j] = v[q][j] * rstd * gg[j]; } }
        }
    }
#undef IN
#undef SEAM
}

extern "C" void kernel_launch(void* const* d_in, const int* in_sizes, int n_in, void* d_out, int out_size, void* d_ws, size_t ws_size, hipStream_t stream) {
    static int grid = 0;
    if (grid == 0) {
        if (n_in != 20 || in_sizes[0] != T * DM || out_size != T * DM || ws_size < WS_END) { fprintf(stderr, "kernel_launch: unexpected shapes: n_in %d in0 %d out %d ws %zu; nothing launched\n", n_in, n_in > 0 ? in_sizes[0] : -1, out_size, ws_size); grid = -1; return; }
        int dev = 0, cus = 0;
        if (hipGetDevice(&dev) != hipSuccess || hipDeviceGetAttribute(&cus, hipDeviceAttributeMultiprocessorCount, dev) != hipSuccess) { grid = -1; return; }
        if (hipFuncSetAttribute((const void*)mk_fwd, hipFuncAttributeMaxDynamicSharedMemorySize, LDS_BYTES) != hipSuccess) { fprintf(stderr, "kernel_launch: hipFuncSetAttribute failed\n"); grid = -1; return; }
        (void)hipGetLastError();
        grid = cus;
    }
    if (grid < 0) return;
    (void)hipMemsetAsync((char*)d_ws + WS_CTL, 0, CTL_ZERO_BYTES, stream);
    Args a{};
    for (int i = 0; i < 20; ++i) a.in[i] = (const float*)d_in[i];
    a.out = (float*)d_out; a.ws = (unsigned char*)d_ws;
#ifndef MK_N_LAUNCHES
#define MK_N_LAUNCHES 1
#endif
    constexpr int NPH = 9;
    if (MK_N_LAUNCHES == 1) { a.ph_lo = 0; a.ph_hi = NPH; hipLaunchKernelGGL(mk_fwd, dim3(grid), dim3(NWAVES * 64), LDS_BYTES, stream, a); }
    else for (int p = 0; p < NPH; ++p) { a.ph_lo = p; a.ph_hi = p + 1; hipLaunchKernelGGL(mk_fwd, dim3(grid), dim3(NWAVES * 64), LDS_BYTES, stream, a); }
}
```
